# Optimizing an MI355X kernel written in HIP

```python
import math
import jax
import jax.numpy as jnp
from jax import lax
import numpy as np

D_MODEL = 2048
BATCH = 8
SEQ = 2048
DEPTH = 1

MEM_LEN = 256
RMS_EPS = 1e-6
DN_HEAD_DIM = 128
DN_WIDTH = D_MODEL // 2
DN_HEADS = DN_WIDTH // DN_HEAD_DIM
DN_CONV = 4
DN_CHUNK = 64
RW_HEAD_DIM = 64
RW_WIDTH = D_MODEL - DN_WIDTH
RW_HEADS = RW_WIDTH // RW_HEAD_DIM
RW_DECAY_LORA = 64
RW_AAA_LORA = 64
RW_GATE_LORA = 128
RW_GN_EPS = 64e-5
DN_COLS = 4 * DN_WIDTH + 2 * DN_HEADS
RW_COLS = 3 * RW_WIDTH + RW_DECAY_LORA + RW_AAA_LORA + RW_GATE_LORA
IN_COLS = DN_COLS + RW_COLS
XA_HEADS = 4
XA_HEAD_DIM = 128
XA_WIDTH = XA_HEADS * XA_HEAD_DIM
FFN_HIDDEN = 4 * D_MODEL

kernel_name = 'hybrid_gdn_rwkv7_memxattn_layer'


def rmsnorm(x, w):
    xf = x.astype(jnp.float32)
    y = xf * lax.rsqrt(jnp.mean(xf * xf, axis=-1, keepdims=True) + RMS_EPS)
    return (y * w.astype(jnp.float32)).astype(x.dtype)


def l2norm(x):
    return x * lax.rsqrt(jnp.sum(x * x, axis=-1, keepdims=True) + 1e-6)


def causal_depthwise_conv(x, w):
    k = w.shape[0]
    return lax.conv_general_dilated(
        x, w[:, None, :].astype(x.dtype), window_strides=(1,), padding=[(k - 1, 0)],
        dimension_numbers=('NWC', 'WIO', 'NWC'), feature_group_count=x.shape[-1])


def token_shift(p):
    return jnp.pad(p, ((0, 0), (1, 0), (0, 0)))[:, :-1]


def chunked_gated_delta_rule(q, k, v, g, beta):
    b, s, h, dk = q.shape
    dv = v.shape[-1]
    c = DN_CHUNK
    n = s // c

    def chunks(t):
        return t.reshape(b, n, c, h, -1).transpose(0, 3, 1, 2, 4)

    q = chunks(q) * (dk ** -0.5)
    k = chunks(k)
    v = chunks(v)
    g = g.reshape(b, n, c, h).transpose(0, 3, 1, 2)
    beta = beta.reshape(b, n, c, h).transpose(0, 3, 1, 2)
    gc = jnp.cumsum(g, axis=-1)
    idx = jnp.arange(c)
    causal = idx[:, None] >= idx[None, :]
    strict = idx[:, None] > idx[None, :]
    decay = jnp.exp(jnp.where(causal, gc[..., :, None] - gc[..., None, :], -jnp.inf))
    kb = k * beta[..., None]
    a_strict = jnp.where(strict, jnp.einsum('bhncd,bhnmd->bhncm', kb, k) * decay, 0.0)
    lower = a_strict + jnp.eye(c, dtype=q.dtype)
    rhs = jnp.concatenate([v * beta[..., None], kb * jnp.exp(gc)[..., None]], axis=-1)
    sol = lax.linalg.triangular_solve(lower, rhs, left_side=True, lower=True)
    u, w = sol[..., :dv], sol[..., dv:]
    attn = jnp.einsum('bhncd,bhnmd->bhncm', q, k) * decay
    qg = q * jnp.exp(gc)[..., None]
    g_last = gc[..., -1]
    kd = k * jnp.exp(g_last[..., None] - gc)[..., None]
    xs = tuple(jnp.moveaxis(t, 2, 0) for t in (u, w, qg, attn, kd, g_last))

    def step(state, xs_n):
        u_n, w_n, qg_n, attn_n, kd_n, gl_n = xs_n
        v_new = u_n - jnp.einsum('bhcd,bhde->bhce', w_n, state)
        o_n = jnp.einsum('bhcd,bhde->bhce', qg_n, state) + jnp.einsum('bhcm,bhme->bhce', attn_n, v_new)
        state = state * jnp.exp(gl_n)[..., None, None] + jnp.einsum('bhcd,bhce->bhde', kd_n, v_new)
        return state, o_n

    s0 = jnp.zeros((b, h, dk, dv), q.dtype)
    _, o = lax.scan(step, s0, xs)
    return o.transpose(1, 0, 3, 2, 4).reshape(b, s, h, dv)


def wkv7_scan(r, w, k, v, kk, a):
    b, s, h, nd = r.shape
    xs = tuple(jnp.swapaxes(t, 0, 1) for t in (r, w, k, v, kk, a))

    def step(state, xs_t):
        r_t, w_t, k_t, v_t, kk_t, a_t = xs_t
        sa = jnp.einsum('bhvk,bhk->bhv', state, -kk_t)
        state = (state * w_t[:, :, None, :] + sa[..., None] * (kk_t * a_t)[:, :, None, :]
                 + v_t[..., None] * k_t[:, :, None, :])
        return state, jnp.einsum('bhvk,bhk->bhv', state, r_t)

    s0 = jnp.zeros((b, h, nd, nd), r.dtype)
    _, y = lax.scan(step, s0, xs)
    return jnp.swapaxes(y, 0, 1)


def deltanet_group(p, conv_w, a_log, dt_bias, norm_w):
    p = p.astype(jnp.float32)
    b, s, _ = p.shape
    qkv, z, ga, gb = jnp.split(p, [3 * DN_WIDTH, 4 * DN_WIDTH, 4 * DN_WIDTH + DN_HEADS], axis=-1)
    qkv = jax.nn.silu(causal_depthwise_conv(qkv, conv_w))
    q, k, v = (t.reshape(b, s, DN_HEADS, DN_HEAD_DIM) for t in jnp.split(qkv, 3, axis=-1))
    q = l2norm(q)
    k = l2norm(k)
    beta = jax.nn.sigmoid(gb)
    g = -jnp.exp(a_log) * jax.nn.softplus(ga + dt_bias)
    o = chunked_gated_delta_rule(q, k, v, g, beta)
    o = rmsnorm(o, norm_w) * jax.nn.silu(z.reshape(b, s, DN_HEADS, DN_HEAD_DIM))
    return o.reshape(b, s, DN_WIDTH)


def rwkv7_group(p, mu, w0, w2, a0, a2, g2, k_k, k_a, r_k, ln_w, ln_b):
    p = p.astype(jnp.float32)
    b, s, _ = p.shape
    p = p + (token_shift(p) - p) * mu
    pr, pk, pv, pw, pa, pg = jnp.split(
        p, [RW_WIDTH, 2 * RW_WIDTH, 3 * RW_WIDTH, 3 * RW_WIDTH + RW_DECAY_LORA,
            3 * RW_WIDTH + RW_DECAY_LORA + RW_AAA_LORA], axis=-1)

    def heads(t):
        return t.reshape(b, s, RW_HEADS, RW_HEAD_DIM)

    log_w = -jax.nn.softplus(-(w0 + jnp.tanh(pw) @ w2)) - 0.5
    decay = jnp.exp(-jnp.exp(log_w))
    a = jax.nn.sigmoid(a0 + pa @ a2)
    gate = jax.nn.sigmoid(pg) @ g2
    kk = heads(pk * k_k)
    kk = kk / jnp.maximum(jnp.sqrt(jnp.sum(kk * kk, axis=-1, keepdims=True)), 1e-12)
    k = pk * (1.0 + (a - 1.0) * k_a)
    r_h, k_h, v_h = heads(pr), heads(k), heads(pv)
    y = wkv7_scan(r_h, heads(decay), k_h, v_h, kk, heads(a))
    mean = jnp.mean(y, axis=-1, keepdims=True)
    var = jnp.mean(jnp.square(y - mean), axis=-1, keepdims=True)
    y = ((y - mean) * lax.rsqrt(var + RW_GN_EPS)).reshape(b, s, RW_WIDTH) * ln_w + ln_b
    bonus = jnp.sum(r_h * k_h * r_k, axis=-1, keepdims=True) * v_h
    return (y + bonus.reshape(b, s, RW_WIDTH)) * gate


def memory_cross_attention(hn, mn, wq, wk, wv, wo):
    b, s, _ = hn.shape
    m = mn.shape[1]
    q = (hn @ wq).reshape(b, s, XA_HEADS, XA_HEAD_DIM)
    k = (mn @ wk).reshape(b, m, XA_HEADS, XA_HEAD_DIM)
    v = (mn @ wv).reshape(b, m, XA_HEADS, XA_HEAD_DIM)
    scores = jnp.einsum('bshd,bmhd->bhsm', q, k).astype(jnp.float32) * (XA_HEAD_DIM ** -0.5)
    probs = jax.nn.softmax(scores, axis=-1).astype(v.dtype)
    o = jnp.einsum('bhsm,bmhd->bshd', probs, v).reshape(b, s, XA_WIDTH)
    return o @ wo


def squared_relu_mlp(u, w1, w2):
    return jnp.square(jax.nn.relu(u @ w1)) @ w2


def setup_inputs(seed: int = 0) -> dict:
    key = jax.random.key(seed)
    ks = jax.random.split(key, 32)
    L = DEPTH
    D = D_MODEL

    def normal(i, shape, scale):
        return jax.random.normal(ks[i], shape, jnp.float32) * scale

    def uniform(i, shape, lo, hi):
        return jax.random.uniform(ks[i], shape, jnp.float32, lo, hi)

    dt = jnp.exp(uniform(6, (L, DN_HEADS), math.log(1e-3), math.log(1e-1)))
    return {
        'x': normal(0, (BATCH, SEQ, D), 1.0),
        'mem': normal(1, (BATCH, MEM_LEN, D), 1.0),
        'mix_norm_w': 1.0 + normal(2, (L, D), 0.02),
        'w_in': normal(3, (L, D, IN_COLS), D ** -0.5),
        'dn_conv_w': normal(4, (L, DN_CONV, 3 * DN_WIDTH), DN_CONV ** -0.5),
        'dn_a_log': jnp.log(uniform(5, (L, DN_HEADS), 1.0, 16.0)),
        'dn_dt_bias': dt + jnp.log(-jnp.expm1(-dt)),
        'dn_norm_w': 1.0 + normal(7, (L, DN_HEAD_DIM), 0.02),
        'rw_mu': uniform(8, (L, RW_COLS), 0.0, 1.0),
        'rw_w0': uniform(9, (L, RW_WIDTH), -6.0, 1.0),
        'rw_w2': normal(10, (L, RW_DECAY_LORA, RW_WIDTH), 0.1 * RW_DECAY_LORA ** -0.5),
        'rw_a0': normal(11, (L, RW_WIDTH), 0.1),
        'rw_a2': normal(12, (L, RW_AAA_LORA, RW_WIDTH), 0.1 * RW_AAA_LORA ** -0.5),
        'rw_g2': normal(13, (L, RW_GATE_LORA, RW_WIDTH), RW_GATE_LORA ** -0.5),
        'rw_k_k': 0.85 + normal(14, (L, RW_WIDTH), 0.02),
        'rw_k_a': 1.0 + normal(15, (L, RW_WIDTH), 0.02),
        'rw_r_k': normal(16, (L, RW_HEADS, RW_HEAD_DIM), 0.1),
        'rw_ln_w': 1.0 + normal(17, (L, RW_WIDTH), 0.02),
        'rw_ln_b': normal(18, (L, RW_WIDTH), 0.02),
        'w_out': normal(19, (L, D, D), D ** -0.5),
        'xa_norm_w': 1.0 + normal(20, (L, D), 0.02),
        'mem_norm_w': 1.0 + normal(21, (L, D), 0.02),
        'xa_wq': normal(22, (L, D, XA_WIDTH), D ** -0.5),
        'xa_wk': normal(23, (L, D, XA_WIDTH), D ** -0.5),
        'xa_wv': normal(24, (L, D, XA_WIDTH), D ** -0.5),
        'xa_wo': normal(25, (L, XA_WIDTH, D), XA_WIDTH ** -0.5),
        'ffn_norm_w': 1.0 + normal(26, (L, D), 0.02),
        'ffn_w1': normal(27, (L, D, FFN_HIDDEN), D ** -0.5),
        'ffn_w2': normal(28, (L, FFN_HIDDEN, D), FFN_HIDDEN ** -0.5),
        'final_norm_w': 1.0 + normal(29, (D,), 0.02),
    }


def reference(x, mem, mix_norm_w, w_in, dn_conv_w, dn_a_log, dn_dt_bias, dn_norm_w, rw_mu, rw_w0,
              rw_w2, rw_a0, rw_a2, rw_g2, rw_k_k, rw_k_a, rw_r_k, rw_ln_w, rw_ln_b, w_out,
              xa_norm_w, mem_norm_w, xa_wq, xa_wk, xa_wv, xa_wo, ffn_norm_w, ffn_w1, ffn_w2,
              final_norm_w):
    h = x
    for l in range(DEPTH):
        u = rmsnorm(h, mix_norm_w[l])
        p = u @ w_in[l]
        o_dn = deltanet_group(p[..., :DN_COLS], dn_conv_w[l], dn_a_log[l], dn_dt_bias[l], dn_norm_w[l])
        o_rw = rwkv7_group(p[..., DN_COLS:], rw_mu[l], rw_w0[l], rw_w2[l], rw_a0[l], rw_a2[l], rw_g2[l],
                           rw_k_k[l], rw_k_a[l], rw_r_k[l], rw_ln_w[l], rw_ln_b[l])
        h = h + jnp.concatenate([o_dn, o_rw], axis=-1).astype(h.dtype) @ w_out[l]
        h = h + memory_cross_attention(rmsnorm(h, xa_norm_w[l]), rmsnorm(mem, mem_norm_w[l]),
                                       xa_wq[l], xa_wk[l], xa_wv[l], xa_wo[l])
        h = h + squared_relu_mlp(rmsnorm(h, ffn_norm_w[l]), ffn_w1[l], ffn_w2[l])
    return rmsnorm(h, final_norm_w)
```

```cpp
#include <hip/hip_runtime.h>
#include <hip/hip_cooperative_groups.h>
#include <cstdio>
#include <cstdint>
namespace cg = cooperative_groups;
namespace pg8 {
#define PG8_LAS __attribute__((address_space(3)))
typedef unsigned short h16_t;
typedef _Float16 h16x8 __attribute__((ext_vector_type(8)));
typedef _Float16 h16x2 __attribute__((ext_vector_type(2)));
typedef float f32x4 __attribute__((ext_vector_type(4)));
typedef float f32x2 __attribute__((ext_vector_type(2)));
typedef unsigned u32x4 __attribute__((ext_vector_type(4)));
typedef unsigned u32x2 __attribute__((ext_vector_type(2)));
constexpr int BM = 256, BK = 64, HALF = 128, HTB = HALF * BK * 2  , STAGE_BYTES = 8 * HTB, NXCD = 8, WGM = 8;

__host__ __device__ __forceinline__ int lds_byte(int r, int c) { const int st = (r >> 4) * 2 + (c >> 5), rr = r & 15, cc = c & 31, ob = rr * 64 + cc * 2; return st * 1024 + (ob ^ (((ob >> 9) & 1) << 5)); }
__host__ __device__ __forceinline__ void stage_rc(int b, int& R, int& C) { const int st = b / 1024, sb = b % 1024, swz = sb ^ (((sb >> 9) & 1) << 5); R = (st >> 1) * 16 + swz / 64; C = (st & 1) * 32 + (swz % 64) / 2; }
__host__ __device__ __forceinline__ int perm32(int rho) { const int n = rho >> 4, i = rho & 15; return 8 * (i >> 2) + 4 * n + (i & 3); }

struct Unit { int pm, pn; };
struct Gemm { const h16_t* A; const h16_t* Bt; int K; };

struct StaticOrder {
    int nM, nN, nwg, G, c, eM, eN;
    __device__ void init(int nM_, int nN_, int G_, int c_, int eM_ = 0, int eN_ = 0) { nM = nM_; nN = nN_; nwg = nM * nN; G = G_; c = c_; eM = eM_; eN = eN_; }
    __device__ bool next(int i, Unit& u) const {
        const long L = (long)i * G + c;
        if (L >= nwg) { const int e = (int)(L - nwg); if (e >= eM * eN) return false; u.pm = nM + e / eN; u.pn = nN + e % eN; return true; }
        int wgid = (int)L; { const int q = nwg / NXCD, r = nwg % NXCD, xcd = wgid % NXCD, off = wgid / NXCD; wgid = (xcd < r ? xcd * (q + 1) : r * (q + 1) + (xcd - r) * q) + off; }
        const int nig = WGM * nN, gid = wgid / nig, fm = gid * WGM, gsz = (nM - fm) < WGM ? (nM - fm) : WGM;
        u.pm = fm + ((wgid % nig) % gsz); u.pn = (wgid % nig) / gsz; return true;
    }
};

__device__ __forceinline__ unsigned pkh(float lo, float hi) { f32x2 v = {lo, hi}; h16x2 h = __builtin_convertvector(v, h16x2); return __builtin_bit_cast(unsigned, h); }


template <int ACT> struct EpiF16 {
    static constexpr bool PERM = true;
    h16_t* O; int ldc; const float* rs; float eps; h16_t* O2; int ldc2; int splitM, splitN;
    __device__ __forceinline__ void operator()(const f32x4 (&acc)[2][2][4][2], const Unit& u, int wr, int wc, int fr, int fq) const {
        int pm = u.pm, pn = u.pn; h16_t* base = O; int ld = ldc;
        if (O2 && pm >= splitM) { pm -= splitM; pn -= splitN; base = O2; ld = ldc2; }
        const int row0 = pm * BM + wr * 64 + fr; const int col0 = pn * BM + wc * 32 + 8 * fq;
#pragma unroll
        for (int ai = 0; ai < 2; ++ai)
#pragma unroll
            for (int m = 0; m < 4; ++m) { const int row = row0 + ai * HALF + m * 16; h16_t* rowp = base + (size_t)row * ld + col0;
                float sc = 1.f; if (rs) sc = __builtin_amdgcn_rsqf(rs[row] * (1.0f / 2048.0f) + eps);
#pragma unroll
                for (int bj = 0; bj < 2; ++bj) { f32x4 v0 = acc[ai][bj][m][0] * sc, v1 = acc[ai][bj][m][1] * sc;
                    if (ACT == 1) { v0 = __builtin_elementwise_max(v0, (f32x4){0.f, 0.f, 0.f, 0.f}); v1 = __builtin_elementwise_max(v1, (f32x4){0.f, 0.f, 0.f, 0.f}); v0 = v0 * v0; v1 = v1 * v1; }
                    u32x4 w; w.x = pkh(v0[0], v0[1]); w.y = pkh(v0[2], v0[3]); w.z = pkh(v1[0], v1[1]); w.w = pkh(v1[2], v1[3]);
                    *(u32x4*)(rowp + bj * HALF) = w; } }
    }
};
struct EpiRes {
    static constexpr bool PERM = false;
    const float* base; float* out; h16_t* o16; float* ss; int ldc;
    __device__ __forceinline__ void operator()(const f32x4 (&acc)[2][2][4][2], const Unit& u, int wr, int wc, int fr, int fq) const {
        const int col0 = u.pn * BM + wc * 32 + 4 * fq;
#pragma unroll
        for (int ai = 0; ai < 2; ++ai)
#pragma unroll
            for (int m = 0; m < 4; ++m) { const int row = u.pm * BM + ai * HALF + wr * 64 + m * 16 + fr; const size_t off = (size_t)row * ldc + col0; float q = 0.f;
#pragma unroll
                for (int bj = 0; bj < 2; ++bj)
#pragma unroll
                    for (int n = 0; n < 2; ++n) { const f32x4 bs = *(const f32x4*)(base + off + bj * HALF + n * 16); const f32x4 o = bs + acc[ai][bj][m][n];
                        *(f32x4*)(out + off + bj * HALF + n * 16) = o; q += (o[0] * o[0] + o[1] * o[1]) + (o[2] * o[2] + o[3] * o[3]);
                        if (o16) { u32x2 w; w.x = pkh(o[0], o[1]); w.y = pkh(o[2], o[3]); *(u32x2*)(o16 + off + bj * HALF + n * 16) = w; } }
                q += __shfl_xor(q, 16); q += __shfl_xor(q, 32);
                if (fq == 0) atomicAdd(ss + row, q); }
    }
};

template <class Epi, class Sched>
__device__ __forceinline__ void gemm_phase(PG8_LAS unsigned char* lds, const Gemm g, const Sched& S, const Epi& E) {
    const int tid = threadIdx.x, wid = __builtin_amdgcn_readfirstlane(tid >> 6), lane = tid & 63, wr = wid >> 2, wc = wid & 3, fr = lane & 15, fq = lane >> 4;
    const int K = g.K, nt = K / BK;
    unsigned voffA[2], voffB[2];
#pragma unroll
    for (int i = 0; i < 2; ++i) { int R, C; stage_rc(tid * 16 + i * 8192, R, C); const int Rb = Epi::PERM ? ((R & ~31) + perm32(R & 31)) : R;
        voffA[i] = (unsigned)(R * K + C) * 2u; voffB[i] = (unsigned)(Rb * K + C) * 2u; }
    const size_t kstep = (size_t)(BK * 2);
    const size_t hstep = (size_t)HALF * K * 2;
    const size_t tstep = 2 * hstep;
    const unsigned ldsw = (unsigned)wid * 1024u;
    const int aoff = lds_byte(wr * 64 + fr, fq * 8), boff = lds_byte(wc * 32 + fr, fq * 8);
#define PG8_SA(b, h) (((b) * 2 + (h)) * HTB)
#define PG8_SB(b, h) ((4 + (b) * 2 + (h)) * HTB)
#define PG8_STAGE(bufoff, gbase, voff) do { _Pragma("unroll") for (int _i = 0; _i < 2; ++_i) \
        __builtin_amdgcn_global_load_lds((const unsigned*)((const char*)(gbase) + (voff)[_i]), (PG8_LAS unsigned*)(lds + (bufoff) + ldsw + _i * 8192), 16, 0, 0); } while (0)
#define PG8_LDA(dst, b, h) do { _Pragma("unroll") for (int m = 0; m < 4; ++m) _Pragma("unroll") for (int k = 0; k < 2; ++k) dst[m][k] = *(const PG8_LAS h16x8*)(lds + PG8_SA(b, h) + aoff + m * 2048 + k * 1024); } while (0)
#define PG8_LDB(dst, b, h) do { _Pragma("unroll") for (int n = 0; n < 2; ++n) _Pragma("unroll") for (int k = 0; k < 2; ++k) dst[n][k] = *(const PG8_LAS h16x8*)(lds + PG8_SB(b, h) + boff + n * 2048 + k * 1024); } while (0)
#define PG8_MMA(ai, bj, At, Bt) do { __builtin_amdgcn_s_setprio(1); _Pragma("unroll") for (int m = 0; m < 4; ++m) _Pragma("unroll") for (int n = 0; n < 2; ++n) _Pragma("unroll") for (int k = 0; k < 2; ++k) \
        acc[ai][bj][m][n] = __builtin_amdgcn_mfma_f32_16x16x32_f16(Bt[n][k], At[m][k], acc[ai][bj][m][n], 0, 0, 0); __builtin_amdgcn_s_setprio(0); } while (0)
#define PG8_WAIT_V(n) asm volatile("s_waitcnt vmcnt(" #n ")" ::: "memory")
#define PG8_WAIT_L(n) asm volatile("s_waitcnt lgkmcnt(" #n ")" ::: "memory")
#define PG8_BAR __builtin_amdgcn_s_barrier()
#define PG8_SCHED __builtin_amdgcn_sched_barrier(0)
    Unit cur, nxt; int ui = 0;
    if (!S.next(0, cur)) return;
    f32x4 acc[2][2][4][2];
#pragma unroll
    for (int a = 0; a < 2; ++a)
#pragma unroll
        for (int b = 0; b < 2; ++b)
#pragma unroll
            for (int m = 0; m < 4; ++m)
#pragma unroll
                for (int n = 0; n < 2; ++n) acc[a][b][m][n] = (f32x4){0.f, 0.f, 0.f, 0.f};
    h16x8 At[4][2], B0[2][2], B1[2][2];
    const char* cA = (const char*)g.A + (size_t)cur.pm * tstep; const char* cB = (const char*)g.Bt + (size_t)cur.pn * tstep;
    PG8_STAGE(PG8_SB(0, 0), cB, voffB); PG8_STAGE(PG8_SB(0, 1), cB + hstep, voffB); PG8_STAGE(PG8_SA(0, 0), cA, voffA); PG8_STAGE(PG8_SA(0, 1), cA + hstep, voffA);
    if (wr == 1) PG8_BAR;
    PG8_WAIT_V(2); PG8_BAR;
    PG8_STAGE(PG8_SB(1, 0), cB + kstep, voffB); PG8_STAGE(PG8_SA(1, 0), cA + kstep, voffA); PG8_STAGE(PG8_SB(1, 1), cB + hstep + kstep, voffB);
    PG8_WAIT_V(6); PG8_BAR;
    for (;;) {
        const bool has_next = S.next(ui + 1, nxt);
        const char* nA = has_next ? (const char*)g.A + (size_t)nxt.pm * tstep : cA; const char* nB = has_next ? (const char*)g.Bt + (size_t)nxt.pn * tstep : cB;
        for (int t = 0; t < nt; t += 2) {
            const bool last = (t == nt - 2);
            const char* a1 = cA + (size_t)(t + 1) * kstep;
            const char* a2 = last ? nA : cA + (size_t)(t + 2) * kstep; const char* b2 = last ? nB : cB + (size_t)(t + 2) * kstep;
            const char* a3 = a2 + kstep; const char* b3 = b2 + kstep;
            PG8_LDB(B0, 0, 0); PG8_LDB(B1, 0, 1); PG8_SCHED; PG8_LDA(At, 0, 0); PG8_STAGE(PG8_SA(1, 1), a1 + hstep, voffA);
            PG8_WAIT_V(8); PG8_WAIT_L(0); PG8_BAR; PG8_MMA(0, 0, At, B0); PG8_MMA(0, 1, At, B1); PG8_BAR; PG8_SCHED;
            PG8_LDA(At, 0, 1); PG8_STAGE(PG8_SB(0, 0), b2, voffB); PG8_STAGE(PG8_SB(0, 1), b2 + hstep, voffB); PG8_STAGE(PG8_SA(0, 0), a2, voffA);
            PG8_WAIT_V(8); PG8_WAIT_L(0); PG8_BAR; PG8_MMA(1, 0, At, B0); PG8_MMA(1, 1, At, B1); PG8_BAR; PG8_SCHED;
            PG8_LDB(B0, 1, 0); PG8_LDB(B1, 1, 1); PG8_SCHED; PG8_LDA(At, 1, 0); PG8_STAGE(PG8_SA(0, 1), a2 + hstep, voffA);
            PG8_WAIT_V(8); PG8_WAIT_L(0); PG8_BAR; PG8_MMA(0, 0, At, B0); PG8_MMA(0, 1, At, B1); PG8_BAR; PG8_SCHED;
            PG8_LDA(At, 1, 1); PG8_STAGE(PG8_SB(1, 0), b3, voffB); PG8_STAGE(PG8_SB(1, 1), b3 + hstep, voffB); PG8_STAGE(PG8_SA(1, 0), a3, voffA);
            PG8_WAIT_V(8); PG8_WAIT_L(0); PG8_BAR; PG8_MMA(1, 0, At, B0); PG8_MMA(1, 1, At, B1); PG8_BAR; PG8_SCHED;
        }
        if (wr == 0) PG8_BAR;
        E(acc, cur, wr, wc, fr, fq);
        if (!has_next) break;
#pragma unroll
        for (int a = 0; a < 2; ++a)
#pragma unroll
            for (int b = 0; b < 2; ++b)
#pragma unroll
                for (int m = 0; m < 4; ++m)
#pragma unroll
                    for (int n = 0; n < 2; ++n) acc[a][b][m][n] = (f32x4){0.f, 0.f, 0.f, 0.f};
        cur = nxt; cA = nA; cB = nB; ++ui;
        if (wr == 1) PG8_BAR;
    }
    PG8_WAIT_V(0);
    PG8_BAR;
#undef PG8_SA
#undef PG8_SB
#undef PG8_STAGE
#undef PG8_LDA
#undef PG8_LDB
#undef PG8_MMA
#undef PG8_WAIT_V
#undef PG8_WAIT_L
#undef PG8_BAR
#undef PG8_SCHED
}
}
constexpr int NWAVES = 8, NTHREADS = 512;
constexpr int DM = 2048, BATCH = 8, SEQ = 2048, MTOK = BATCH * SEQ, MEMLEN = 256, MMEM = BATCH * MEMLEN;
constexpr int INC = 7440, PW = 7680;
constexpr int RW0 = 4128;
constexpr int FF = 8192;
constexpr float RMS_EPS = 1e-6f;
constexpr size_t MiB = 1u << 20;
constexpr size_t WS_CTL = 0, CTL_ZERO_BYTES = 1 * MiB;
constexpr size_t CTL_SS1 = 65536, CTL_SS2 = 131072, CTL_SS3 = 196608;
constexpr size_t WS_WALL = 2 * MiB;
constexpr size_t WS_WOUT = 36 * MiB, WS_WQ = 44 * MiB, WS_WO = 46 * MiB, WS_W1 = 48 * MiB, WS_W2 = 80 * MiB;
constexpr size_t WS_LORA = 112 * MiB;
constexpr size_t WS_KV = 113 * MiB;
constexpr size_t WS_Q = 117 * MiB, WS_AO = 133 * MiB;
constexpr size_t WS_C = 150 * MiB;
constexpr size_t WS_P = WS_C;
constexpr size_t WS_OMIX = WS_C + 240 * MiB;
constexpr size_t WS_HID = WS_C;
constexpr size_t WS_H1 = WS_C;
constexpr size_t WS_H2 = WS_C + 256 * MiB;
constexpr size_t WS_END = WS_C + 320 * MiB;

constexpr int LDS_BYTES = 147456;

#define GAS __attribute__((address_space(1)))
#define LAS __attribute__((address_space(3)))
typedef unsigned short h16;
typedef float f32x4 __attribute__((ext_vector_type(4)));
typedef float f32x2 __attribute__((ext_vector_type(2)));
typedef unsigned v4u __attribute__((ext_vector_type(4)));
typedef unsigned v2u __attribute__((ext_vector_type(2)));
typedef _Float16 h16x8 __attribute__((ext_vector_type(8)));
typedef _Float16 h16x4 __attribute__((ext_vector_type(4)));
using pg8::pkh;
__device__ __forceinline__ float h2f(h16 v) { return (float)__builtin_bit_cast(_Float16, v); }
__device__ __forceinline__ h16 f2h(float v) { return __builtin_bit_cast(h16, (_Float16)v); }
__device__ __forceinline__ float sigmoidf_(float x) { return 1.0f / (1.0f + __expf(-x)); }
__device__ __forceinline__ float softplusf_(float x) { return x > 20.f ? x : log1pf(__expf(x)); }
__device__ __forceinline__ float dppf(float v, int ctrl);
template <int CTRL> __device__ __forceinline__ float dpp_(float v) { return __builtin_bit_cast(float, __builtin_amdgcn_update_dpp(0, __builtin_bit_cast(int, v), CTRL, 0xf, 0xf, true)); }
__device__ __forceinline__ float red8(float x) { x += dpp_<0xB1>(x); x += dpp_<0x4E>(x); x += dpp_<0x141>(x); return x; }
__device__ __forceinline__ float red16(float x) { x += __shfl_xor(x, 1); x += __shfl_xor(x, 2); x += __shfl_xor(x, 4); x += __shfl_xor(x, 8); return x; }
__device__ __forceinline__ float wave_sum(float v) {
#pragma unroll
    for (int o = 1; o < 64; o <<= 1) v += __shfl_xor(v, o);
    return v;
}

struct Args {
    const float* in[30]; float* out; unsigned char* ws; int ph_lo, ph_hi;
};
struct Frame {
    LAS unsigned char* lds; int tid, lane, wave, G, bid;
};

__device__ __forceinline__ void tr_item(const float* W, int N, int K, h16* WT, const float* kscale, LAS float* scr, int k0, int nsrc0, int nvalid, int ndst0, int lane) {
    const int j = lane & 31;
#pragma unroll 8
    for (int i = 0; i < 32; ++i) { const int kk = 2 * i + (lane >> 5); float v = 0.f; if (j < nvalid) { v = W[(size_t)(k0 + kk) * N + nsrc0 + j]; if (kscale) v *= kscale[k0 + kk]; } scr[kk * 33 + j] = v; }
    asm volatile("s_waitcnt lgkmcnt(0)" ::: "memory");
    const int c = lane & 7;
#pragma unroll
    for (int jj = 0; jj < 4; ++jj) { const int n = (lane >> 3) + 8 * jj; const LAS float* s = scr + (8 * c) * 33 + n;
        v4u o; o.x = pkh(s[0 * 33], s[1 * 33]); o.y = pkh(s[2 * 33], s[3 * 33]); o.z = pkh(s[4 * 33], s[5 * 33]); o.w = pkh(s[6 * 33], s[7 * 33]);
        *(GAS v4u*)(WT + (size_t)(ndst0 + n) * K + k0 + 8 * c) = o; }
    asm volatile("s_waitcnt lgkmcnt(0)" ::: "memory");
}
__device__ __forceinline__ void rms_row_to_f16(const float* xrow, const float* w, h16* orow, int lane) {
    const GAS f32x4* xr = (const GAS f32x4*)xrow + lane; const GAS f32x4* wr = (const GAS f32x4*)w + lane;
    f32x4 v[8]; float s = 0.f;
#pragma unroll
    for (int j = 0; j < 8; ++j) { v[j] = xr[64 * j]; s += (v[j].x * v[j].x + v[j].y * v[j].y) + (v[j].z * v[j].z + v[j].w * v[j].w); }
    const float rstd = __builtin_amdgcn_rsqf(wave_sum(s) * (1.f / DM) + RMS_EPS);
    GAS v2u* o8 = (GAS v2u*)orow + lane;
#pragma unroll
    for (int j = 0; j < 8; ++j) { const f32x4 ww = wr[64 * j]; v2u o; o.x = pkh(v[j].x * rstd * ww.x, v[j].y * rstd * ww.y); o.y = pkh(v[j].z * rstd * ww.z, v[j].w * rstd * ww.w); o8[64 * j] = o; }
}
__device__ __forceinline__ void p0_prologue(const Frame& F, const Args& a) {
    LAS float* scr = (LAS float*)(F.lds + F.wave * 16384);
    unsigned char* ws = a.ws;
    const int gw = F.bid * NWAVES + F.wave, NGW = F.G * NWAVES, lane = F.lane;
    constexpr int I_IN = 240 * 32, I_K = 16 * 32, I_V = 16 * 32, I_OUT = 64 * 32, I_Q = 16 * 32, I_O = 64 * 8, I_1 = 256 * 32, I_2 = 64 * 128, I_LW = 32, I_LA = 32, I_LG = 64;
    constexpr int NITEMS = I_IN + I_K + I_V + I_OUT + I_Q + I_O + I_1 + I_2 + I_LW + I_LA + I_LG;
    h16* wall = (h16*)(ws + WS_WALL);
    for (int it = gw; it < NITEMS; it += NGW) {
        int r = it;
        if (r < I_IN) { const int nb = r % 240, kb = r / 240; int ns, nv;
            if (nb < 128) { ns = 32 * nb; nv = 32; } else if (nb == 128) { ns = 4096; nv = 16; } else if (nb < 233) { ns = 4112 + 32 * (nb - 129); nv = 32; } else { ns = 0; nv = 0; }
            tr_item(a.in[3], INC, DM, wall, nullptr, scr, 64 * kb, ns, nv, 32 * nb, lane); continue; } r -= I_IN;
        if (r < I_K) { tr_item(a.in[23], 512, DM, wall, nullptr, scr, 64 * (r / 16), 32 * (r % 16), 32, 7680 + 32 * (r % 16), lane); continue; } r -= I_K;
        if (r < I_V) { tr_item(a.in[24], 512, DM, wall, nullptr, scr, 64 * (r / 16), 32 * (r % 16), 32, 8192 + 32 * (r % 16), lane); continue; } r -= I_V;
        if (r < I_OUT) { tr_item(a.in[19], DM, DM, (h16*)(ws + WS_WOUT), nullptr, scr, 64 * (r / 64), 32 * (r % 64), 32, 32 * (r % 64), lane); continue; } r -= I_OUT;
        if (r < I_Q) { tr_item(a.in[22], 512, DM, (h16*)(ws + WS_WQ), a.in[20], scr, 64 * (r / 16), 32 * (r % 16), 32, 32 * (r % 16), lane); continue; } r -= I_Q;
        if (r < I_O) { tr_item(a.in[25], DM, 512, (h16*)(ws + WS_WO), nullptr, scr, 64 * (r / 64), 32 * (r % 64), 32, 32 * (r % 64), lane); continue; } r -= I_O;
        if (r < I_1) { tr_item(a.in[27], FF, DM, (h16*)(ws + WS_W1), a.in[26], scr, 64 * (r / 256), 32 * (r % 256), 32, 32 * (r % 256), lane); continue; } r -= I_1;
        if (r < I_2) { tr_item(a.in[28], DM, FF, (h16*)(ws + WS_W2), nullptr, scr, 64 * (r / 64), 32 * (r % 64), 32, 32 * (r % 64), lane); continue; } r -= I_2;
        if (r < I_LW) { tr_item(a.in[10], 1024, 64, (h16*)(ws + WS_LORA), nullptr, scr, 0, 32 * r, 32, 32 * r, lane); continue; } r -= I_LW;
        if (r < I_LA) { tr_item(a.in[12], 1024, 64, (h16*)(ws + WS_LORA + 131072), nullptr, scr, 0, 32 * r, 32, 32 * r, lane); continue; } r -= I_LA;
        tr_item(a.in[13], 1024, 128, (h16*)(ws + WS_LORA + 262144), nullptr, scr, 64 * (r / 32), 32 * (r % 32), 32, 32 * (r % 32), lane);
    }
    h16* aall = (h16*)a.out;
    for (int m = gw; m < MTOK + MMEM; m += NGW) {
        if (m < MTOK) rms_row_to_f16(a.in[0] + (size_t)m * DM, a.in[2], aall + (size_t)m * DM, lane);
        else rms_row_to_f16(a.in[1] + (size_t)(m - MTOK) * DM, a.in[21], aall + (size_t)m * DM, lane);
    }
}
constexpr int DN_TB = 32;
constexpr int DNL_Q = 0, DNL_K = DNL_Q + DN_TB * 128 * 4, DNL_V = DNL_K + DN_TB * 128 * 4, DNL_SC = DNL_V + DN_TB * 64 * 4, DNL_O = DNL_SC + DN_TB * 16, DNL_END = DNL_O + DN_TB * 64 * 4;
__device__ __forceinline__ void dn_direct(const Frame& F, const Args& a, int unit) {
    const int bh = unit >> 1, half = unit & 1, b = bh >> 3, h = bh & 7;
    const int tid = F.tid, lane = F.lane, w = F.wave;
    LAS float* qL = (LAS float*)(F.lds + DNL_Q); LAS float* kL = (LAS float*)(F.lds + DNL_K); LAS float* vL = (LAS float*)(F.lds + DNL_V);
    LAS float* scL = (LAS float*)(F.lds + DNL_SC); LAS float* oL = (LAS float*)(F.lds + DNL_O);
    const h16* P = (const h16*)(a.ws + WS_P);
    float* oraw = a.out;
    const bool is_col = tid < 320, is_g = (tid >= 320 && tid < 352);
    int pcol = 0; float cw0 = 0.f, cw1 = 0.f, cw2 = 0.f, cw3 = 0.f;
    if (is_col) { pcol = tid < 128 ? h * 128 + tid : (tid < 256 ? 1024 + h * 128 + (tid - 128) : 2048 + h * 128 + 64 * half + (tid - 256));
        const float* cw = a.in[4]; cw0 = cw[pcol]; cw1 = cw[3072 + pcol]; cw2 = cw[2 * 3072 + pcol]; cw3 = cw[3 * 3072 + pcol]; }
    const float neg_ea = -__expf(a.in[5][h]), dtb = a.in[6][h];
    const size_t row0 = (size_t)b * SEQ;
    h16 raw[DN_TB + 3]; h16 rg0 = 0, rg1 = 0;
    float S[16];
#pragma unroll
    for (int i = 0; i < 16; ++i) S[i] = 0.f;
    const int seg = lane & 7, c = 8 * w + (lane >> 3);
    auto load_raw = [&](int t0) {
        if (is_col) {
#pragma unroll
            for (int i = 0; i < DN_TB + 3; ++i) { const int t = t0 - 3 + i; raw[i] = (t >= 0) ? P[(row0 + t) * PW + pcol] : (h16)0; }
        } else if (is_g) { const int t = t0 + (tid - 320); rg0 = P[(row0 + t) * PW + 4096 + h]; rg1 = P[(row0 + t) * PW + 4104 + h]; }
    };
    auto prep = [&]() {
        if (is_col) {
            LAS float* dst = tid < 128 ? qL + tid : (tid < 256 ? kL + (tid - 128) : vL + (tid - 256)); const int pitch = tid < 256 ? 128 : 64;
#pragma unroll
            for (int t = 0; t < DN_TB; ++t) { float y = cw0 * h2f(raw[t]) + cw1 * h2f(raw[t + 1]) + cw2 * h2f(raw[t + 2]) + cw3 * h2f(raw[t + 3]); y = y * sigmoidf_(y); dst[t * pitch] = y; }
        } else if (is_g) { const int t = tid - 320; const float g = neg_ea * softplusf_(h2f(rg0) + dtb); scL[t * 4 + 0] = __expf(g); scL[t * 4 + 1] = sigmoidf_(h2f(rg1)); }
        __syncthreads();
        { const int t = tid >> 4, part = tid & 15; LAS float* qp = qL + t * 128 + part * 8; LAS float* kp = kL + t * 128 + part * 8;
            f32x4 q0 = *(LAS f32x4*)qp, q1 = *(LAS f32x4*)(qp + 4), k0 = *(LAS f32x4*)kp, k1 = *(LAS f32x4*)(kp + 4);
            float sq = (q0.x * q0.x + q0.y * q0.y) + (q0.z * q0.z + q0.w * q0.w) + (q1.x * q1.x + q1.y * q1.y) + (q1.z * q1.z + q1.w * q1.w);
            float sk = (k0.x * k0.x + k0.y * k0.y) + (k0.z * k0.z + k0.w * k0.w) + (k1.x * k1.x + k1.y * k1.y) + (k1.z * k1.z + k1.w * k1.w);
            float dq = (q0.x * k0.x + q0.y * k0.y) + (q0.z * k0.z + q0.w * k0.w) + (q1.x * k1.x + q1.y * k1.y) + (q1.z * k1.z + q1.w * k1.w);
            sq = red16(sq); sk = red16(sk); dq = red16(dq);
            const float rq = __builtin_amdgcn_rsqf(sq + 1e-6f) * 0.08838834764831845f, rk = __builtin_amdgcn_rsqf(sk + 1e-6f);
            *(LAS f32x4*)qp = q0 * rq; *(LAS f32x4*)(qp + 4) = q1 * rq; *(LAS f32x4*)kp = k0 * rk; *(LAS f32x4*)(kp + 4) = k1 * rk;
            if (part == 0) scL[t * 4 + 2] = dq * rq * rk; }
        __syncthreads();
    };
    load_raw(0); prep();
    for (int bt = 0; bt < SEQ / DN_TB; ++bt) {
        const int t0 = bt * DN_TB;
        if (bt + 1 < SEQ / DN_TB) load_raw(t0 + DN_TB);
        for (int t = 0; t < DN_TB; ++t) {
            const LAS f32x4* kp = (const LAS f32x4*)(kL + t * 128 + 16 * seg); const LAS f32x4* qp = (const LAS f32x4*)(qL + t * 128 + 16 * seg);
            const f32x4 ka = kp[0], kb = kp[1], kc = kp[2], kd = kp[3], qa = qp[0], qb = qp[1], qc = qp[2], qd = qp[3];
            const f32x4 sc = *(const LAS f32x4*)(scL + t * 4); const float vc = vL[t * 64 + c];
            const float kk[16] = {ka.x, ka.y, ka.z, ka.w, kb.x, kb.y, kb.z, kb.w, kc.x, kc.y, kc.z, kc.w, kd.x, kd.y, kd.z, kd.w};
            const float qq[16] = {qa.x, qa.y, qa.z, qa.w, qb.x, qb.y, qb.z, qb.w, qc.x, qc.y, qc.z, qc.w, qd.x, qd.y, qd.z, qd.w};
            float pk0 = 0.f, pk1 = 0.f, pq0 = 0.f, pq1 = 0.f;
#pragma unroll
            for (int i = 0; i < 16; i += 2) { pk0 += kk[i] * S[i]; pk1 += kk[i + 1] * S[i + 1]; pq0 += qq[i] * S[i]; pq1 += qq[i + 1] * S[i + 1]; }
            const float kS = red8(pk0 + pk1), qS = red8(pq0 + pq1);
            const float eg = sc.x, delta = sc.y * (vc - eg * kS), o = eg * qS + delta * sc.z;
#pragma unroll
            for (int i = 0; i < 16; ++i) S[i] = eg * S[i] + kk[i] * delta;
            if (seg == 0) oL[t * 64 + c] = o;
        }
        __syncthreads();
        { const int t = tid >> 4, part = tid & 15; const f32x4 v = *(const LAS f32x4*)(oL + t * 64 + part * 4);
            *(GAS f32x4*)(oraw + (row0 + t0 + t) * 1024 + h * 128 + 64 * half + part * 4) = v; }
        if (bt + 1 < SEQ / DN_TB) prep();
        else __syncthreads();
    }
}
constexpr int RW_TB = 32;
constexpr int RWL_R = 0, RWL_W = RWL_R + RW_TB * 64 * 4, RWL_K = RWL_W + RW_TB * 64 * 4, RWL_KK = RWL_K + RW_TB * 64 * 4, RWL_B = RWL_KK + RW_TB * 64 * 4, RWL_V = RWL_B + RW_TB * 64 * 4,
              RWL_G = RWL_V + RW_TB * 64 * 4, RWL_Y = RWL_G + RW_TB * 64 * 4, RWL_A = RWL_Y + RW_TB * 64 * 4, RWL_BON = RWL_A + RW_TB * 64 * 4,
              RWL_HW = RWL_BON + RW_TB * 4, RWL_HA = RWL_HW + RW_TB * 72 * 2, RWL_HG = RWL_HA + RW_TB * 72 * 2, RWL_END = RWL_HG + RW_TB * 136 * 2;
__device__ __forceinline__ void rw_direct(const Frame& F, const Args& a, int unit) {
    const int b = unit >> 4, h = unit & 15;
    const int tid = F.tid, lane = F.lane, w = F.wave;
    LAS float* rL = (LAS float*)(F.lds + RWL_R); LAS float* wL = (LAS float*)(F.lds + RWL_W); LAS float* kL = (LAS float*)(F.lds + RWL_K); LAS float* kkL = (LAS float*)(F.lds + RWL_KK);
    LAS float* bL = (LAS float*)(F.lds + RWL_B); LAS float* vL = (LAS float*)(F.lds + RWL_V); LAS float* gL = (LAS float*)(F.lds + RWL_G); LAS float* yL = (LAS float*)(F.lds + RWL_Y);
    LAS float* aL = (LAS float*)(F.lds + RWL_A); LAS float* bonL = (LAS float*)(F.lds + RWL_BON);
    LAS h16* hW = (LAS h16*)(F.lds + RWL_HW); LAS h16* hA = (LAS h16*)(F.lds + RWL_HA); LAS h16* hG = (LAS h16*)(F.lds + RWL_HG);
    const h16* P = (const h16*)(a.ws + WS_P);
    h16* omix = (h16*)(a.ws + WS_OMIX);
    const size_t row0 = (size_t)b * SEQ;
    const bool is_col = tid < 448;
    int rcol = 0; float mu = 0.f;
    if (is_col) { rcol = tid < 192 ? (tid >> 6) * 1024 + h * 64 + (tid & 63) : 3072 + (tid - 192); mu = a.in[8][rcol]; }
    h16 raw[RW_TB + 1];
    const int fpart = tid & 15, ft = tid >> 4, hc0 = h * 64 + 4 * fpart;
    const f32x4 c_kk = *(const f32x4*)(a.in[14] + hc0), c_ka = *(const f32x4*)(a.in[15] + hc0), c_rk = *(const f32x4*)(a.in[16] + hc0), c_lnw = *(const f32x4*)(a.in[17] + hc0), c_lnb = *(const f32x4*)(a.in[18] + hc0);
    const int mt = w & 1, nt = w >> 1, l15 = lane & 15, lg = lane >> 4;
    const h16* w2T = (const h16*)(a.ws + WS_LORA) + (size_t)(h * 64 + 16 * nt + l15) * 64 + 8 * lg;
    const h16* a2T = (const h16*)(a.ws + WS_LORA + 131072) + (size_t)(h * 64 + 16 * nt + l15) * 64 + 8 * lg;
    const h16* g2T = (const h16*)(a.ws + WS_LORA + 262144) + (size_t)(h * 64 + 16 * nt + l15) * 128 + 8 * lg;
    const float c_w0 = a.in[9][h * 64 + 16 * nt + l15], c_a0 = a.in[11][h * 64 + 16 * nt + l15];
    float S[8];
#pragma unroll
    for (int i = 0; i < 8; ++i) S[i] = 0.f;
    const int seg = lane & 7, vrow = 8 * w + (lane >> 3);
#define RW_LOAD_RAW(t0_) do { if (is_col) { _Pragma("unroll") for (int i = 0; i < RW_TB + 1; ++i) { const int t = (t0_) - 1 + i; raw[i] = (t >= 0) ? P[(row0 + t) * PW + RW0 + rcol] : (h16)0; } } } while (0)
#define RW_PREP() do { \
        if (is_col) { \
            _Pragma("unroll") for (int t = 0; t < RW_TB; ++t) { const float x = h2f(raw[t + 1]), xp = h2f(raw[t]); const float y = x + (xp - x) * mu; \
                if (tid < 64) rL[t * 64 + tid] = y; else if (tid < 128) kL[t * 64 + tid - 64] = y; else if (tid < 192) vL[t * 64 + tid - 128] = y; \
                else if (tid < 256) hW[t * 72 + tid - 192] = f2h(tanhf(y)); else if (tid < 320) hA[t * 72 + tid - 256] = f2h(y); else hG[t * 136 + tid - 320] = f2h(sigmoidf_(y)); } \
        } \
        __syncthreads(); \
        {   \
            pg8::f32x4 accw = {0.f, 0.f, 0.f, 0.f}, acca = accw, accg = accw; \
            _Pragma("unroll") for (int ks = 0; ks < 2; ++ks) { \
                const h16x8 fa = *(const LAS h16x8*)(hW + (16 * mt + l15) * 72 + 32 * ks + 8 * lg); const h16x8 fb = *(const GAS h16x8*)(w2T + 32 * ks); \
                accw = __builtin_amdgcn_mfma_f32_16x16x32_f16(fa, fb, accw, 0, 0, 0); \
                const h16x8 fa2 = *(const LAS h16x8*)(hA + (16 * mt + l15) * 72 + 32 * ks + 8 * lg); const h16x8 fb2 = *(const GAS h16x8*)(a2T + 32 * ks); \
                acca = __builtin_amdgcn_mfma_f32_16x16x32_f16(fa2, fb2, acca, 0, 0, 0); } \
            _Pragma("unroll") for (int ks = 0; ks < 4; ++ks) { \
                const h16x8 fa = *(const LAS h16x8*)(hG + (16 * mt + l15) * 136 + 32 * ks + 8 * lg); const h16x8 fb = *(const GAS h16x8*)(g2T + 32 * ks); \
                accg = __builtin_amdgcn_mfma_f32_16x16x32_f16(fa, fb, accg, 0, 0, 0); } \
            _Pragma("unroll") for (int r = 0; r < 4; ++r) { const int tok = 16 * mt + 4 * lg + r, n = 16 * nt + l15; \
                const float lw = -softplusf_(-(c_w0 + accw[r])) - 0.5f; wL[tok * 64 + n] = __expf(-__expf(lw)); \
                aL[tok * 64 + n] = sigmoidf_(c_a0 + acca[r]); gL[tok * 64 + n] = accg[r]; } \
        } \
        __syncthreads(); \
        { const int o = ft * 64 + 4 * fpart; const f32x4 pk = *(const LAS f32x4*)(kL + o), av = *(const LAS f32x4*)(aL + o), rv = *(const LAS f32x4*)(rL + o); \
            f32x4 kk = pk * c_kk; float ss = red16((kk.x * kk.x + kk.y * kk.y) + (kk.z * kk.z + kk.w * kk.w)); \
            const float inv = 1.0f / fmaxf(sqrtf(ss), 1e-12f); kk = kk * inv; \
            const f32x4 kf = pk * (1.0f + (av - 1.0f) * c_ka); \
            *(LAS f32x4*)(kkL + o) = kk; *(LAS f32x4*)(bL + o) = kk * av; *(LAS f32x4*)(kL + o) = kf; \
            const f32x4 rb = rv * kf * c_rk; const float bon = red16((rb.x + rb.y) + (rb.z + rb.w)); if (fpart == 0) bonL[ft] = bon; } \
        __syncthreads(); \
    } while (0)
    RW_LOAD_RAW(0); RW_PREP();
    for (int bt = 0; bt < SEQ / RW_TB; ++bt) {
        const int t0 = bt * RW_TB;
        if (bt + 1 < SEQ / RW_TB) RW_LOAD_RAW(t0 + RW_TB);
        for (int t = 0; t < RW_TB; ++t) {
            const int o = t * 64 + 8 * seg;
            const f32x4 k0 = *(const LAS f32x4*)(kkL + o), k1 = *(const LAS f32x4*)(kkL + o + 4), w0 = *(const LAS f32x4*)(wL + o), w1 = *(const LAS f32x4*)(wL + o + 4);
            const f32x4 b0 = *(const LAS f32x4*)(bL + o), b1 = *(const LAS f32x4*)(bL + o + 4), x0 = *(const LAS f32x4*)(kL + o), x1 = *(const LAS f32x4*)(kL + o + 4);
            const f32x4 r0 = *(const LAS f32x4*)(rL + o), r1 = *(const LAS f32x4*)(rL + o + 4); const float vv = vL[t * 64 + vrow];
            const float kkv[8] = {k0.x, k0.y, k0.z, k0.w, k1.x, k1.y, k1.z, k1.w}, wv[8] = {w0.x, w0.y, w0.z, w0.w, w1.x, w1.y, w1.z, w1.w}, bv[8] = {b0.x, b0.y, b0.z, b0.w, b1.x, b1.y, b1.z, b1.w};
            const float xv[8] = {x0.x, x0.y, x0.z, x0.w, x1.x, x1.y, x1.z, x1.w}, rv[8] = {r0.x, r0.y, r0.z, r0.w, r1.x, r1.y, r1.z, r1.w};
            float p0 = 0.f, p1 = 0.f;
#pragma unroll
            for (int i = 0; i < 8; i += 2) { p0 += S[i] * kkv[i]; p1 += S[i + 1] * kkv[i + 1]; }
            const float sa = -red8(p0 + p1);
            float y0 = 0.f, y1 = 0.f;
#pragma unroll
            for (int i = 0; i < 8; i += 2) { S[i] = S[i] * wv[i] + sa * bv[i] + vv * xv[i]; S[i + 1] = S[i + 1] * wv[i + 1] + sa * bv[i + 1] + vv * xv[i + 1]; y0 += S[i] * rv[i]; y1 += S[i + 1] * rv[i + 1]; }
            const float y = red8(y0 + y1);
            if (seg == 0) yL[t * 64 + vrow] = y;
        }
        __syncthreads();
        {
            const int o = ft * 64 + 4 * fpart; const f32x4 y = *(const LAS f32x4*)(yL + o), vv4 = *(const LAS f32x4*)(vL + o), g4 = *(const LAS f32x4*)(gL + o);
            const float mean = red16((y.x + y.y) + (y.z + y.w)) * (1.0f / 64.0f); const f32x4 d = y - mean;
            const float var = red16((d.x * d.x + d.y * d.y) + (d.z * d.z + d.w * d.w)) * (1.0f / 64.0f); const float rstd = __builtin_amdgcn_rsqf(var + 64e-5f);
            const f32x4 res = (d * rstd * c_lnw + c_lnb + vv4 * bonL[ft]) * g4;
            v2u pk2; pk2.x = pkh(res.x, res.y); pk2.y = pkh(res.z, res.w);
            *(GAS v2u*)(omix + (row0 + t0 + ft) * DM + 1024 + h * 64 + 4 * fpart) = pk2; }
        __syncthreads();
        if (bt + 1 < SEQ / RW_TB) RW_PREP();
    }
#undef RW_LOAD_RAW
#undef RW_PREP
}
__device__ __forceinline__ void dn_norm_gate(const Frame& F, const Args& a) {
    const int gw = F.bid * NWAVES + F.wave, NGW = F.G * NWAVES, lane = F.lane;
    const float* oraw = a.out; const h16* P = (const h16*)(a.ws + WS_P); h16* omix = (h16*)(a.ws + WS_OMIX);
    const int cn = (lane & 7) * 16;
    f32x4 nw[4];
#pragma unroll
    for (int j = 0; j < 4; ++j) nw[j] = *(const f32x4*)(a.in[7] + cn + 4 * j);
    for (int m = gw; m < MTOK; m += NGW) {
        const GAS f32x4* op = (const GAS f32x4*)(oraw + (size_t)m * 1024 + lane * 16);
        f32x4 v[4]; float s = 0.f;
#pragma unroll
        for (int j = 0; j < 4; ++j) { v[j] = op[j]; s += (v[j].x * v[j].x + v[j].y * v[j].y) + (v[j].z * v[j].z + v[j].w * v[j].w); }
        s = red8(s);
        const float rstd = __builtin_amdgcn_rsqf(s * (1.0f / 128.0f) + RMS_EPS);
        const GAS v4u* zp = (const GAS v4u*)(P + (size_t)m * PW + 3072 + lane * 16);
        const v4u z0 = zp[0], z1 = zp[1]; const unsigned zz[8] = {z0.x, z0.y, z0.z, z0.w, z1.x, z1.y, z1.z, z1.w};
        unsigned ow[8];
#pragma unroll
        for (int j = 0; j < 4; ++j) {
            const float za = h2f((h16)(zz[2 * j] & 0xffff)), zb = h2f((h16)(zz[2 * j] >> 16)), zc = h2f((h16)(zz[2 * j + 1] & 0xffff)), zd = h2f((h16)(zz[2 * j + 1] >> 16));
            const f32x4 o = v[j] * rstd * nw[j];
            ow[2 * j] = pkh(o.x * za * sigmoidf_(za), o.y * zb * sigmoidf_(zb)); ow[2 * j + 1] = pkh(o.z * zc * sigmoidf_(zc), o.w * zd * sigmoidf_(zd)); }
        GAS v4u* dst = (GAS v4u*)(omix + (size_t)m * DM + lane * 16);
        dst[0] = (v4u){ow[0], ow[1], ow[2], ow[3]}; dst[1] = (v4u){ow[4], ow[5], ow[6], ow[7]};
    }
}

constexpr int XA_KP = 136, XA_VP = 264;
constexpr int XAL_K = 0, XAL_V = XAL_K + 256 * XA_KP * 2, XAL_END = XAL_V + 128 * XA_VP * 2;
__device__ __forceinline__ void xattn_phase(const Frame& F, const Args& a) {
    const int tid = F.tid, lane = F.lane, w = F.wave, l15 = lane & 15, lg = lane >> 4;
    LAS h16* KL = (LAS h16*)(F.lds + XAL_K); LAS h16* VT = (LAS h16*)(F.lds + XAL_V);
    const h16* KV = (const h16*)(a.ws + WS_KV); const h16* Q = (const h16*)(a.ws + WS_Q); h16* AO = (h16*)(a.ws + WS_AO);
    for (int pair = F.bid; pair < 256; pair += F.G) {
        const int bhd = pair >> 3, b = bhd >> 2, hd = bhd & 3;
        __syncthreads();
#pragma unroll
        for (int i = 0; i < 8; ++i) { const int id = tid + 512 * i, mem = id & 255, dc = id >> 8;
            const v4u kv = *(const GAS v4u*)(KV + (size_t)(b * 256 + mem) * 1024 + hd * 128 + dc * 8);
            *(LAS v4u*)(KL + mem * XA_KP + dc * 8) = kv;
            const v4u vv = *(const GAS v4u*)(KV + (size_t)(b * 256 + mem) * 1024 + 512 + hd * 128 + dc * 8);
            const unsigned vw[4] = {vv.x, vv.y, vv.z, vv.w};
#pragma unroll
            for (int e = 0; e < 4; ++e) { VT[(dc * 8 + 2 * e) * XA_VP + mem] = (h16)(vw[e] & 0xffff); VT[(dc * 8 + 2 * e + 1) * XA_VP + mem] = (h16)(vw[e] >> 16); } }
        __syncthreads();
        for (int qi = 0; qi < 2; ++qi) {
            const int qb = (pair & 7) * 2 + qi; const size_t tok = (size_t)b * SEQ + qb * 128 + 16 * w + l15;
            h16x8 qf[4];
#pragma unroll
            for (int ks = 0; ks < 4; ++ks) qf[ks] = *(const GAS h16x8*)(Q + tok * 512 + hd * 128 + 32 * ks + 8 * lg);
            pg8::f32x4 s[16];
#pragma unroll
            for (int mt = 0; mt < 16; ++mt) { s[mt] = (pg8::f32x4){0.f, 0.f, 0.f, 0.f};
#pragma unroll
                for (int ks = 0; ks < 4; ++ks) { const h16x8 kf = *(const LAS h16x8*)(KL + (16 * mt + l15) * XA_KP + 32 * ks + 8 * lg); s[mt] = __builtin_amdgcn_mfma_f32_16x16x32_f16(kf, qf[ks], s[mt], 0, 0, 0); }
                if (mt & 1) __builtin_amdgcn_sched_barrier(0); }
            float mx = -3.0e38f;
#pragma unroll
            for (int mt = 0; mt < 16; ++mt) mx = fmaxf(fmaxf(fmaxf(mx, s[mt][0]), fmaxf(s[mt][1], s[mt][2])), s[mt][3]);
            mx = fmaxf(mx, __shfl_xor(mx, 16)); mx = fmaxf(mx, __shfl_xor(mx, 32));
            const float sc = 0.08838834764831845f * 1.4426950408889634f; float sum = 0.f;
#pragma unroll
            for (int mt = 0; mt < 16; ++mt)
#pragma unroll
                for (int r = 0; r < 4; ++r) { const float p = __builtin_amdgcn_exp2f((s[mt][r] - mx) * sc); s[mt][r] = p; sum += p; }
            sum += __shfl_xor(sum, 16); sum += __shfl_xor(sum, 32);
            const float inv = 1.0f / sum;
            h16x8 pf[8];
#pragma unroll
            for (int ss = 0; ss < 8; ++ss) { v4u t; t.x = pkh(s[2 * ss][0] * inv, s[2 * ss][1] * inv); t.y = pkh(s[2 * ss][2] * inv, s[2 * ss][3] * inv); t.z = pkh(s[2 * ss + 1][0] * inv, s[2 * ss + 1][1] * inv); t.w = pkh(s[2 * ss + 1][2] * inv, s[2 * ss + 1][3] * inv);
                pf[ss] = __builtin_bit_cast(h16x8, t); }
#pragma unroll
            for (int dt = 0; dt < 8; ++dt) { pg8::f32x4 o = {0.f, 0.f, 0.f, 0.f};
#pragma unroll
                for (int ss = 0; ss < 8; ++ss) { const LAS h16* vp = VT + (16 * dt + l15) * XA_VP + 32 * ss + 4 * lg;
                    const v2u lo = *(const LAS v2u*)vp, hi = *(const LAS v2u*)(vp + 16); const v4u t = {lo.x, lo.y, hi.x, hi.y};
                    o = __builtin_amdgcn_mfma_f32_16x16x32_f16(__builtin_bit_cast(h16x8, t), pf[ss], o, 0, 0, 0); }
                v2u ow; ow.x = pkh(o[0], o[1]); ow.y = pkh(o[2], o[3]);
                *(GAS v2u*)(AO + tok * 512 + hd * 128 + 16 * dt + 4 * lg) = ow; __builtin_amdgcn_sched_barrier(0); }
        }
    }
}

__device__ __forceinline__ void final_norm(const Frame& F, const Args& a) {
    const int gw = F.bid * NWAVES + F.wave, NGW = F.G * NWAVES, lane = F.lane;
    const float* ss = (const float*)(a.ws + WS_CTL + CTL_SS3); const GAS f32x4* wr = (const GAS f32x4*)a.in[29] + lane;
    for (int m = gw; m < MTOK; m += NGW) {
        const float rstd = __builtin_amdgcn_rsqf(__hip_atomic_load(ss + m, __ATOMIC_RELAXED, __HIP_MEMORY_SCOPE_AGENT) * (1.0f / DM) + RMS_EPS);
        GAS f32x4* xr = (GAS f32x4*)(a.out + (size_t)m * DM) + lane;
#pragma unroll
        for (int j = 0; j < 8; ++j) { const f32x4 v = xr[64 * j]; xr[64 * j] = v * rstd * wr[64 * j]; }
    }
}
constexpr int N_PHASES = 11;
#ifndef MK_ONE_LAUNCH
#define MK_ONE_LAUNCH 0
#endif
__global__ void __launch_bounds__(NTHREADS, 2) fwd_kernel(Args args) {
    extern __shared__ __attribute__((aligned(16))) unsigned char lds[];
    Frame F; F.lds = (LAS unsigned char*)lds; F.tid = threadIdx.x; F.lane = F.tid & 63; F.wave = __builtin_amdgcn_readfirstlane(F.tid >> 6); F.G = gridDim.x; F.bid = blockIdx.x;
    unsigned char* ws = args.ws;
    const int lo = args.ph_lo, hi = args.ph_hi;
#define IN(k) (lo <= (k) && (k) < hi)
#if MK_ONE_LAUNCH
#define SEAM(k) do { if (IN(k) && IN((k) + 1)) { cg::this_grid().sync(); } } while (0)
#else
#define SEAM(k) do { } while (0)
#endif
    float* ss1 = (float*)(ws + WS_CTL + CTL_SS1); float* ss2 = (float*)(ws + WS_CTL + CTL_SS2); float* ss3 = (float*)(ws + WS_CTL + CTL_SS3);
    if (IN(0)) { p0_prologue(F, args); } SEAM(0);
    if (IN(1)) { pg8::Gemm g{(const pg8::h16_t*)args.out, (const pg8::h16_t*)(ws + WS_WALL), DM}; pg8::StaticOrder S; S.init(64, 30, F.G, F.bid, 8, 4);
        pg8::EpiF16<0> E{(pg8::h16_t*)(ws + WS_P), PW, nullptr, 0.f, (pg8::h16_t*)(ws + WS_KV), 1024, 64, 30};
        pg8::gemm_phase(F.lds, g, S, E); } SEAM(1);
    if (IN(2)) { for (int u = F.bid; u < 256; u += F.G) { if (u < 128) dn_direct(F, args, u); else rw_direct(F, args, u - 128); } } SEAM(2);
    if (IN(3)) { dn_norm_gate(F, args); } SEAM(3);
    if (IN(4)) { pg8::Gemm g{(const pg8::h16_t*)(ws + WS_OMIX), (const pg8::h16_t*)(ws + WS_WOUT), DM}; pg8::StaticOrder S; S.init(64, 8, F.G, F.bid);
        pg8::EpiRes E{args.in[0], args.out, (pg8::h16_t*)(ws + WS_H1), ss1, DM};
        pg8::gemm_phase(F.lds, g, S, E); } SEAM(4);
    if (IN(5)) { pg8::Gemm g{(const pg8::h16_t*)(ws + WS_H1), (const pg8::h16_t*)(ws + WS_WQ), DM}; pg8::StaticOrder S; S.init(64, 2, F.G, F.bid);
        pg8::EpiF16<0> E{(pg8::h16_t*)(ws + WS_Q), 512, ss1, RMS_EPS, nullptr, 0, 0, 0};
        pg8::gemm_phase(F.lds, g, S, E); } SEAM(5);
    if (IN(6)) { xattn_phase(F, args); } SEAM(6);
    if (IN(7)) { pg8::Gemm g{(const pg8::h16_t*)(ws + WS_AO), (const pg8::h16_t*)(ws + WS_WO), 512}; pg8::StaticOrder S; S.init(64, 8, F.G, F.bid);
        pg8::EpiRes E{args.out, args.out, (pg8::h16_t*)(ws + WS_H2), ss2, DM};
        pg8::gemm_phase(F.lds, g, S, E); } SEAM(7);
    if (IN(8)) { pg8::Gemm g{(const pg8::h16_t*)(ws + WS_H2), (const pg8::h16_t*)(ws + WS_W1), DM}; pg8::StaticOrder S; S.init(64, 32, F.G, F.bid);
        pg8::EpiF16<1> E{(pg8::h16_t*)(ws + WS_HID), FF, ss2, RMS_EPS, nullptr, 0, 0, 0};
        pg8::gemm_phase(F.lds, g, S, E); } SEAM(8);
    if (IN(9)) { pg8::Gemm g{(const pg8::h16_t*)(ws + WS_HID), (const pg8::h16_t*)(ws + WS_W2), FF}; pg8::StaticOrder S; S.init(64, 8, F.G, F.bid);
        pg8::EpiRes E{args.out, args.out, nullptr, ss3, DM};
        pg8::gemm_phase(F.lds, g, S, E); } SEAM(9);
    if (IN(10)) { final_norm(F, args); }
#undef IN
#undef SEAM
}

extern "C" void kernel_launch(void* const* d_in, const int* in_sizes, int n_in, void* d_out, int out_size, void* d_ws, size_t ws_size, hipStream_t stream) {
    static int grid = 0;
    if (grid == 0) {
        if (n_in != 30 || out_size != MTOK * DM || ws_size < WS_END) { fprintf(stderr, "kernel_launch: unexpected problem (n_in %d, out %d, ws %zu < %zu)\n", n_in, out_size, ws_size, (size_t)WS_END); grid = -1; return; }
        int dev = 0, cus = 0, per_cu = 0;
        hipGetDevice(&dev); hipDeviceGetAttribute(&cus, hipDeviceAttributeMultiprocessorCount, dev);
        if (hipFuncSetAttribute((const void*)fwd_kernel, hipFuncAttributeMaxDynamicSharedMemorySize, LDS_BYTES) != hipSuccess) { fprintf(stderr, "kernel_launch: hipFuncSetAttribute failed\n"); grid = -1; return; }
        if (hipOccupancyMaxActiveBlocksPerMultiprocessor(&per_cu, (const void*)fwd_kernel, NTHREADS, LDS_BYTES) != hipSuccess || per_cu < 1) { fprintf(stderr, "kernel_launch: occupancy query says %d\n", per_cu); per_cu = 1; }
        (void)hipGetLastError();
        grid = cus;
        if (grid > 256) grid = 256;
    }
    if (grid < 0) return;
    hipMemsetAsync((char*)d_ws + WS_CTL, 0, CTL_ZERO_BYTES, stream);
    Args a{};
    for (int i = 0; i < 30; ++i) a.in[i] = (const float*)d_in[i];
    a.out = (float*)d_out; a.ws = (unsigned char*)d_ws;
#if MK_ONE_LAUNCH
    a.ph_lo = 0; a.ph_hi = N_PHASES;
    void* kargs[] = {&a};
    hipError_t e = hipLaunchCooperativeKernel((const void*)fwd_kernel, dim3(grid), dim3(NTHREADS), kargs, LDS_BYTES, stream);
    if (e != hipSuccess) fprintf(stderr, "cooperative launch failed: %s (grid %d)\n", hipGetErrorString(e), grid);
#else
    for (int ph = 0; ph < N_PHASES; ++ph) { a.ph_lo = ph; a.ph_hi = ph + 1; hipLaunchKernelGGL(fwd_kernel, dim3(grid), dim3(NTHREADS), LDS_BYTES, stream, a); }
#endif
}
```

```cpp
#include <hip/hip_runtime.h>
#include <hip/hip_cooperative_groups.h>
#include <cstdio>
#include <cstdint>
namespace cg = cooperative_groups;
namespace pg8 {
#define PG8_LAS __attribute__((address_space(3)))
typedef unsigned short h16_t;
typedef _Float16 h16x8 __attribute__((ext_vector_type(8)));
typedef _Float16 h16x2 __attribute__((ext_vector_type(2)));
typedef float f32x4 __attribute__((ext_vector_type(4)));
typedef float f32x2 __attribute__((ext_vector_type(2)));
typedef unsigned u32x4 __attribute__((ext_vector_type(4)));
typedef unsigned u32x2 __attribute__((ext_vector_type(2)));
constexpr int BM = 256, BK = 64, HALF = 128, HTB = HALF * BK * 2  , STAGE_BYTES = 8 * HTB, NXCD = 8, WGM = 8;

__host__ __device__ __forceinline__ int lds_byte(int r, int c) { const int st = (r >> 4) * 2 + (c >> 5), rr = r & 15, cc = c & 31, ob = rr * 64 + cc * 2; return st * 1024 + (ob ^ (((ob >> 9) & 1) << 5)); }
__host__ __device__ __forceinline__ void stage_rc(int b, int& R, int& C) { const int st = b / 1024, sb = b % 1024, swz = sb ^ (((sb >> 9) & 1) << 5); R = (st >> 1) * 16 + swz / 64; C = (st & 1) * 32 + (swz % 64) / 2; }
__host__ __device__ __forceinline__ int perm32(int rho) { const int n = rho >> 4, i = rho & 15; return 8 * (i >> 2) + 4 * n + (i & 3); }

struct Unit { int pm, pn; };
struct Gemm { const h16_t* A; const h16_t* Bt; int K; };

struct StaticOrder {
    int nM, nN, nwg, G, c, eM, eN;
    __device__ void init(int nM_, int nN_, int G_, int c_, int eM_ = 0, int eN_ = 0) { nM = nM_; nN = nN_; nwg = nM * nN; G = G_; c = c_; eM = eM_; eN = eN_; }
    __device__ bool next(int i, Unit& u) const {
        const long L = (long)i * G + c;
        if (L >= nwg) { const int e = (int)(L - nwg); if (e >= eM * eN) return false; u.pm = nM + e / eN; u.pn = nN + e % eN; return true; }
        int wgid = (int)L; { const int q = nwg / NXCD, r = nwg % NXCD, xcd = wgid % NXCD, off = wgid / NXCD; wgid = (xcd < r ? xcd * (q + 1) : r * (q + 1) + (xcd - r) * q) + off; }
        const int nig = WGM * nN, gid = wgid / nig, fm = gid * WGM, gsz = (nM - fm) < WGM ? (nM - fm) : WGM;
        u.pm = fm + ((wgid % nig) % gsz); u.pn = (wgid % nig) / gsz; return true;
    }
};

__device__ __forceinline__ unsigned pkh(float lo, float hi) { f32x2 v = {lo, hi}; h16x2 h = __builtin_convertvector(v, h16x2); return __builtin_bit_cast(unsigned, h); }


template <int ACT> struct EpiF16 {
    static constexpr bool PERM = true;
    h16_t* O; int ldc; const float* rs; float eps; h16_t* O2; int ldc2; int splitM, splitN;
    __device__ __forceinline__ void operator()(const f32x4 (&acc)[2][2][4][2], const Unit& u, int wr, int wc, int fr, int fq) const {
        int pm = u.pm, pn = u.pn; h16_t* base = O; int ld = ldc;
        if (O2 && pm >= splitM) { pm -= splitM; pn -= splitN; base = O2; ld = ldc2; }
        const int row0 = pm * BM + wr * 64 + fr; const int col0 = pn * BM + wc * 32 + 8 * fq;
#pragma unroll
        for (int ai = 0; ai < 2; ++ai)
#pragma unroll
            for (int m = 0; m < 4; ++m) { const int row = row0 + ai * HALF + m * 16; h16_t* rowp = base + (size_t)row * ld + col0;
                float sc = 1.f; if (rs) sc = __builtin_amdgcn_rsqf(rs[row] * (1.0f / 2048.0f) + eps);
#pragma unroll
                for (int bj = 0; bj < 2; ++bj) { f32x4 v0 = acc[ai][bj][m][0] * sc, v1 = acc[ai][bj][m][1] * sc;
                    if (ACT == 1) { v0 = __builtin_elementwise_max(v0, (f32x4){0.f, 0.f, 0.f, 0.f}); v1 = __builtin_elementwise_max(v1, (f32x4){0.f, 0.f, 0.f, 0.f}); v0 = v0 * v0; v1 = v1 * v1; }
                    u32x4 w; w.x = pkh(v0[0], v0[1]); w.y = pkh(v0[2], v0[3]); w.z = pkh(v1[0], v1[1]); w.w = pkh(v1[2], v1[3]);
                    *(u32x4*)(rowp + bj * HALF) = w; } }
    }
};
struct EpiRes {
    static constexpr bool PERM = false;
    const float* base; float* out; h16_t* o16; float* ss; int ldc;
    __device__ __forceinline__ void operator()(const f32x4 (&acc)[2][2][4][2], const Unit& u, int wr, int wc, int fr, int fq) const {
        const int col0 = u.pn * BM + wc * 32 + 4 * fq;
#pragma unroll
        for (int ai = 0; ai < 2; ++ai)
#pragma unroll
            for (int m = 0; m < 4; ++m) { const int row = u.pm * BM + ai * HALF + wr * 64 + m * 16 + fr; const size_t off = (size_t)row * ldc + col0; float q = 0.f;
#pragma unroll
                for (int bj = 0; bj < 2; ++bj)
#pragma unroll
                    for (int n = 0; n < 2; ++n) { const f32x4 bs = *(const f32x4*)(base + off + bj * HALF + n * 16); const f32x4 o = bs + acc[ai][bj][m][n];
                        *(f32x4*)(out + off + bj * HALF + n * 16) = o; q += (o[0] * o[0] + o[1] * o[1]) + (o[2] * o[2] + o[3] * o[3]);
                        if (o16) { u32x2 w; w.x = pkh(o[0], o[1]); w.y = pkh(o[2], o[3]); *(u32x2*)(o16 + off + bj * HALF + n * 16) = w; } }
                q += __shfl_xor(q, 16); q += __shfl_xor(q, 32);
                if (fq == 0) atomicAdd(ss + row, q); }
    }
};

template <class Epi, class Sched>
__device__ __forceinline__ void gemm_phase(PG8_LAS unsigned char* lds, const Gemm g, const Sched& S, const Epi& E) {
    const int tid = threadIdx.x, wid = __builtin_amdgcn_readfirstlane(tid >> 6), lane = tid & 63, wr = wid >> 2, wc = wid & 3, fr = lane & 15, fq = lane >> 4;
    const int K = g.K, nt = K / BK;
    unsigned voffA[2], voffB[2];
#pragma unroll
    for (int i = 0; i < 2; ++i) { int R, C; stage_rc(tid * 16 + i * 8192, R, C); const int Rb = Epi::PERM ? ((R & ~31) + perm32(R & 31)) : R;
        voffA[i] = (unsigned)(R * K + C) * 2u; voffB[i] = (unsigned)(Rb * K + C) * 2u; }
    const size_t kstep = (size_t)(BK * 2);
    const size_t hstep = (size_t)HALF * K * 2;
    const size_t tstep = 2 * hstep;
    const unsigned ldsw = (unsigned)wid * 1024u;
    const int aoff = lds_byte(wr * 64 + fr, fq * 8), boff = lds_byte(wc * 32 + fr, fq * 8);
#define PG8_SA(b, h) (((b) * 2 + (h)) * HTB)
#define PG8_SB(b, h) ((4 + (b) * 2 + (h)) * HTB)
#define PG8_STAGE(bufoff, gbase, voff) do { _Pragma("unroll") for (int _i = 0; _i < 2; ++_i) \
        __builtin_amdgcn_global_load_lds((const unsigned*)((const char*)(gbase) + (voff)[_i]), (PG8_LAS unsigned*)(lds + (bufoff) + ldsw + _i * 8192), 16, 0, 0); } while (0)
#define PG8_LDA(dst, b, h) do { _Pragma("unroll") for (int m = 0; m < 4; ++m) _Pragma("unroll") for (int k = 0; k < 2; ++k) dst[m][k] = *(const PG8_LAS h16x8*)(lds + PG8_SA(b, h) + aoff + m * 2048 + k * 1024); } while (0)
#define PG8_LDB(dst, b, h) do { _Pragma("unroll") for (int n = 0; n < 2; ++n) _Pragma("unroll") for (int k = 0; k < 2; ++k) dst[n][k] = *(const PG8_LAS h16x8*)(lds + PG8_SB(b, h) + boff + n * 2048 + k * 1024); } while (0)
#define PG8_MMA(ai, bj, At, Bt) do { __builtin_amdgcn_s_setprio(1); _Pragma("unroll") for (int m = 0; m < 4; ++m) _Pragma("unroll") for (int n = 0; n < 2; ++n) _Pragma("unroll") for (int k = 0; k < 2; ++k) \
        acc[ai][bj][m][n] = __builtin_amdgcn_mfma_f32_16x16x32_f16(Bt[n][k], At[m][k], acc[ai][bj][m][n], 0, 0, 0); __builtin_amdgcn_s_setprio(0); } while (0)
#define PG8_WAIT_V(n) asm volatile("s_waitcnt vmcnt(" #n ")" ::: "memory")
#define PG8_WAIT_L(n) asm volatile("s_waitcnt lgkmcnt(" #n ")" ::: "memory")
#define PG8_BAR __builtin_amdgcn_s_barrier()
#define PG8_SCHED __builtin_amdgcn_sched_barrier(0)
    Unit cur, nxt; int ui = 0;
    if (!S.next(0, cur)) return;
    f32x4 acc[2][2][4][2];
#pragma unroll
    for (int a = 0; a < 2; ++a)
#pragma unroll
        for (int b = 0; b < 2; ++b)
#pragma unroll
            for (int m = 0; m < 4; ++m)
#pragma unroll
                for (int n = 0; n < 2; ++n) acc[a][b][m][n] = (f32x4){0.f, 0.f, 0.f, 0.f};
    h16x8 At[4][2], B0[2][2], B1[2][2];
    const char* cA = (const char*)g.A + (size_t)cur.pm * tstep; const char* cB = (const char*)g.Bt + (size_t)cur.pn * tstep;
    PG8_STAGE(PG8_SB(0, 0), cB, voffB); PG8_STAGE(PG8_SB(0, 1), cB + hstep, voffB); PG8_STAGE(PG8_SA(0, 0), cA, voffA); PG8_STAGE(PG8_SA(0, 1), cA + hstep, voffA);
    if (wr == 1) PG8_BAR;
    PG8_WAIT_V(2); PG8_BAR;
    PG8_STAGE(PG8_SB(1, 0), cB + kstep, voffB); PG8_STAGE(PG8_SA(1, 0), cA + kstep, voffA); PG8_STAGE(PG8_SB(1, 1), cB + hstep + kstep, voffB);
    PG8_WAIT_V(6); PG8_BAR;
    for (;;) {
        const bool has_next = S.next(ui + 1, nxt);
        const char* nA = has_next ? (const char*)g.A + (size_t)nxt.pm * tstep : cA; const char* nB = has_next ? (const char*)g.Bt + (size_t)nxt.pn * tstep : cB;
        for (int t = 0; t < nt; t += 2) {
            const bool last = (t == nt - 2);
            const char* a1 = cA + (size_t)(t + 1) * kstep;
            const char* a2 = last ? nA : cA + (size_t)(t + 2) * kstep; const char* b2 = last ? nB : cB + (size_t)(t + 2) * kstep;
            const char* a3 = a2 + kstep; const char* b3 = b2 + kstep;
            PG8_LDB(B0, 0, 0); PG8_LDB(B1, 0, 1); PG8_SCHED; PG8_LDA(At, 0, 0); PG8_STAGE(PG8_SA(1, 1), a1 + hstep, voffA);
            PG8_WAIT_V(8); PG8_WAIT_L(0); PG8_BAR; PG8_MMA(0, 0, At, B0); PG8_MMA(0, 1, At, B1); PG8_BAR; PG8_SCHED;
            PG8_LDA(At, 0, 1); PG8_STAGE(PG8_SB(0, 0), b2, voffB); PG8_STAGE(PG8_SB(0, 1), b2 + hstep, voffB); PG8_STAGE(PG8_SA(0, 0), a2, voffA);
            PG8_WAIT_V(8); PG8_WAIT_L(0); PG8_BAR; PG8_MMA(1, 0, At, B0); PG8_MMA(1, 1, At, B1); PG8_BAR; PG8_SCHED;
            PG8_LDB(B0, 1, 0); PG8_LDB(B1, 1, 1); PG8_SCHED; PG8_LDA(At, 1, 0); PG8_STAGE(PG8_SA(0, 1), a2 + hstep, voffA);
            PG8_WAIT_V(8); PG8_WAIT_L(0); PG8_BAR; PG8_MMA(0, 0, At, B0); PG8_MMA(0, 1, At, B1); PG8_BAR; PG8_SCHED;
            PG8_LDA(At, 1, 1); PG8_STAGE(PG8_SB(1, 0), b3, voffB); PG8_STAGE(PG8_SB(1, 1), b3 + hstep, voffB); PG8_STAGE(PG8_SA(1, 0), a3, voffA);
            PG8_WAIT_V(8); PG8_WAIT_L(0); PG8_BAR; PG8_MMA(1, 0, At, B0); PG8_MMA(1, 1, At, B1); PG8_BAR; PG8_SCHED;
        }
        if (wr == 0) PG8_BAR;
        E(acc, cur, wr, wc, fr, fq);
        if (!has_next) break;
#pragma unroll
        for (int a = 0; a < 2; ++a)
#pragma unroll
            for (int b = 0; b < 2; ++b)
#pragma unroll
                for (int m = 0; m < 4; ++m)
#pragma unroll
                    for (int n = 0; n < 2; ++n) acc[a][b][m][n] = (f32x4){0.f, 0.f, 0.f, 0.f};
        cur = nxt; cA = nA; cB = nB; ++ui;
        if (wr == 1) PG8_BAR;
    }
    PG8_WAIT_V(0);
    PG8_BAR;
#undef PG8_SA
#undef PG8_SB
#undef PG8_STAGE
#undef PG8_LDA
#undef PG8_LDB
#undef PG8_MMA
#undef PG8_WAIT_V
#undef PG8_WAIT_L
#undef PG8_BAR
#undef PG8_SCHED
}
}
constexpr int NWAVES = 8, NTHREADS = 512;
constexpr int DM = 2048, BATCH = 8, SEQ = 2048, MTOK = BATCH * SEQ, MEMLEN = 256, MMEM = BATCH * MEMLEN;
constexpr int INC = 7440, PW = 7680;
constexpr int RW0 = 4128;
constexpr int FF = 8192;
constexpr float RMS_EPS = 1e-6f;
constexpr size_t MiB = 1u << 20;
constexpr size_t WS_CTL = 0, CTL_ZERO_BYTES = 1 * MiB;
constexpr size_t CTL_SS1 = 65536, CTL_SS2 = 131072, CTL_SS3 = 196608;
constexpr size_t WS_WALL = 2 * MiB;
constexpr size_t WS_WOUT = 36 * MiB, WS_WQ = 44 * MiB, WS_WO = 46 * MiB, WS_W1 = 48 * MiB, WS_W2 = 80 * MiB;
constexpr size_t WS_LORA = 112 * MiB;
constexpr size_t WS_KV = 113 * MiB;
constexpr size_t WS_Q = 117 * MiB, WS_AO = 133 * MiB;
constexpr size_t WS_C = 150 * MiB;
constexpr size_t WS_P = WS_C;
constexpr size_t WS_OMIX = WS_C + 240 * MiB;
constexpr size_t WS_HID = WS_C;
constexpr size_t WS_H1 = WS_C;
constexpr size_t WS_H2 = WS_C + 256 * MiB;
constexpr size_t WS_END = WS_C + 320 * MiB;

constexpr int LDS_BYTES = 147456;

#define GAS __attribute__((address_space(1)))
#define LAS __attribute__((address_space(3)))
typedef unsigned short h16;
typedef float f32x4 __attribute__((ext_vector_type(4)));
typedef float f32x2 __attribute__((ext_vector_type(2)));
typedef unsigned v4u __attribute__((ext_vector_type(4)));
typedef unsigned v2u __attribute__((ext_vector_type(2)));
typedef _Float16 h16x8 __attribute__((ext_vector_type(8)));
typedef _Float16 h16x4 __attribute__((ext_vector_type(4)));
using pg8::pkh;
__device__ __forceinline__ float h2f(h16 v) { return (float)__builtin_bit_cast(_Float16, v); }
__device__ __forceinline__ h16 f2h(float v) { return __builtin_bit_cast(h16, (_Float16)v); }
__device__ __forceinline__ float sigmoidf_(float x) { return 1.0f / (1.0f + __expf(-x)); }
__device__ __forceinline__ float softplusf_(float x) { return x > 20.f ? x : log1pf(__expf(x)); }
__device__ __forceinline__ float dppf(float v, int ctrl);
template <int CTRL> __device__ __forceinline__ float dpp_(float v) { return __builtin_bit_cast(float, __builtin_amdgcn_update_dpp(0, __builtin_bit_cast(int, v), CTRL, 0xf, 0xf, true)); }
__device__ __forceinline__ float red8(float x) { x += dpp_<0xB1>(x); x += dpp_<0x4E>(x); x += dpp_<0x141>(x); return x; }
__device__ __forceinline__ float red16(float x) { x += __shfl_xor(x, 1); x += __shfl_xor(x, 2); x += __shfl_xor(x, 4); x += __shfl_xor(x, 8); return x; }
__device__ __forceinline__ float wave_sum(float v) {
#pragma unroll
    for (int o = 1; o < 64; o <<= 1) v += __shfl_xor(v, o);
    return v;
}

struct Args {
    const float* in[30]; float* out; unsigned char* ws; int ph_lo, ph_hi;
};
struct Frame {
    LAS unsigned char* lds; int tid, lane, wave, G, bid;
};

__device__ __forceinline__ void tr_item(const float* W, int N, int K, h16* WT, const float* kscale, LAS float* scr, int k0, int nsrc0, int nvalid, int ndst0, int lane) {
    const int j = lane & 31;
#pragma unroll 8
    for (int i = 0; i < 32; ++i) { const int kk = 2 * i + (lane >> 5); float v = 0.f; if (j < nvalid) { v = W[(size_t)(k0 + kk) * N + nsrc0 + j]; if (kscale) v *= kscale[k0 + kk]; } scr[kk * 33 + j] = v; }
    asm volatile("s_waitcnt lgkmcnt(0)" ::: "memory");
    const int c = lane & 7;
#pragma unroll
    for (int jj = 0; jj < 4; ++jj) { const int n = (lane >> 3) + 8 * jj; const LAS float* s = scr + (8 * c) * 33 + n;
        v4u o; o.x = pkh(s[0 * 33], s[1 * 33]); o.y = pkh(s[2 * 33], s[3 * 33]); o.z = pkh(s[4 * 33], s[5 * 33]); o.w = pkh(s[6 * 33], s[7 * 33]);
        *(GAS v4u*)(WT + (size_t)(ndst0 + n) * K + k0 + 8 * c) = o; }
    asm volatile("s_waitcnt lgkmcnt(0)" ::: "memory");
}
__device__ __forceinline__ void rms_row_to_f16(const float* xrow, const float* w, h16* orow, int lane) {
    const GAS f32x4* xr = (const GAS f32x4*)xrow + lane; const GAS f32x4* wr = (const GAS f32x4*)w + lane;
    f32x4 v[8]; float s = 0.f;
#pragma unroll
    for (int j = 0; j < 8; ++j) { v[j] = xr[64 * j]; s += (v[j].x * v[j].x + v[j].y * v[j].y) + (v[j].z * v[j].z + v[j].w * v[j].w); }
    const float rstd = __builtin_amdgcn_rsqf(wave_sum(s) * (1.f / DM) + RMS_EPS);
    GAS v2u* o8 = (GAS v2u*)orow + lane;
#pragma unroll
    for (int j = 0; j < 8; ++j) { const f32x4 ww = wr[64 * j]; v2u o; o.x = pkh(v[j].x * rstd * ww.x, v[j].y * rstd * ww.y); o.y = pkh(v[j].z * rstd * ww.z, v[j].w * rstd * ww.w); o8[64 * j] = o; }
}
__device__ __forceinline__ void p0_prologue(const Frame& F, const Args& a) {
    LAS float* scr = (LAS float*)(F.lds + F.wave * 16384);
    unsigned char* ws = a.ws;
    const int gw = F.bid * NWAVES + F.wave, NGW = F.G * NWAVES, lane = F.lane;
    constexpr int I_IN = 240 * 32, I_K = 16 * 32, I_V = 16 * 32, I_OUT = 64 * 32, I_Q = 16 * 32, I_O = 64 * 8, I_1 = 256 * 32, I_2 = 64 * 128, I_LW = 32, I_LA = 32, I_LG = 64;
    constexpr int NITEMS = I_IN + I_K + I_V + I_OUT + I_Q + I_O + I_1 + I_2 + I_LW + I_LA + I_LG;
    h16* wall = (h16*)(ws + WS_WALL);
    for (int it = gw; it < NITEMS; it += NGW) {
        int r = it;
        if (r < I_IN) { const int nb = r % 240, kb = r / 240; int ns, nv;
            if (nb < 128) { ns = 32 * nb; nv = 32; } else if (nb == 128) { ns = 4096; nv = 16; } else if (nb < 233) { ns = 4112 + 32 * (nb - 129); nv = 32; } else { ns = 0; nv = 0; }
            tr_item(a.in[3], INC, DM, wall, nullptr, scr, 64 * kb, ns, nv, 32 * nb, lane); continue; } r -= I_IN;
        if (r < I_K) { tr_item(a.in[23], 512, DM, wall, nullptr, scr, 64 * (r / 16), 32 * (r % 16), 32, 7680 + 32 * (r % 16), lane); continue; } r -= I_K;
        if (r < I_V) { tr_item(a.in[24], 512, DM, wall, nullptr, scr, 64 * (r / 16), 32 * (r % 16), 32, 8192 + 32 * (r % 16), lane); continue; } r -= I_V;
        if (r < I_OUT) { tr_item(a.in[19], DM, DM, (h16*)(ws + WS_WOUT), nullptr, scr, 64 * (r / 64), 32 * (r % 64), 32, 32 * (r % 64), lane); continue; } r -= I_OUT;
        if (r < I_Q) { tr_item(a.in[22], 512, DM, (h16*)(ws + WS_WQ), a.in[20], scr, 64 * (r / 16), 32 * (r % 16), 32, 32 * (r % 16), lane); continue; } r -= I_Q;
        if (r < I_O) { tr_item(a.in[25], DM, 512, (h16*)(ws + WS_WO), nullptr, scr, 64 * (r / 64), 32 * (r % 64), 32, 32 * (r % 64), lane); continue; } r -= I_O;
        if (r < I_1) { tr_item(a.in[27], FF, DM, (h16*)(ws + WS_W1), a.in[26], scr, 64 * (r / 256), 32 * (r % 256), 32, 32 * (r % 256), lane); continue; } r -= I_1;
        if (r < I_2) { tr_item(a.in[28], DM, FF, (h16*)(ws + WS_W2), nullptr, scr, 64 * (r / 64), 32 * (r % 64), 32, 32 * (r % 64), lane); continue; } r -= I_2;
        if (r < I_LW) { tr_item(a.in[10], 1024, 64, (h16*)(ws + WS_LORA), nullptr, scr, 0, 32 * r, 32, 32 * r, lane); continue; } r -= I_LW;
        if (r < I_LA) { tr_item(a.in[12], 1024, 64, (h16*)(ws + WS_LORA + 131072), nullptr, scr, 0, 32 * r, 32, 32 * r, lane); continue; } r -= I_LA;
        tr_item(a.in[13], 1024, 128, (h16*)(ws + WS_LORA + 262144), nullptr, scr, 64 * (r / 32), 32 * (r % 32), 32, 32 * (r % 32), lane);
    }
    h16* aall = (h16*)a.out;
    for (int m = gw; m < MTOK + MMEM; m += NGW) {
        if (m < MTOK) rms_row_to_f16(a.in[0] + (size_t)m * DM, a.in[2], aall + (size_t)m * DM, lane);
        else rms_row_to_f16(a.in[1] + (size_t)(m - MTOK) * DM, a.in[21], aall + (size_t)m * DM, lane);
    }
}
constexpr int DN_TB = 32;
constexpr int DNL_Q = 0, DNL_K = DNL_Q + DN_TB * 128 * 4, DNL_V = DNL_K + DN_TB * 128 * 4, DNL_SC = DNL_V + DN_TB * 64 * 4, DNL_O = DNL_SC + DN_TB * 16, DNL_END = DNL_O + DN_TB * 64 * 4;
__device__ __forceinline__ void dn_direct(const Frame& F, const Args& a, int unit) {
    const int bh = unit >> 1, half = unit & 1, b = bh >> 3, h = bh & 7;
    const int tid = F.tid, lane = F.lane, w = F.wave;
    LAS float* qL = (LAS float*)(F.lds + DNL_Q); LAS float* kL = (LAS float*)(F.lds + DNL_K); LAS float* vL = (LAS float*)(F.lds + DNL_V);
    LAS float* scL = (LAS float*)(F.lds + DNL_SC); LAS float* oL = (LAS float*)(F.lds + DNL_O);
    const h16* P = (const h16*)(a.ws + WS_P);
    float* oraw = a.out;
    const bool is_col = tid < 320, is_g = (tid >= 320 && tid < 352);
    int pcol = 0; float cw0 = 0.f, cw1 = 0.f, cw2 = 0.f, cw3 = 0.f;
    if (is_col) { pcol = tid < 128 ? h * 128 + tid : (tid < 256 ? 1024 + h * 128 + (tid - 128) : 2048 + h * 128 + 64 * half + (tid - 256));
        const float* cw = a.in[4]; cw0 = cw[pcol]; cw1 = cw[3072 + pcol]; cw2 = cw[2 * 3072 + pcol]; cw3 = cw[3 * 3072 + pcol]; }
    const float neg_ea = -__expf(a.in[5][h]), dtb = a.in[6][h];
    const size_t row0 = (size_t)b * SEQ;
    h16 raw[DN_TB + 3]; h16 rg0 = 0, rg1 = 0;
    float S[16];
#pragma unroll
    for (int i = 0; i < 16; ++i) S[i] = 0.f;
    const int seg = lane & 7, c = 8 * w + (lane >> 3);
    auto load_raw = [&](int t0) {
        if (is_col) {
#pragma unroll
            for (int i = 0; i < DN_TB + 3; ++i) { const int t = t0 - 3 + i; raw[i] = (t >= 0) ? P[(row0 + t) * PW + pcol] : (h16)0; }
        } else if (is_g) { const int t = t0 + (tid - 320); rg0 = P[(row0 + t) * PW + 4096 + h]; rg1 = P[(row0 + t) * PW + 4104 + h]; }
    };
    auto prep = [&]() {
        if (is_col) {
            LAS float* dst = tid < 128 ? qL + tid : (tid < 256 ? kL + (tid - 128) : vL + (tid - 256)); const int pitch = tid < 256 ? 128 : 64;
#pragma unroll
            for (int t = 0; t < DN_TB; ++t) { float y = cw0 * h2f(raw[t]) + cw1 * h2f(raw[t + 1]) + cw2 * h2f(raw[t + 2]) + cw3 * h2f(raw[t + 3]); y = y * sigmoidf_(y); dst[t * pitch] = y; }
        } else if (is_g) { const int t = tid - 320; const float g = neg_ea * softplusf_(h2f(rg0) + dtb); scL[t * 4 + 0] = __expf(g); scL[t * 4 + 1] = sigmoidf_(h2f(rg1)); }
        __syncthreads();
        { const int t = tid >> 4, part = tid & 15; LAS float* qp = qL + t * 128 + part * 8; LAS float* kp = kL + t * 128 + part * 8;
            f32x4 q0 = *(LAS f32x4*)qp, q1 = *(LAS f32x4*)(qp + 4), k0 = *(LAS f32x4*)kp, k1 = *(LAS f32x4*)(kp + 4);
            float sq = (q0.x * q0.x + q0.y * q0.y) + (q0.z * q0.z + q0.w * q0.w) + (q1.x * q1.x + q1.y * q1.y) + (q1.z * q1.z + q1.w * q1.w);
            float sk = (k0.x * k0.x + k0.y * k0.y) + (k0.z * k0.z + k0.w * k0.w) + (k1.x * k1.x + k1.y * k1.y) + (k1.z * k1.z + k1.w * k1.w);
            float dq = (q0.x * k0.x + q0.y * k0.y) + (q0.z * k0.z + q0.w * k0.w) + (q1.x * k1.x + q1.y * k1.y) + (q1.z * k1.z + q1.w * k1.w);
            sq = red16(sq); sk = red16(sk); dq = red16(dq);
            const float rq = __builtin_amdgcn_rsqf(sq + 1e-6f) * 0.08838834764831845f, rk = __builtin_amdgcn_rsqf(sk + 1e-6f);
            *(LAS f32x4*)qp = q0 * rq; *(LAS f32x4*)(qp + 4) = q1 * rq; *(LAS f32x4*)kp = k0 * rk; *(LAS f32x4*)(kp + 4) = k1 * rk;
            if (part == 0) scL[t * 4 + 2] = dq * rq * rk; }
        __syncthreads();
    };
    load_raw(0); prep();
    for (int bt = 0; bt < SEQ / DN_TB; ++bt) {
        const int t0 = bt * DN_TB;
        if (bt + 1 < SEQ / DN_TB) load_raw(t0 + DN_TB);
        for (int t = 0; t < DN_TB; ++t) {
            const LAS f32x4* kp = (const LAS f32x4*)(kL + t * 128 + 16 * seg); const LAS f32x4* qp = (const LAS f32x4*)(qL + t * 128 + 16 * seg);
            const f32x4 ka = kp[0], kb = kp[1], kc = kp[2], kd = kp[3], qa = qp[0], qb = qp[1], qc = qp[2], qd = qp[3];
            const f32x4 sc = *(const LAS f32x4*)(scL + t * 4); const float vc = vL[t * 64 + c];
            const float kk[16] = {ka.x, ka.y, ka.z, ka.w, kb.x, kb.y, kb.z, kb.w, kc.x, kc.y, kc.z, kc.w, kd.x, kd.y, kd.z, kd.w};
            const float qq[16] = {qa.x, qa.y, qa.z, qa.w, qb.x, qb.y, qb.z, qb.w, qc.x, qc.y, qc.z, qc.w, qd.x, qd.y, qd.z, qd.w};
            float pk0 = 0.f, pk1 = 0.f, pq0 = 0.f, pq1 = 0.f;
#pragma unroll
            for (int i = 0; i < 16; i += 2) { pk0 += kk[i] * S[i]; pk1 += kk[i + 1] * S[i + 1]; pq0 += qq[i] * S[i]; pq1 += qq[i + 1] * S[i + 1]; }
            const float kS = red8(pk0 + pk1), qS = red8(pq0 + pq1);
            const float eg = sc.x, delta = sc.y * (vc - eg * kS), o = eg * qS + delta * sc.z;
#pragma unroll
            for (int i = 0; i < 16; ++i) S[i] = eg * S[i] + kk[i] * delta;
            if (seg == 0) oL[t * 64 + c] = o;
        }
        __syncthreads();
        { const int t = tid >> 4, part = tid & 15; const f32x4 v = *(const LAS f32x4*)(oL + t * 64 + part * 4);
            *(GAS f32x4*)(oraw + (row0 + t0 + t) * 1024 + h * 128 + 64 * half + part * 4) = v; }
        if (bt + 1 < SEQ / DN_TB) prep();
        else __syncthreads();
    }
}
constexpr int RW_TB = 32;
constexpr int RWL_R = 0, RWL_W = RWL_R + RW_TB * 64 * 4, RWL_K = RWL_W + RW_TB * 64 * 4, RWL_KK = RWL_K + RW_TB * 64 * 4, RWL_B = RWL_KK + RW_TB * 64 * 4, RWL_V = RWL_B + RW_TB * 64 * 4,
              RWL_G = RWL_V + RW_TB * 64 * 4, RWL_Y = RWL_G + RW_TB * 64 * 4, RWL_A = RWL_Y + RW_TB * 64 * 4, RWL_BON = RWL_A + RW_TB * 64 * 4,
              RWL_HW = RWL_BON + RW_TB * 4, RWL_HA = RWL_HW + RW_TB * 72 * 2, RWL_HG = RWL_HA + RW_TB * 72 * 2, RWL_END = RWL_HG + RW_TB * 136 * 2;
__device__ __forceinline__ void rw_direct(const Frame& F, const Args& a, int unit) {
    const int b = unit >> 4, h = unit & 15;
    const int tid = F.tid, lane = F.lane, w = F.wave;
    LAS float* rL = (LAS float*)(F.lds + RWL_R); LAS float* wL = (LAS float*)(F.lds + RWL_W); LAS float* kL = (LAS float*)(F.lds + RWL_K); LAS float* kkL = (LAS float*)(F.lds + RWL_KK);
    LAS float* bL = (LAS float*)(F.lds + RWL_B); LAS float* vL = (LAS float*)(F.lds + RWL_V); LAS float* gL = (LAS float*)(F.lds + RWL_G); LAS float* yL = (LAS float*)(F.lds + RWL_Y);
    LAS float* aL = (LAS float*)(F.lds + RWL_A); LAS float* bonL = (LAS float*)(F.lds + RWL_BON);
    LAS h16* hW = (LAS h16*)(F.lds + RWL_HW); LAS h16* hA = (LAS h16*)(F.lds + RWL_HA); LAS h16* hG = (LAS h16*)(F.lds + RWL_HG);
    const h16* P = (const h16*)(a.ws + WS_P);
    h16* omix = (h16*)(a.ws + WS_OMIX);
    const size_t row0 = (size_t)b * SEQ;
    const bool is_col = tid < 448;
    int rcol = 0; float mu = 0.f;
    if (is_col) { rcol = tid < 192 ? (tid >> 6) * 1024 + h * 64 + (tid & 63) : 3072 + (tid - 192); mu = a.in[8][rcol]; }
    h16 raw[RW_TB + 1];
    const int fpart = tid & 15, ft = tid >> 4, hc0 = h * 64 + 4 * fpart;
    const f32x4 c_kk = *(const f32x4*)(a.in[14] + hc0), c_ka = *(const f32x4*)(a.in[15] + hc0), c_rk = *(const f32x4*)(a.in[16] + hc0), c_lnw = *(const f32x4*)(a.in[17] + hc0), c_lnb = *(const f32x4*)(a.in[18] + hc0);
    const int mt = w & 1, nt = w >> 1, l15 = lane & 15, lg = lane >> 4;
    const h16* w2T = (const h16*)(a.ws + WS_LORA) + (size_t)(h * 64 + 16 * nt + l15) * 64 + 8 * lg;
    const h16* a2T = (const h16*)(a.ws + WS_LORA + 131072) + (size_t)(h * 64 + 16 * nt + l15) * 64 + 8 * lg;
    const h16* g2T = (const h16*)(a.ws + WS_LORA + 262144) + (size_t)(h * 64 + 16 * nt + l15) * 128 + 8 * lg;
    const float c_w0 = a.in[9][h * 64 + 16 * nt + l15], c_a0 = a.in[11][h * 64 + 16 * nt + l15];
    float S[8];
#pragma unroll
    for (int i = 0; i < 8; ++i) S[i] = 0.f;
    const int seg = lane & 7, vrow = 8 * w + (lane >> 3);
#define RW_LOAD_RAW(t0_) do { if (is_col) { _Pragma("unroll") for (int i = 0; i < RW_TB + 1; ++i) { const int t = (t0_) - 1 + i; raw[i] = (t >= 0) ? P[(row0 + t) * PW + RW0 + rcol] : (h16)0; } } } while (0)
#define RW_PREP() do { \
        if (is_col) { \
            _Pragma("unroll") for (int t = 0; t < RW_TB; ++t) { const float x = h2f(raw[t + 1]), xp = h2f(raw[t]); const float y = x + (xp - x) * mu; \
                if (tid < 64) rL[t * 64 + tid] = y; else if (tid < 128) kL[t * 64 + tid - 64] = y; else if (tid < 192) vL[t * 64 + tid - 128] = y; \
                else if (tid < 256) hW[t * 72 + tid - 192] = f2h(tanhf(y)); else if (tid < 320) hA[t * 72 + tid - 256] = f2h(y); else hG[t * 136 + tid - 320] = f2h(sigmoidf_(y)); } \
        } \
        __syncthreads(); \
        {   \
            pg8::f32x4 accw = {0.f, 0.f, 0.f, 0.f}, acca = accw, accg = accw; \
            _Pragma("unroll") for (int ks = 0; ks < 2; ++ks) { \
                const h16x8 fa = *(const LAS h16x8*)(hW + (16 * mt + l15) * 72 + 32 * ks + 8 * lg); const h16x8 fb = *(const GAS h16x8*)(w2T + 32 * ks); \
                accw = __builtin_amdgcn_mfma_f32_16x16x32_f16(fa, fb, accw, 0, 0, 0); \
                const h16x8 fa2 = *(const LAS h16x8*)(hA + (16 * mt + l15) * 72 + 32 * ks + 8 * lg); const h16x8 fb2 = *(const GAS h16x8*)(a2T + 32 * ks); \
                acca = __builtin_amdgcn_mfma_f32_16x16x32_f16(fa2, fb2, acca, 0, 0, 0); } \
            _Pragma("unroll") for (int ks = 0; ks < 4; ++ks) { \
                const h16x8 fa = *(const LAS h16x8*)(hG + (16 * mt + l15) * 136 + 32 * ks + 8 * lg); const h16x8 fb = *(const GAS h16x8*)(g2T + 32 * ks); \
                accg = __builtin_amdgcn_mfma_f32_16x16x32_f16(fa, fb, accg, 0, 0, 0); } \
            _Pragma("unroll") for (int r = 0; r < 4; ++r) { const int tok = 16 * mt + 4 * lg + r, n = 16 * nt + l15; \
                const float lw = -softplusf_(-(c_w0 + accw[r])) - 0.5f; wL[tok * 64 + n] = __expf(-__expf(lw)); \
                aL[tok * 64 + n] = sigmoidf_(c_a0 + acca[r]); gL[tok * 64 + n] = accg[r]; } \
        } \
        __syncthreads(); \
        { const int o = ft * 64 + 4 * fpart; const f32x4 pk = *(const LAS f32x4*)(kL + o), av = *(const LAS f32x4*)(aL + o), rv = *(const LAS f32x4*)(rL + o); \
            f32x4 kk = pk * c_kk; float ss = red16((kk.x * kk.x + kk.y * kk.y) + (kk.z * kk.z + kk.w * kk.w)); \
            const float inv = 1.0f / fmaxf(sqrtf(ss), 1e-12f); kk = kk * inv; \
            const f32x4 kf = pk * (1.0f + (av - 1.0f) * c_ka); \
            *(LAS f32x4*)(kkL + o) = kk; *(LAS f32x4*)(bL + o) = kk * av; *(LAS f32x4*)(kL + o) = kf; \
            const f32x4 rb = rv * kf * c_rk; const float bon = red16((rb.x + rb.y) + (rb.z + rb.w)); if (fpart == 0) bonL[ft] = bon; } \
        __syncthreads(); \
    } while (0)
    RW_LOAD_RAW(0); RW_PREP();
    for (int bt = 0; bt < SEQ / RW_TB; ++bt) {
        const int t0 = bt * RW_TB;
        if (bt + 1 < SEQ / RW_TB) RW_LOAD_RAW(t0 + RW_TB);
        for (int t = 0; t < RW_TB; ++t) {
            const int o = t * 64 + 8 * seg;
            const f32x4 k0 = *(const LAS f32x4*)(kkL + o), k1 = *(const LAS f32x4*)(kkL + o + 4), w0 = *(const LAS f32x4*)(wL + o), w1 = *(const LAS f32x4*)(wL + o + 4);
            const f32x4 b0 = *(const LAS f32x4*)(bL + o), b1 = *(const LAS f32x4*)(bL + o + 4), x0 = *(const LAS f32x4*)(kL + o), x1 = *(const LAS f32x4*)(kL + o + 4);
            const f32x4 r0 = *(const LAS f32x4*)(rL + o), r1 = *(const LAS f32x4*)(rL + o + 4); const float vv = vL[t * 64 + vrow];
            const float kkv[8] = {k0.x, k0.y, k0.z, k0.w, k1.x, k1.y, k1.z, k1.w}, wv[8] = {w0.x, w0.y, w0.z, w0.w, w1.x, w1.y, w1.z, w1.w}, bv[8] = {b0.x, b0.y, b0.z, b0.w, b1.x, b1.y, b1.z, b1.w};
            const float xv[8] = {x0.x, x0.y, x0.z, x0.w, x1.x, x1.y, x1.z, x1.w}, rv[8] = {r0.x, r0.y, r0.z, r0.w, r1.x, r1.y, r1.z, r1.w};
            float p0 = 0.f, p1 = 0.f;
#pragma unroll
            for (int i = 0; i < 8; i += 2) { p0 += S[i] * kkv[i]; p1 += S[i + 1] * kkv[i + 1]; }
            const float sa = -red8(p0 + p1);
            float y0 = 0.f, y1 = 0.f;
#pragma unroll
            for (int i = 0; i < 8; i += 2) { S[i] = S[i] * wv[i] + sa * bv[i] + vv * xv[i]; S[i + 1] = S[i + 1] * wv[i + 1] + sa * bv[i + 1] + vv * xv[i + 1]; y0 += S[i] * rv[i]; y1 += S[i + 1] * rv[i + 1]; }
            const float y = red8(y0 + y1);
            if (seg == 0) yL[t * 64 + vrow] = y;
        }
        __syncthreads();
        {
            const int o = ft * 64 + 4 * fpart; const f32x4 y = *(const LAS f32x4*)(yL + o), vv4 = *(const LAS f32x4*)(vL + o), g4 = *(const LAS f32x4*)(gL + o);
            const float mean = red16((y.x + y.y) + (y.z + y.w)) * (1.0f / 64.0f); const f32x4 d = y - mean;
            const float var = red16((d.x * d.x + d.y * d.y) + (d.z * d.z + d.w * d.w)) * (1.0f / 64.0f); const float rstd = __builtin_amdgcn_rsqf(var + 64e-5f);
            const f32x4 res = (d * rstd * c_lnw + c_lnb + vv4 * bonL[ft]) * g4;
            v2u pk2; pk2.x = pkh(res.x, res.y); pk2.y = pkh(res.z, res.w);
            *(GAS v2u*)(omix + (row0 + t0 + ft) * DM + 1024 + h * 64 + 4 * fpart) = pk2; }
        __syncthreads();
        if (bt + 1 < SEQ / RW_TB) RW_PREP();
    }
#undef RW_LOAD_RAW
#undef RW_PREP
}
__device__ __forceinline__ void dn_norm_gate(const Frame& F, const Args& a) {
    const int gw = F.bid * NWAVES + F.wave, NGW = F.G * NWAVES, lane = F.lane;
    const float* oraw = a.out; const h16* P = (const h16*)(a.ws + WS_P); h16* omix = (h16*)(a.ws + WS_OMIX);
    const int cn = (lane & 7) * 16;
    f32x4 nw[4];
#pragma unroll
    for (int j = 0; j < 4; ++j) nw[j] = *(const f32x4*)(a.in[7] + cn + 4 * j);
    for (int m = gw; m < MTOK; m += NGW) {
        const GAS f32x4* op = (const GAS f32x4*)(oraw + (size_t)m * 1024 + lane * 16);
        f32x4 v[4]; float s = 0.f;
#pragma unroll
        for (int j = 0; j < 4; ++j) { v[j] = op[j]; s += (v[j].x * v[j].x + v[j].y * v[j].y) + (v[j].z * v[j].z + v[j].w * v[j].w); }
        s = red8(s);
        const float rstd = __builtin_amdgcn_rsqf(s * (1.0f / 128.0f) + RMS_EPS);
        const GAS v4u* zp = (const GAS v4u*)(P + (size_t)m * PW + 3072 + lane * 16);
        const v4u z0 = zp[0], z1 = zp[1]; const unsigned zz[8] = {z0.x, z0.y, z0.z, z0.w, z1.x, z1.y, z1.z, z1.w};
        unsigned ow[8];
#pragma unroll
        for (int j = 0; j < 4; ++j) {
            const float za = h2f((h16)(zz[2 * j] & 0xffff)), zb = h2f((h16)(zz[2 * j] >> 16)), zc = h2f((h16)(zz[2 * j + 1] & 0xffff)), zd = h2f((h16)(zz[2 * j + 1] >> 16));
            const f32x4 o = v[j] * rstd * nw[j];
            ow[2 * j] = pkh(o.x * za * sigmoidf_(za), o.y * zb * sigmoidf_(zb)); ow[2 * j + 1] = pkh(o.z * zc * sigmoidf_(zc), o.w * zd * sigmoidf_(zd)); }
        GAS v4u* dst = (GAS v4u*)(omix + (size_t)m * DM + lane * 16);
        dst[0] = (v4u){ow[0], ow[1], ow[2], ow[3]}; dst[1] = (v4u){ow[4], ow[5], ow[6], ow[7]};
    }
}

constexpr int XA_KP = 136, XA_VP = 264;
constexpr int XAL_K = 0, XAL_V = XAL_K + 256 * XA_KP * 2, XAL_END = XAL_V + 128 * XA_VP * 2;
__device__ __forceinline__ void xattn_phase(const Frame& F, const Args& a) {
    const int tid = F.tid, lane = F.lane, w = F.wave, l15 = lane & 15, lg = lane >> 4;
    LAS h16* KL = (LAS h16*)(F.lds + XAL_K); LAS h16* VT = (LAS h16*)(F.lds + XAL_V);
    const h16* KV = (const h16*)(a.ws + WS_KV); const h16* Q = (const h16*)(a.ws + WS_Q); h16* AO = (h16*)(a.ws + WS_AO);
    for (int pair = F.bid; pair < 256; pair += F.G) {
        const int bhd = pair >> 3, b = bhd >> 2, hd = bhd & 3;
        __syncthreads();
#pragma unroll
        for (int i = 0; i < 8; ++i) { const int id = tid + 512 * i, mem = id & 255, dc = id >> 8;
            const v4u kv = *(const GAS v4u*)(KV + (size_t)(b * 256 + mem) * 1024 + hd * 128 + dc * 8);
            *(LAS v4u*)(KL + mem * XA_KP + dc * 8) = kv;
            const v4u vv = *(const GAS v4u*)(KV + (size_t)(b * 256 + mem) * 1024 + 512 + hd * 128 + dc * 8);
            const unsigned vw[4] = {vv.x, vv.y, vv.z, vv.w};
#pragma unroll
            for (int e = 0; e < 4; ++e) { VT[(dc * 8 + 2 * e) * XA_VP + mem] = (h16)(vw[e] & 0xffff); VT[(dc * 8 + 2 * e + 1) * XA_VP + mem] = (h16)(vw[e] >> 16); } }
        __syncthreads();
        for (int qi = 0; qi < 2; ++qi) {
            const int qb = (pair & 7) * 2 + qi; const size_t tok = (size_t)b * SEQ + qb * 128 + 16 * w + l15;
            h16x8 qf[4];
#pragma unroll
            for (int ks = 0; ks < 4; ++ks) qf[ks] = *(const GAS h16x8*)(Q + tok * 512 + hd * 128 + 32 * ks + 8 * lg);
            pg8::f32x4 s[16];
#pragma unroll
            for (int mt = 0; mt < 16; ++mt) { s[mt] = (pg8::f32x4){0.f, 0.f, 0.f, 0.f};
#pragma unroll
                for (int ks = 0; ks < 4; ++ks) { const h16x8 kf = *(const LAS h16x8*)(KL + (16 * mt + l15) * XA_KP + 32 * ks + 8 * lg); s[mt] = __builtin_amdgcn_mfma_f32_16x16x32_f16(kf, qf[ks], s[mt], 0, 0, 0); }
                if (mt & 1) __builtin_amdgcn_sched_barrier(0); }
            float mx = -3.0e38f;
#pragma unroll
            for (int mt = 0; mt < 16; ++mt) mx = fmaxf(fmaxf(fmaxf(mx, s[mt][0]), fmaxf(s[mt][1], s[mt][2])), s[mt][3]);
            mx = fmaxf(mx, __shfl_xor(mx, 16)); mx = fmaxf(mx, __shfl_xor(mx, 32));
            const float sc = 0.08838834764831845f * 1.4426950408889634f; float sum = 0.f;
#pragma unroll
            for (int mt = 0; mt < 16; ++mt)
#pragma unroll
                for (int r = 0; r < 4; ++r) { const float p = __builtin_amdgcn_exp2f((s[mt][r] - mx) * sc); s[mt][r] = p; sum += p; }
            sum += __shfl_xor(sum, 16); sum += __shfl_xor(sum, 32);
            const float inv = 1.0f / sum;
            h16x8 pf[8];
#pragma unroll
            for (int ss = 0; ss < 8; ++ss) { v4u t; t.x = pkh(s[2 * ss][0] * inv, s[2 * ss][1] * inv); t.y = pkh(s[2 * ss][2] * inv, s[2 * ss][3] * inv); t.z = pkh(s[2 * ss + 1][0] * inv, s[2 * ss + 1][1] * inv); t.w = pkh(s[2 * ss + 1][2] * inv, s[2 * ss + 1][3] * inv);
                pf[ss] = __builtin_bit_cast(h16x8, t); }
#pragma unroll
            for (int dt = 0; dt < 8; ++dt) { pg8::f32x4 o = {0.f, 0.f, 0.f, 0.f};
#pragma unroll
                for (int ss = 0; ss < 8; ++ss) { const LAS h16* vp = VT + (16 * dt + l15) * XA_VP + 32 * ss + 4 * lg;
                    const v2u lo = *(const LAS v2u*)vp, hi = *(const LAS v2u*)(vp + 16); const v4u t = {lo.x, lo.y, hi.x, hi.y};
                    o = __builtin_amdgcn_mfma_f32_16x16x32_f16(__builtin_bit_cast(h16x8, t), pf[ss], o, 0, 0, 0); }
                v2u ow; ow.x = pkh(o[0], o[1]); ow.y = pkh(o[2], o[3]);
                *(GAS v2u*)(AO + tok * 512 + hd * 128 + 16 * dt + 4 * lg) = ow; __builtin_amdgcn_sched_barrier(0); }
        }
    }
}

__device__ __forceinline__ void final_norm(const Frame& F, const Args& a) {
    const int gw = F.bid * NWAVES + F.wave, NGW = F.G * NWAVES, lane = F.lane;
    const float* ss = (const float*)(a.ws + WS_CTL + CTL_SS3); const GAS f32x4* wr = (const GAS f32x4*)a.in[29] + lane;
    for (int m = gw; m < MTOK; m += NGW) {
        const float rstd = __builtin_amdgcn_rsqf(__hip_atomic_load(ss + m, __ATOMIC_RELAXED, __HIP_MEMORY_SCOPE_AGENT) * (1.0f / DM) + RMS_EPS);
        GAS f32x4* xr = (GAS f32x4*)(a.out + (size_t)m * DM) + lane;
#pragma unroll
        for (int j = 0; j < 8; ++j) { const f32x4 v = xr[64 * j]; xr[64 * j] = v * rstd * wr[64 * j]; }
    }
}
constexpr int N_PHASES = 11;
#ifndef MK_ONE_LAUNCH
#define MK_ONE_LAUNCH 1
#endif
__global__ void __launch_bounds__(NTHREADS, 2) fwd_kernel(Args args) {
    extern __shared__ __attribute__((aligned(16))) unsigned char lds[];
    Frame F; F.lds = (LAS unsigned char*)lds; F.tid = threadIdx.x; F.lane = F.tid & 63; F.wave = __builtin_amdgcn_readfirstlane(F.tid >> 6); F.G = gridDim.x; F.bid = blockIdx.x;
    unsigned char* ws = args.ws;
    const int lo = args.ph_lo, hi = args.ph_hi;
#define IN(k) (lo <= (k) && (k) < hi)
#if MK_ONE_LAUNCH
#define SEAM(k) do { if (IN(k) && IN((k) + 1)) { cg::this_grid().sync(); } } while (0)
#else
#define SEAM(k) do { } while (0)
#endif
    float* ss1 = (float*)(ws + WS_CTL + CTL_SS1); float* ss2 = (float*)(ws + WS_CTL + CTL_SS2); float* ss3 = (float*)(ws + WS_CTL + CTL_SS3);
    if (IN(0)) { p0_prologue(F, args); } SEAM(0);
    if (IN(1)) { pg8::Gemm g{(const pg8::h16_t*)args.out, (const pg8::h16_t*)(ws + WS_WALL), DM}; pg8::StaticOrder S; S.init(64, 30, F.G, F.bid, 8, 4);
        pg8::EpiF16<0> E{(pg8::h16_t*)(ws + WS_P), PW, nullptr, 0.f, (pg8::h16_t*)(ws + WS_KV), 1024, 64, 30};
        pg8::gemm_phase(F.lds, g, S, E); } SEAM(1);
    if (IN(2)) { for (int u = F.bid; u < 256; u += F.G) { if (u < 128) dn_direct(F, args, u); else rw_direct(F, args, u - 128); } } SEAM(2);
    if (IN(3)) { dn_norm_gate(F, args); } SEAM(3);
    if (IN(4)) { pg8::Gemm g{(const pg8::h16_t*)(ws + WS_OMIX), (const pg8::h16_t*)(ws + WS_WOUT), DM}; pg8::StaticOrder S; S.init(64, 8, F.G, F.bid);
        pg8::EpiRes E{args.in[0], args.out, (pg8::h16_t*)(ws + WS_H1), ss1, DM};
        pg8::gemm_phase(F.lds, g, S, E); } SEAM(4);
    if (IN(5)) { pg8::Gemm g{(const pg8::h16_t*)(ws + WS_H1), (const pg8::h16_t*)(ws + WS_WQ), DM}; pg8::StaticOrder S; S.init(64, 2, F.G, F.bid);
        pg8::EpiF16<0> E{(pg8::h16_t*)(ws + WS_Q), 512, ss1, RMS_EPS, nullptr, 0, 0, 0};
        pg8::gemm_phase(F.lds, g, S, E); } SEAM(5);
    if (IN(6)) { xattn_phase(F, args); } SEAM(6);
    if (IN(7)) { pg8::Gemm g{(const pg8::h16_t*)(ws + WS_AO), (const pg8::h16_t*)(ws + WS_WO), 512}; pg8::StaticOrder S; S.init(64, 8, F.G, F.bid);
        pg8::EpiRes E{args.out, args.out, (pg8::h16_t*)(ws + WS_H2), ss2, DM};
        pg8::gemm_phase(F.lds, g, S, E); } SEAM(7);
    if (IN(8)) { pg8::Gemm g{(const pg8::h16_t*)(ws + WS_H2), (const pg8::h16_t*)(ws + WS_W1), DM}; pg8::StaticOrder S; S.init(64, 32, F.G, F.bid);
        pg8::EpiF16<1> E{(pg8::h16_t*)(ws + WS_HID), FF, ss2, RMS_EPS, nullptr, 0, 0, 0};
        pg8::gemm_phase(F.lds, g, S, E); } SEAM(8);
    if (IN(9)) { pg8::Gemm g{(const pg8::h16_t*)(ws + WS_HID), (const pg8::h16_t*)(ws + WS_W2), FF}; pg8::StaticOrder S; S.init(64, 8, F.G, F.bid);
        pg8::EpiRes E{args.out, args.out, nullptr, ss3, DM};
        pg8::gemm_phase(F.lds, g, S, E); } SEAM(9);
    if (IN(10)) { final_norm(F, args); }
#undef IN
#undef SEAM
}

extern "C" void kernel_launch(void* const* d_in, const int* in_sizes, int n_in, void* d_out, int out_size, void* d_ws, size_t ws_size, hipStream_t stream) {
    static int grid = 0;
    if (grid == 0) {
        if (n_in != 30 || out_size != MTOK * DM || ws_size < WS_END) { fprintf(stderr, "kernel_launch: unexpected problem (n_in %d, out %d, ws %zu < %zu)\n", n_in, out_size, ws_size, (size_t)WS_END); grid = -1; return; }
        int dev = 0, cus = 0, per_cu = 0;
        hipGetDevice(&dev); hipDeviceGetAttribute(&cus, hipDeviceAttributeMultiprocessorCount, dev);
        if (hipFuncSetAttribute((const void*)fwd_kernel, hipFuncAttributeMaxDynamicSharedMemorySize, LDS_BYTES) != hipSuccess) { fprintf(stderr, "kernel_launch: hipFuncSetAttribute failed\n"); grid = -1; return; }
        if (hipOccupancyMaxActiveBlocksPerMultiprocessor(&per_cu, (const void*)fwd_kernel, NTHREADS, LDS_BYTES) != hipSuccess || per_cu < 1) { fprintf(stderr, "kernel_launch: occupancy query says %d\n", per_cu); per_cu = 1; }
        (void)hipGetLastError();
        grid = cus;
        if (grid > 256) grid = 256;
    }
    if (grid < 0) return;
    hipMemsetAsync((char*)d_ws + WS_CTL, 0, CTL_ZERO_BYTES, stream);
    Args a{};
    for (int i = 0; i < 30; ++i) a.in[i] = (const float*)d_in[i];
    a.out = (float*)d_out; a.ws = (unsigned char*)d_ws;
#if MK_ONE_LAUNCH
    a.ph_lo = 0; a.ph_hi = N_PHASES;
    void* kargs[] = {&a};
    hipError_t e = hipLaunchCooperativeKernel((const void*)fwd_kernel, dim3(grid), dim3(NTHREADS), kargs, LDS_BYTES, stream);
    if (e != hipSuccess) fprintf(stderr, "cooperative launch failed: %s (grid %d)\n", hipGetErrorString(e), grid);
#else
    for (int ph = 0; ph < N_PHASES; ++ph) { a.ph_lo = ph; a.ph_hi = ph + 1; hipLaunchKernelGGL(fwd_kernel, dim3(grid), dim3(NTHREADS), LDS_BYTES, stream, a); }
#endif
}
```

```cpp
#include <hip/hip_runtime.h>
#include <hip/hip_cooperative_groups.h>
#include <cstdio>
#include <cstdint>
namespace cg = cooperative_groups;
namespace pg8 {
#define PG8_LAS __attribute__((address_space(3)))
typedef unsigned short h16_t;
typedef _Float16 h16x8 __attribute__((ext_vector_type(8)));
typedef _Float16 h16x2 __attribute__((ext_vector_type(2)));
typedef float f32x4 __attribute__((ext_vector_type(4)));
typedef float f32x2 __attribute__((ext_vector_type(2)));
typedef unsigned u32x4 __attribute__((ext_vector_type(4)));
typedef unsigned u32x2 __attribute__((ext_vector_type(2)));
constexpr int BM = 256, BK = 64, HALF = 128, HTB = HALF * BK * 2  , STAGE_BYTES = 8 * HTB, NXCD = 8, WGM = 8;

__host__ __device__ __forceinline__ int lds_byte(int r, int c) { const int st = (r >> 4) * 2 + (c >> 5), rr = r & 15, cc = c & 31, ob = rr * 64 + cc * 2; return st * 1024 + (ob ^ (((ob >> 9) & 1) << 5)); }
__host__ __device__ __forceinline__ void stage_rc(int b, int& R, int& C) { const int st = b / 1024, sb = b % 1024, swz = sb ^ (((sb >> 9) & 1) << 5); R = (st >> 1) * 16 + swz / 64; C = (st & 1) * 32 + (swz % 64) / 2; }
__host__ __device__ __forceinline__ int perm32(int rho) { const int n = rho >> 4, i = rho & 15; return 8 * (i >> 2) + 4 * n + (i & 3); }

struct Unit { int pm, pn; };
struct Gemm { const h16_t* A; const h16_t* Bt; int K; };

struct StaticOrder {
    int nM, nN, nwg, G, c, eM, eN;
    __device__ void init(int nM_, int nN_, int G_, int c_, int eM_ = 0, int eN_ = 0) { nM = nM_; nN = nN_; nwg = nM * nN; G = G_; c = c_; eM = eM_; eN = eN_; }
    __device__ bool next(int i, Unit& u) const {
        const long L = (long)i * G + c;
        if (L >= nwg) { const int e = (int)(L - nwg); if (e >= eM * eN) return false; u.pm = nM + e / eN; u.pn = nN + e % eN; return true; }
        int wgid = (int)L; { const int q = nwg / NXCD, r = nwg % NXCD, xcd = wgid % NXCD, off = wgid / NXCD; wgid = (xcd < r ? xcd * (q + 1) : r * (q + 1) + (xcd - r) * q) + off; }
        const int nig = WGM * nN, gid = wgid / nig, fm = gid * WGM, gsz = (nM - fm) < WGM ? (nM - fm) : WGM;
        u.pm = fm + ((wgid % nig) % gsz); u.pn = (wgid % nig) / gsz; return true;
    }
};

__device__ __forceinline__ unsigned pkh(float lo, float hi) { f32x2 v = {lo, hi}; h16x2 h = __builtin_convertvector(v, h16x2); return __builtin_bit_cast(unsigned, h); }


template <int ACT> struct EpiF16 {
    static constexpr bool PERM = true;
    h16_t* O; int ldc; const float* rs; float eps; h16_t* O2; int ldc2; int splitM, splitN;
    __device__ __forceinline__ void operator()(const f32x4 (&acc)[2][2][4][2], const Unit& u, int wr, int wc, int fr, int fq) const {
        int pm = u.pm, pn = u.pn; h16_t* base = O; int ld = ldc;
        if (O2 && pm >= splitM) { pm -= splitM; pn -= splitN; base = O2; ld = ldc2; }
        const int row0 = pm * BM + wr * 64 + fr; const int col0 = pn * BM + wc * 32 + 8 * fq;
#pragma unroll
        for (int ai = 0; ai < 2; ++ai)
#pragma unroll
            for (int m = 0; m < 4; ++m) { const int row = row0 + ai * HALF + m * 16; h16_t* rowp = base + (size_t)row * ld + col0;
                float sc = 1.f; if (rs) sc = __builtin_amdgcn_rsqf(rs[row] * (1.0f / 2048.0f) + eps);
#pragma unroll
                for (int bj = 0; bj < 2; ++bj) { f32x4 v0 = acc[ai][bj][m][0] * sc, v1 = acc[ai][bj][m][1] * sc;
                    if (ACT == 1) { v0 = __builtin_elementwise_max(v0, (f32x4){0.f, 0.f, 0.f, 0.f}); v1 = __builtin_elementwise_max(v1, (f32x4){0.f, 0.f, 0.f, 0.f}); v0 = v0 * v0; v1 = v1 * v1; }
                    u32x4 w; w.x = pkh(v0[0], v0[1]); w.y = pkh(v0[2], v0[3]); w.z = pkh(v1[0], v1[1]); w.w = pkh(v1[2], v1[3]);
                    *(u32x4*)(rowp + bj * HALF) = w; } }
    }
};
struct EpiRes {
    static constexpr bool PERM = false;
    const float* base; float* out; h16_t* o16; float* ss; int ldc;
    __device__ __forceinline__ void operator()(const f32x4 (&acc)[2][2][4][2], const Unit& u, int wr, int wc, int fr, int fq) const {
        const int col0 = u.pn * BM + wc * 32 + 4 * fq;
#pragma unroll
        for (int ai = 0; ai < 2; ++ai)
#pragma unroll
            for (int m = 0; m < 4; ++m) { const int row = u.pm * BM + ai * HALF + wr * 64 + m * 16 + fr; const size_t off = (size_t)row * ldc + col0; float q = 0.f;
#pragma unroll
                for (int bj = 0; bj < 2; ++bj)
#pragma unroll
                    for (int n = 0; n < 2; ++n) { const f32x4 bs = *(const f32x4*)(base + off + bj * HALF + n * 16); const f32x4 o = bs + acc[ai][bj][m][n];
                        *(f32x4*)(out + off + bj * HALF + n * 16) = o; q += (o[0] * o[0] + o[1] * o[1]) + (o[2] * o[2] + o[3] * o[3]);
                        if (o16) { u32x2 w; w.x = pkh(o[0], o[1]); w.y = pkh(o[2], o[3]); *(u32x2*)(o16 + off + bj * HALF + n * 16) = w; } }
                q += __shfl_xor(q, 16); q += __shfl_xor(q, 32);
                if (fq == 0) atomicAdd(ss + row, q); }
    }
};

template <class Epi, class Sched>
__device__ __forceinline__ void gemm_phase(PG8_LAS unsigned char* lds, const Gemm g, const Sched& S, const Epi& E) {
    const int tid = threadIdx.x, wid = __builtin_amdgcn_readfirstlane(tid >> 6), lane = tid & 63, wr = wid >> 2, wc = wid & 3, fr = lane & 15, fq = lane >> 4;
    const int K = g.K, nt = K / BK;
    unsigned voffA[2], voffB[2];
#pragma unroll
    for (int i = 0; i < 2; ++i) { int R, C; stage_rc(tid * 16 + i * 8192, R, C); const int Rb = Epi::PERM ? ((R & ~31) + perm32(R & 31)) : R;
        voffA[i] = (unsigned)(R * K + C) * 2u; voffB[i] = (unsigned)(Rb * K + C) * 2u; }
    const size_t kstep = (size_t)(BK * 2);
    const size_t hstep = (size_t)HALF * K * 2;
    const size_t tstep = 2 * hstep;
    const unsigned ldsw = (unsigned)wid * 1024u;
    const int aoff = lds_byte(wr * 64 + fr, fq * 8), boff = lds_byte(wc * 32 + fr, fq * 8);
#define PG8_SA(b, h) (((b) * 2 + (h)) * HTB)
#define PG8_SB(b, h) ((4 + (b) * 2 + (h)) * HTB)
#define PG8_STAGE(bufoff, gbase, voff) do { _Pragma("unroll") for (int _i = 0; _i < 2; ++_i) \
        __builtin_amdgcn_global_load_lds((const unsigned*)((const char*)(gbase) + (voff)[_i]), (PG8_LAS unsigned*)(lds + (bufoff) + ldsw + _i * 8192), 16, 0, 0); } while (0)
#define PG8_LDA(dst, b, h) do { _Pragma("unroll") for (int m = 0; m < 4; ++m) _Pragma("unroll") for (int k = 0; k < 2; ++k) dst[m][k] = *(const PG8_LAS h16x8*)(lds + PG8_SA(b, h) + aoff + m * 2048 + k * 1024); } while (0)
#define PG8_LDB(dst, b, h) do { _Pragma("unroll") for (int n = 0; n < 2; ++n) _Pragma("unroll") for (int k = 0; k < 2; ++k) dst[n][k] = *(const PG8_LAS h16x8*)(lds + PG8_SB(b, h) + boff + n * 2048 + k * 1024); } while (0)
#define PG8_MMA(ai, bj, At, Bt) do { __builtin_amdgcn_s_setprio(1); _Pragma("unroll") for (int m = 0; m < 4; ++m) _Pragma("unroll") for (int n = 0; n < 2; ++n) _Pragma("unroll") for (int k = 0; k < 2; ++k) \
        acc[ai][bj][m][n] = __builtin_amdgcn_mfma_f32_16x16x32_f16(Bt[n][k], At[m][k], acc[ai][bj][m][n], 0, 0, 0); __builtin_amdgcn_s_setprio(0); } while (0)
#define PG8_WAIT_V(n) asm volatile("s_waitcnt vmcnt(" #n ")" ::: "memory")
#define PG8_WAIT_L(n) asm volatile("s_waitcnt lgkmcnt(" #n ")" ::: "memory")
#define PG8_BAR __builtin_amdgcn_s_barrier()
#define PG8_SCHED __builtin_amdgcn_sched_barrier(0)
    Unit cur, nxt; int ui = 0;
    if (!S.next(0, cur)) return;
    f32x4 acc[2][2][4][2];
#pragma unroll
    for (int a = 0; a < 2; ++a)
#pragma unroll
        for (int b = 0; b < 2; ++b)
#pragma unroll
            for (int m = 0; m < 4; ++m)
#pragma unroll
                for (int n = 0; n < 2; ++n) acc[a][b][m][n] = (f32x4){0.f, 0.f, 0.f, 0.f};
    h16x8 At[4][2], B0[2][2], B1[2][2];
    const char* cA = (const char*)g.A + (size_t)cur.pm * tstep; const char* cB = (const char*)g.Bt + (size_t)cur.pn * tstep;
    PG8_STAGE(PG8_SB(0, 0), cB, voffB); PG8_STAGE(PG8_SB(0, 1), cB + hstep, voffB); PG8_STAGE(PG8_SA(0, 0), cA, voffA); PG8_STAGE(PG8_SA(0, 1), cA + hstep, voffA);
    if (wr == 1) PG8_BAR;
    PG8_WAIT_V(2); PG8_BAR;
    PG8_STAGE(PG8_SB(1, 0), cB + kstep, voffB); PG8_STAGE(PG8_SA(1, 0), cA + kstep, voffA); PG8_STAGE(PG8_SB(1, 1), cB + hstep + kstep, voffB);
    PG8_WAIT_V(6); PG8_BAR;
    for (;;) {
        const bool has_next = S.next(ui + 1, nxt);
        const char* nA = has_next ? (const char*)g.A + (size_t)nxt.pm * tstep : cA; const char* nB = has_next ? (const char*)g.Bt + (size_t)nxt.pn * tstep : cB;
        for (int t = 0; t < nt; t += 2) {
            const bool last = (t == nt - 2);
            const char* a1 = cA + (size_t)(t + 1) * kstep;
            const char* a2 = last ? nA : cA + (size_t)(t + 2) * kstep; const char* b2 = last ? nB : cB + (size_t)(t + 2) * kstep;
            const char* a3 = a2 + kstep; const char* b3 = b2 + kstep;
            PG8_LDB(B0, 0, 0); PG8_LDB(B1, 0, 1); PG8_SCHED; PG8_LDA(At, 0, 0); PG8_STAGE(PG8_SA(1, 1), a1 + hstep, voffA);
            PG8_WAIT_V(8); PG8_WAIT_L(0); PG8_BAR; PG8_MMA(0, 0, At, B0); PG8_MMA(0, 1, At, B1); PG8_BAR; PG8_SCHED;
            PG8_LDA(At, 0, 1); PG8_STAGE(PG8_SB(0, 0), b2, voffB); PG8_STAGE(PG8_SB(0, 1), b2 + hstep, voffB); PG8_STAGE(PG8_SA(0, 0), a2, voffA);
            PG8_WAIT_V(8); PG8_WAIT_L(0); PG8_BAR; PG8_MMA(1, 0, At, B0); PG8_MMA(1, 1, At, B1); PG8_BAR; PG8_SCHED;
            PG8_LDB(B0, 1, 0); PG8_LDB(B1, 1, 1); PG8_SCHED; PG8_LDA(At, 1, 0); PG8_STAGE(PG8_SA(0, 1), a2 + hstep, voffA);
            PG8_WAIT_V(8); PG8_WAIT_L(0); PG8_BAR; PG8_MMA(0, 0, At, B0); PG8_MMA(0, 1, At, B1); PG8_BAR; PG8_SCHED;
            PG8_LDA(At, 1, 1); PG8_STAGE(PG8_SB(1, 0), b3, voffB); PG8_STAGE(PG8_SB(1, 1), b3 + hstep, voffB); PG8_STAGE(PG8_SA(1, 0), a3, voffA);
            PG8_WAIT_V(8); PG8_WAIT_L(0); PG8_BAR; PG8_MMA(1, 0, At, B0); PG8_MMA(1, 1, At, B1); PG8_BAR; PG8_SCHED;
        }
        if (wr == 0) PG8_BAR;
        E(acc, cur, wr, wc, fr, fq);
        if (!has_next) break;
#pragma unroll
        for (int a = 0; a < 2; ++a)
#pragma unroll
            for (int b = 0; b < 2; ++b)
#pragma unroll
                for (int m = 0; m < 4; ++m)
#pragma unroll
                    for (int n = 0; n < 2; ++n) acc[a][b][m][n] = (f32x4){0.f, 0.f, 0.f, 0.f};
        cur = nxt; cA = nA; cB = nB; ++ui;
        if (wr == 1) PG8_BAR;
    }
    PG8_WAIT_V(0);
    PG8_BAR;
#undef PG8_SA
#undef PG8_SB
#undef PG8_STAGE
#undef PG8_LDA
#undef PG8_LDB
#undef PG8_MMA
#undef PG8_WAIT_V
#undef PG8_WAIT_L
#undef PG8_BAR
#undef PG8_SCHED
}
}
constexpr int NWAVES = 8, NTHREADS = 512;
constexpr int DM = 2048, BATCH = 8, SEQ = 2048, MTOK = BATCH * SEQ, MEMLEN = 256, MMEM = BATCH * MEMLEN;
constexpr int INC = 7440, PW = 7680;
constexpr int RW0 = 4128;
constexpr int FF = 8192;
constexpr float RMS_EPS = 1e-6f;
constexpr size_t MiB = 1u << 20;
constexpr size_t WS_CTL = 0, CTL_ZERO_BYTES = 1 * MiB;
constexpr size_t CTL_SS1 = 65536, CTL_SS2 = 131072, CTL_SS3 = 196608;
constexpr size_t WS_WALL = 2 * MiB;
constexpr size_t WS_WOUT = 36 * MiB, WS_WQ = 44 * MiB, WS_WO = 46 * MiB, WS_W1 = 48 * MiB, WS_W2 = 80 * MiB;
constexpr size_t WS_LORA = 112 * MiB;
constexpr size_t WS_KV = 113 * MiB;
constexpr size_t WS_Q = 117 * MiB, WS_AO = 133 * MiB;
constexpr size_t WS_C = 150 * MiB;
constexpr size_t WS_P = WS_C;
constexpr size_t WS_OMIX = WS_C + 240 * MiB;
constexpr size_t WS_HID = WS_C;
constexpr size_t WS_H1 = WS_C;
constexpr size_t WS_H2 = WS_C + 256 * MiB;
constexpr size_t WS_END = WS_C + 320 * MiB;

constexpr int LDS_BYTES = 163840;

#define GAS __attribute__((address_space(1)))
#define LAS __attribute__((address_space(3)))
typedef unsigned short h16;
typedef float f32x4 __attribute__((ext_vector_type(4)));
typedef float f32x2 __attribute__((ext_vector_type(2)));
typedef unsigned v4u __attribute__((ext_vector_type(4)));
typedef unsigned v2u __attribute__((ext_vector_type(2)));
typedef _Float16 h16x8 __attribute__((ext_vector_type(8)));
typedef _Float16 h16x4 __attribute__((ext_vector_type(4)));
using pg8::pkh;
__device__ __forceinline__ float h2f(h16 v) { return (float)__builtin_bit_cast(_Float16, v); }
__device__ __forceinline__ h16 f2h(float v) { return __builtin_bit_cast(h16, (_Float16)v); }
__device__ __forceinline__ float sigmoidf_(float x) { return 1.0f / (1.0f + __expf(-x)); }
__device__ __forceinline__ float softplusf_(float x) { return x > 20.f ? x : log1pf(__expf(x)); }
__device__ __forceinline__ float dppf(float v, int ctrl);
template <int CTRL> __device__ __forceinline__ float dpp_(float v) { return __builtin_bit_cast(float, __builtin_amdgcn_update_dpp(0, __builtin_bit_cast(int, v), CTRL, 0xf, 0xf, true)); }
__device__ __forceinline__ float red8(float x) { x += dpp_<0xB1>(x); x += dpp_<0x4E>(x); x += dpp_<0x141>(x); return x; }
__device__ __forceinline__ float red16(float x) { x += __shfl_xor(x, 1); x += __shfl_xor(x, 2); x += __shfl_xor(x, 4); x += __shfl_xor(x, 8); return x; }
__device__ __forceinline__ float wave_sum(float v) {
#pragma unroll
    for (int o = 1; o < 64; o <<= 1) v += __shfl_xor(v, o);
    return v;
}

struct Args {
    const float* in[30]; float* out; unsigned char* ws; int ph_lo, ph_hi;
};
struct Frame {
    LAS unsigned char* lds; int tid, lane, wave, G, bid;
};

__device__ __forceinline__ void tr_item(const float* W, int N, int K, h16* WT, const float* kscale, LAS float* scr, int k0, int nsrc0, int nvalid, int ndst0, int lane) {
    const int j = lane & 31;
#pragma unroll 8
    for (int i = 0; i < 32; ++i) { const int kk = 2 * i + (lane >> 5); float v = 0.f; if (j < nvalid) { v = W[(size_t)(k0 + kk) * N + nsrc0 + j]; if (kscale) v *= kscale[k0 + kk]; } scr[kk * 33 + j] = v; }
    asm volatile("s_waitcnt lgkmcnt(0)" ::: "memory");
    const int c = lane & 7;
#pragma unroll
    for (int jj = 0; jj < 4; ++jj) { const int n = (lane >> 3) + 8 * jj; const LAS float* s = scr + (8 * c) * 33 + n;
        v4u o; o.x = pkh(s[0 * 33], s[1 * 33]); o.y = pkh(s[2 * 33], s[3 * 33]); o.z = pkh(s[4 * 33], s[5 * 33]); o.w = pkh(s[6 * 33], s[7 * 33]);
        *(GAS v4u*)(WT + (size_t)(ndst0 + n) * K + k0 + 8 * c) = o; }
    asm volatile("s_waitcnt lgkmcnt(0)" ::: "memory");
}
__device__ __forceinline__ void rms_row_to_f16(const float* xrow, const float* w, h16* orow, int lane) {
    const GAS f32x4* xr = (const GAS f32x4*)xrow + lane; const GAS f32x4* wr = (const GAS f32x4*)w + lane;
    f32x4 v[8]; float s = 0.f;
#pragma unroll
    for (int j = 0; j < 8; ++j) { v[j] = xr[64 * j]; s += (v[j].x * v[j].x + v[j].y * v[j].y) + (v[j].z * v[j].z + v[j].w * v[j].w); }
    const float rstd = __builtin_amdgcn_rsqf(wave_sum(s) * (1.f / DM) + RMS_EPS);
    GAS v2u* o8 = (GAS v2u*)orow + lane;
#pragma unroll
    for (int j = 0; j < 8; ++j) { const f32x4 ww = wr[64 * j]; v2u o; o.x = pkh(v[j].x * rstd * ww.x, v[j].y * rstd * ww.y); o.y = pkh(v[j].z * rstd * ww.z, v[j].w * rstd * ww.w); o8[64 * j] = o; }
}
__device__ __forceinline__ void p0_prologue(const Frame& F, const Args& a) {
    LAS float* scr = (LAS float*)(F.lds + F.wave * 16384);
    unsigned char* ws = a.ws;
    const int gw = F.bid * NWAVES + F.wave, NGW = F.G * NWAVES, lane = F.lane;
    constexpr int I_IN = 240 * 32, I_K = 16 * 32, I_V = 16 * 32, I_OUT = 64 * 32, I_Q = 16 * 32, I_O = 64 * 8, I_1 = 256 * 32, I_2 = 64 * 128, I_LW = 32, I_LA = 32, I_LG = 64;
    constexpr int NITEMS = I_IN + I_K + I_V + I_OUT + I_Q + I_O + I_1 + I_2 + I_LW + I_LA + I_LG;
    h16* wall = (h16*)(ws + WS_WALL);
    for (int it = gw; it < NITEMS; it += NGW) {
        int r = it;
        if (r < I_IN) { const int nb = r % 240, kb = r / 240; int ns, nv;
            if (nb < 128) { ns = 32 * nb; nv = 32; } else if (nb == 128) { ns = 4096; nv = 16; } else if (nb < 233) { ns = 4112 + 32 * (nb - 129); nv = 32; } else { ns = 0; nv = 0; }
            tr_item(a.in[3], INC, DM, wall, nullptr, scr, 64 * kb, ns, nv, 32 * nb, lane); continue; } r -= I_IN;
        if (r < I_K) { tr_item(a.in[23], 512, DM, wall, nullptr, scr, 64 * (r / 16), 32 * (r % 16), 32, 7680 + 32 * (r % 16), lane); continue; } r -= I_K;
        if (r < I_V) { tr_item(a.in[24], 512, DM, wall, nullptr, scr, 64 * (r / 16), 32 * (r % 16), 32, 8192 + 32 * (r % 16), lane); continue; } r -= I_V;
        if (r < I_OUT) { tr_item(a.in[19], DM, DM, (h16*)(ws + WS_WOUT), nullptr, scr, 64 * (r / 64), 32 * (r % 64), 32, 32 * (r % 64), lane); continue; } r -= I_OUT;
        if (r < I_Q) { tr_item(a.in[22], 512, DM, (h16*)(ws + WS_WQ), a.in[20], scr, 64 * (r / 16), 32 * (r % 16), 32, 32 * (r % 16), lane); continue; } r -= I_Q;
        if (r < I_O) { tr_item(a.in[25], DM, 512, (h16*)(ws + WS_WO), nullptr, scr, 64 * (r / 64), 32 * (r % 64), 32, 32 * (r % 64), lane); continue; } r -= I_O;
        if (r < I_1) { tr_item(a.in[27], FF, DM, (h16*)(ws + WS_W1), a.in[26], scr, 64 * (r / 256), 32 * (r % 256), 32, 32 * (r % 256), lane); continue; } r -= I_1;
        if (r < I_2) { tr_item(a.in[28], DM, FF, (h16*)(ws + WS_W2), nullptr, scr, 64 * (r / 64), 32 * (r % 64), 32, 32 * (r % 64), lane); continue; } r -= I_2;
        if (r < I_LW) { tr_item(a.in[10], 1024, 64, (h16*)(ws + WS_LORA), nullptr, scr, 0, 32 * r, 32, 32 * r, lane); continue; } r -= I_LW;
        if (r < I_LA) { tr_item(a.in[12], 1024, 64, (h16*)(ws + WS_LORA + 131072), nullptr, scr, 0, 32 * r, 32, 32 * r, lane); continue; } r -= I_LA;
        tr_item(a.in[13], 1024, 128, (h16*)(ws + WS_LORA + 262144), nullptr, scr, 64 * (r / 32), 32 * (r % 32), 32, 32 * (r % 32), lane);
    }
    h16* aall = (h16*)a.out;
    for (int m = gw; m < MTOK + MMEM; m += NGW) {
        if (m < MTOK) rms_row_to_f16(a.in[0] + (size_t)m * DM, a.in[2], aall + (size_t)m * DM, lane);
        else rms_row_to_f16(a.in[1] + (size_t)(m - MTOK) * DM, a.in[21], aall + (size_t)m * DM, lane);
    }
}
constexpr int DC_P = 136;
constexpr int DCL_RAWQ = 0, DCL_RAWK = DCL_RAWQ + 64 * DC_P * 2, DCL_VV = DCL_RAWK + 64 * DC_P * 2, DCL_QH = DCL_VV + 64 * DC_P * 2, DCL_KH = DCL_QH + 64 * DC_P * 2, DCL_KBH = DCL_KH + 64 * DC_P * 2,
              DCL_KDT = DCL_KBH + 64 * DC_P * 2, DCL_ATT = DCL_KDT + 4 * 128 * 16 * 2, DCL_AMT = DCL_ATT + 64 * 24 * 2, DCL_SM = DCL_AMT + 4 * 16 * 20 * 4, DCL_END = DCL_SM + 2048;
constexpr int DCL_QG = DCL_RAWQ, DCL_XW = DCL_QH  , DCL_OS = DCL_VV;
static_assert(64 * 264 * 2 <= 2 * 64 * DC_P * 2 && DCL_END <= LDS_BYTES, "DN LDS map");
__device__ __forceinline__ void dn_chunked(const Frame& F, const Args& a, int unit) {
    const int b = unit >> 3, h = unit & 7;
    const int tid = F.tid, lane = F.lane, w = F.wave, l15 = lane & 15, lg = lane >> 4;
    LAS h16* RAWQ = (LAS h16*)(F.lds + DCL_RAWQ); LAS h16* RAWK = (LAS h16*)(F.lds + DCL_RAWK); LAS h16* VV = (LAS h16*)(F.lds + DCL_VV);
    LAS h16* QH = (LAS h16*)(F.lds + DCL_QH); LAS h16* KH = (LAS h16*)(F.lds + DCL_KH); LAS h16* KBH = (LAS h16*)(F.lds + DCL_KBH);
    LAS h16* KDT = (LAS h16*)(F.lds + DCL_KDT); LAS h16* ATT = (LAS h16*)(F.lds + DCL_ATT); LAS float* AMT = (LAS float*)(F.lds + DCL_AMT);
    LAS float* gS = (LAS float*)(F.lds + DCL_SM); LAS float* betaS = gS + 64; LAS float* egcS = gS + 128; LAS float* eclS = gS + 192; LAS float* gcS = gS + 256;
    LAS h16* QG = (LAS h16*)(F.lds + DCL_QG); LAS h16* XW = (LAS h16*)(F.lds + DCL_XW); LAS h16* OS = (LAS h16*)(F.lds + DCL_OS);
    const h16* P = (const h16*)(a.ws + WS_P); h16* omix = (h16*)(a.ws + WS_OMIX);
    const size_t row0 = (size_t)b * SEQ;
    const bool is_col = tid < 384, is_g = (tid >= 384 && tid < 448);
    const int cp = tid % 192, rg = tid / 192;
    int pcol = 0; f32x2 cw0 = {0.f, 0.f}, cw1 = cw0, cw2 = cw0, cw3 = cw0;
    if (is_col) { pcol = (cp >> 6) * 1024 + h * 128 + 2 * (cp & 63); const float* cw = a.in[4]; cw0 = *(const f32x2*)(cw + pcol); cw1 = *(const f32x2*)(cw + 3072 + pcol); cw2 = *(const f32x2*)(cw + 6144 + pcol); cw3 = *(const f32x2*)(cw + 9216 + pcol); }
    const float neg_ea = -__expf(a.in[5][h]), dtb = a.in[6][h];
    const int pt = tid >> 3, pp = tid & 7;
    unsigned raw[35]; h16 rg0 = 0, rg1 = 0;
    pg8::f32x4 S[8];
#pragma unroll
    for (int i = 0; i < 8; ++i) S[i] = (pg8::f32x4){0.f, 0.f, 0.f, 0.f};
    const __amdgpu_buffer_rsrc_t prs = __builtin_amdgcn_make_buffer_rsrc((void*)(P - 3 * PW), (short)0, (MTOK + 3) * PW * 2, 0x00020000);
#define DC_LOAD_RAW(t0_) do { if (is_col) { const int tb = (t0_) + 32 * rg; const unsigned vo = (unsigned)((row0 + tb) * PW + pcol) * 2u; \
            _Pragma("unroll") for (int i = 0; i < 35; ++i) { const unsigned v = __builtin_amdgcn_raw_buffer_load_b32(prs, vo, i * PW * 2, 0); raw[i] = (tb + i >= 3) ? v : 0u; } } \
        else if (is_g) { const int t = (t0_) + (tid - 384); rg0 = P[(row0 + t) * PW + 4096 + h]; rg1 = P[(row0 + t) * PW + 4104 + h]; } } while (0)
    DC_LOAD_RAW(0);
    for (int bt = 0; bt < SEQ / 64; ++bt) {
        const int t0 = bt * 64;
        if (is_col) { LAS h16* dst = (cp < 64 ? RAWQ : (cp < 128 ? RAWK : VV)) + 2 * (cp & 63);
#pragma unroll
            for (int t = 0; t < 32; ++t) { f32x2 y = {0.f, 0.f};
#pragma unroll
                for (int j = 0; j < 4; ++j) { const unsigned rw = raw[t + j]; const f32x2 x = {h2f((h16)(rw & 0xffff)), h2f((h16)(rw >> 16))}; y += (j == 0 ? cw0 : j == 1 ? cw1 : j == 2 ? cw2 : cw3) * x; }
                y.x = y.x * sigmoidf_(y.x); y.y = y.y * sigmoidf_(y.y);
                *(LAS unsigned*)(dst + (32 * rg + t) * DC_P) = pkh(y.x, y.y); if ((t & 7) == 7) __builtin_amdgcn_sched_barrier(0); }
        } else if (is_g) { const int t = tid - 384; gS[t] = neg_ea * softplusf_(h2f(rg0) + dtb); betaS[t] = sigmoidf_(h2f(rg1)); }
        __syncthreads();
        { const int t = pt, c16 = t & ~15; float gc = 0.f, gl = 0.f;
            for (int i = 0; i < 16; ++i) { const float gv = gS[c16 + i]; gl += gv; if (c16 + i <= t) gc += gv; }
            const float egc = __expf(gc), ekd = __expf(gl - gc), beta = betaS[t];
            if (pp == 0) { egcS[t] = egc; gcS[t] = gc; if ((t & 15) == 15) eclS[t >> 4] = __expf(gl); }
            const LAS h16* qp = RAWQ + t * DC_P + 16 * pp; const LAS h16* kp = RAWK + t * DC_P + 16 * pp;
            const h16x8 q0 = *(const LAS h16x8*)qp, q1 = *(const LAS h16x8*)(qp + 8), k0 = *(const LAS h16x8*)kp, k1 = *(const LAS h16x8*)(kp + 8);
            float qf[16], kf[16]; float sq = 0.f, sk = 0.f;
#pragma unroll
            for (int i = 0; i < 8; ++i) { qf[i] = (float)q0[i]; qf[8 + i] = (float)q1[i]; kf[i] = (float)k0[i]; kf[8 + i] = (float)k1[i]; }
#pragma unroll
            for (int i = 0; i < 16; ++i) { sq += qf[i] * qf[i]; sk += kf[i] * kf[i]; }
            sq = red8(sq); sk = red8(sk);
            const float rq = __builtin_amdgcn_rsqf(sq + 1e-6f) * 0.08838834764831845f, rk = __builtin_amdgcn_rsqf(sk + 1e-6f);
            unsigned oq[8], og[8], ok[8], ob[8];
#pragma unroll
            for (int i = 0; i < 8; ++i) { const float qa = qf[2 * i] * rq, qb = qf[2 * i + 1] * rq, ka = kf[2 * i] * rk, kb = kf[2 * i + 1] * rk;
                oq[i] = pkh(qa, qb); og[i] = pkh(qa * egc, qb * egc); ok[i] = pkh(ka, kb); ob[i] = pkh(ka * beta, kb * beta);
                KDT[((t >> 4) * 128 + 16 * pp + 2 * i) * 16 + (t & 15)] = f2h(ka * ekd); KDT[((t >> 4) * 128 + 16 * pp + 2 * i + 1) * 16 + (t & 15)] = f2h(kb * ekd); }
            *(LAS v4u*)(QH + t * DC_P + 16 * pp) = (v4u){oq[0], oq[1], oq[2], oq[3]}; *(LAS v4u*)(QH + t * DC_P + 16 * pp + 8) = (v4u){oq[4], oq[5], oq[6], oq[7]};
            *(LAS v4u*)(QG + t * DC_P + 16 * pp) = (v4u){og[0], og[1], og[2], og[3]}; *(LAS v4u*)(QG + t * DC_P + 16 * pp + 8) = (v4u){og[4], og[5], og[6], og[7]};
            *(LAS v4u*)(KH + t * DC_P + 16 * pp) = (v4u){ok[0], ok[1], ok[2], ok[3]}; *(LAS v4u*)(KH + t * DC_P + 16 * pp + 8) = (v4u){ok[4], ok[5], ok[6], ok[7]};
            *(LAS v4u*)(KBH + t * DC_P + 16 * pp) = (v4u){ob[0], ob[1], ob[2], ob[3]}; *(LAS v4u*)(KBH + t * DC_P + 16 * pp + 8) = (v4u){ob[4], ob[5], ob[6], ob[7]}; }
        __syncthreads();
        { const int c = w & 3, which = w >> 2; const LAS h16* Am = (which ? QH : KBH) + (16 * c + l15) * DC_P + 8 * lg; const LAS h16* Bm = KH + (16 * c + l15) * DC_P + 8 * lg;
            pg8::f32x4 acc = {0.f, 0.f, 0.f, 0.f};
#pragma unroll
            for (int ks = 0; ks < 4; ++ks) acc = __builtin_amdgcn_mfma_f32_16x16x32_f16(*(const LAS h16x8*)(Am + 32 * ks), *(const LAS h16x8*)(Bm + 32 * ks), acc, 0, 0, 0);
            const float gj = gcS[16 * c + l15];
#pragma unroll
            for (int r = 0; r < 4; ++r) { const int i = 4 * lg + r, j = l15; const float dec = __expf(gcS[16 * c + i] - gj);
                if (which) ATT[(16 * c + i) * 24 + j] = f2h(i >= j ? acc[r] * dec : 0.f); else AMT[(c * 16 + j) * 20 + i] = (i > j ? acc[r] * dec : 0.f); } }
        __syncthreads();
#pragma unroll 1
        for (int pass = 0; pass < 2; ++pass) { const int c = (tid >> 8) + 2 * pass, col = tid & 255; float x[16];
#pragma unroll
            for (int i = 0; i < 16; ++i) { const int t = 16 * c + i; x[i] = col < 128 ? h2f(VV[t * DC_P + col]) * betaS[t] : h2f(KBH[t * DC_P + col - 128]) * egcS[t]; }
#pragma unroll
            for (int j = 0; j < 15; ++j) { const LAS float* ap = AMT + (c * 16 + j) * 20;
#pragma unroll
                for (int i = j + 1; i < 16; ++i) x[i] -= ap[i] * x[j]; }
#pragma unroll
            for (int i = 0; i < 16; ++i) XW[(16 * c + i) * 264 + col] = f2h(x[i]); }
        __syncthreads();
        if (bt + 1 < SEQ / 64) DC_LOAD_RAW(t0 + 64);
#pragma unroll 1
        for (int c = 0; c < 4; ++c) { const int T0 = 16 * c;
            h16x8 sf[4];
#pragma unroll
            for (int s = 0; s < 4; ++s) { const v4u t = {pkh(S[2 * s][0], S[2 * s][1]), pkh(S[2 * s][2], S[2 * s][3]), pkh(S[2 * s + 1][0], S[2 * s + 1][1]), pkh(S[2 * s + 1][2], S[2 * s + 1][3])}; sf[s] = __builtin_bit_cast(h16x8, t); }
            pg8::f32x4 av = {0.f, 0.f, 0.f, 0.f}, ao = av;
#pragma unroll
            for (int s = 0; s < 4; ++s) { const LAS h16* wp = XW + (T0 + l15) * 264 + 128 + 32 * s + 4 * lg; const v2u lo = *(const LAS v2u*)wp, hi = *(const LAS v2u*)(wp + 16);
                av = __builtin_amdgcn_mfma_f32_16x16x32_f16(__builtin_bit_cast(h16x8, (v4u){lo.x, lo.y, hi.x, hi.y}), sf[s], av, 0, 0, 0);
                const LAS h16* qp = QG + (T0 + l15) * DC_P + 32 * s + 4 * lg; const v2u ql = *(const LAS v2u*)qp, qh = *(const LAS v2u*)(qp + 16);
                ao = __builtin_amdgcn_mfma_f32_16x16x32_f16(__builtin_bit_cast(h16x8, (v4u){ql.x, ql.y, qh.x, qh.y}), sf[s], ao, 0, 0, 0); }
            float vn[4];
#pragma unroll
            for (int r = 0; r < 4; ++r) vn[r] = h2f(XW[(T0 + 4 * lg + r) * 264 + 16 * w + l15]) - av[r];
            const h16x8 vf = __builtin_bit_cast(h16x8, (v4u){pkh(vn[0], vn[1]), pkh(vn[2], vn[3]), 0u, 0u});
            { const v2u al = *(const LAS v2u*)(ATT + (T0 + l15) * 24 + 4 * lg); ao = __builtin_amdgcn_mfma_f32_16x16x32_f16(__builtin_bit_cast(h16x8, (v4u){al.x, al.y, 0u, 0u}), vf, ao, 0, 0, 0); }
            const float ecl = eclS[c];
#pragma unroll
            for (int tau = 0; tau < 8; ++tau) { const v2u kl = *(const LAS v2u*)(KDT + ((c * 128 + 16 * tau + l15) * 16) + 4 * lg);
                S[tau] = __builtin_amdgcn_mfma_f32_16x16x32_f16(__builtin_bit_cast(h16x8, (v4u){kl.x, kl.y, 0u, 0u}), vf, S[tau] * ecl, 0, 0, 0); }
#pragma unroll
            for (int r = 0; r < 4; ++r) OS[(T0 + 4 * lg + r) * DC_P + 16 * w + l15] = f2h(ao[r]);
        }
        __syncthreads();
        { const LAS h16* op = OS + pt * DC_P + 16 * pp; const h16x8 o0 = *(const LAS h16x8*)op, o1 = *(const LAS h16x8*)(op + 8);
            const GAS v4u* zp = (const GAS v4u*)(P + (row0 + t0 + pt) * PW + 3072 + h * 128 + 16 * pp); const v4u z0 = zp[0], z1 = zp[1];
            f32x4 nw[4];
#pragma unroll
            for (int j = 0; j < 4; ++j) nw[j] = *(const GAS f32x4*)(a.in[7] + 16 * pp + 4 * j);
            float of[16]; float s = 0.f;
#pragma unroll
            for (int i = 0; i < 8; ++i) { of[i] = (float)o0[i]; of[8 + i] = (float)o1[i]; }
#pragma unroll
            for (int i = 0; i < 16; ++i) s += of[i] * of[i];
            s = red8(s); const float rstd = __builtin_amdgcn_rsqf(s * (1.0f / 128.0f) + RMS_EPS);
            const unsigned zz[8] = {z0.x, z0.y, z0.z, z0.w, z1.x, z1.y, z1.z, z1.w}; unsigned ow[8];
#pragma unroll
            for (int i = 0; i < 8; ++i) { const float za = h2f((h16)(zz[i] & 0xffff)), zb = h2f((h16)(zz[i] >> 16)); const float wa = nw[i >> 1][(2 * i) & 3], wb = nw[i >> 1][(2 * i + 1) & 3];
                ow[i] = pkh(of[2 * i] * rstd * wa * za * sigmoidf_(za), of[2 * i + 1] * rstd * wb * zb * sigmoidf_(zb)); }
            GAS v4u* dst = (GAS v4u*)(omix + (row0 + t0 + pt) * DM + h * 128 + 16 * pp);
            dst[0] = (v4u){ow[0], ow[1], ow[2], ow[3]}; dst[1] = (v4u){ow[4], ow[5], ow[6], ow[7]}; }
        __syncthreads();
    }
#undef DC_LOAD_RAW
}
constexpr int RC_F = 65 * 64 * 4, RC_H = 72 * 64 * 2;
constexpr int RCL_RL = 0, RCL_PKL = RCL_RL + RC_F, RCL_GL = RCL_PKL + RC_F, RCL_ALR = RCL_GL + RC_F, RCL_GATE = RCL_ALR + RC_F, RCL_VH = RCL_GATE + RC_F, RCL_HW = RCL_VH + RC_H, RCL_HA = RCL_HW + RC_H,
              RCL_HG = RCL_HA + RC_H, RCL_BR = RCL_HG + 64 * 136 * 2, RCL_KR = RCL_BR + RC_H, RCL_KHT = RCL_KR + RC_H, RCL_WC = RCL_KHT + 8192, RCL_BON = RCL_WC + 1024, RCL_END = RCL_BON + 256;
constexpr int RCL_LT = RCL_RL, RCL_RHS2 = RCL_LT + 4352, RCL_MRB = RCL_RHS2 + 4352, RCL_MRK = RCL_MRB + 3072;
constexpr int RCL_WP = RCL_PKL, RCL_TL = RCL_WP + RC_H;
constexpr int RCL_YL = RCL_GL, RCL_ATF = RCL_ALR, RCL_AR = RCL_HW, RCL_RT = RCL_HA, RCL_RR = RCL_HG, RCL_BHT = RCL_HG + RC_H;
static_assert(RCL_MRK + 3072 <= RCL_PKL && RCL_TL + 3072 <= RCL_GL && RCL_BHT + 8192 <= RCL_BR && RCL_END <= LDS_BYTES, "RW LDS map");
__device__ __forceinline__ void rw_chunked(const Frame& F, const Args& a, int unit) {
    const int b = unit >> 4, h = unit & 15;
    const int tid0 = F.tid, w = F.wave;
    LAS float* RL = (LAS float*)(F.lds + RCL_RL); LAS float* PKL = (LAS float*)(F.lds + RCL_PKL); LAS float* GL = (LAS float*)(F.lds + RCL_GL); LAS float* ALR = (LAS float*)(F.lds + RCL_ALR);
    LAS float* GATE = (LAS float*)(F.lds + RCL_GATE); LAS h16* VH = (LAS h16*)(F.lds + RCL_VH); LAS h16* HW = (LAS h16*)(F.lds + RCL_HW); LAS h16* HA = (LAS h16*)(F.lds + RCL_HA); LAS h16* HG = (LAS h16*)(F.lds + RCL_HG);
    LAS h16* BR = (LAS h16*)(F.lds + RCL_BR); LAS h16* KR = (LAS h16*)(F.lds + RCL_KR); LAS h16* KHT = (LAS h16*)(F.lds + RCL_KHT); LAS float* WC = (LAS float*)(F.lds + RCL_WC); LAS float* BON = (LAS float*)(F.lds + RCL_BON);
    LAS float* LT = (LAS float*)(F.lds + RCL_LT); LAS float* RHS2 = (LAS float*)(F.lds + RCL_RHS2); LAS h16* MRB = (LAS h16*)(F.lds + RCL_MRB); LAS h16* MRK = (LAS h16*)(F.lds + RCL_MRK);
    LAS h16* WP = (LAS h16*)(F.lds + RCL_WP); LAS h16* TL = (LAS h16*)(F.lds + RCL_TL); LAS float* YL = (LAS float*)(F.lds + RCL_YL); LAS float* ATF = (LAS float*)(F.lds + RCL_ATF);
    LAS h16* AR = (LAS h16*)(F.lds + RCL_AR); LAS h16* RT = (LAS h16*)(F.lds + RCL_RT); LAS h16* RR = (LAS h16*)(F.lds + RCL_RR); LAS h16* BHT = (LAS h16*)(F.lds + RCL_BHT);
    const h16* P = (const h16*)(a.ws + WS_P); h16* omix = (h16*)(a.ws + WS_OMIX);
    const size_t row0 = (size_t)b * SEQ;
    const bool is_col = tid0 < 448; const int cp = tid0 % 224, rgp = tid0 / 224;
    int rcol = 0; f32x2 mu = {0.f, 0.f};
    if (is_col) { rcol = cp < 96 ? (cp >> 5) * 1024 + h * 64 + 2 * (cp & 31) : 3072 + 2 * (cp - 96); mu = *(const f32x2*)(a.in[8] + rcol); }
    int kind = 0, dstb = 0, dstride = 260;
    if (cp < 32) { dstb = RCL_RL + 8 * cp; } else if (cp < 64) { dstb = RCL_PKL + 8 * (cp - 32); } else if (cp < 96) { kind = 1; dstb = RCL_VH + 4 * (cp - 64); dstride = 144; }
    else if (cp < 128) { kind = 2; dstb = RCL_HW + 4 * (cp - 96); dstride = 144; } else if (cp < 160) { kind = 1; dstb = RCL_HA + 4 * (cp - 128); dstride = 144; } else { kind = 3; dstb = RCL_HG + 4 * (cp - 160); dstride = 272; }
    const __amdgpu_buffer_rsrc_t prs = __builtin_amdgcn_make_buffer_rsrc((void*)(P - PW), (short)0, (MTOK + 1) * PW * 2, 0x00020000);
    unsigned raw[33];
#define RC_LOAD_RAW(t0_) do { if (is_col) { const int tb = (t0_) + 32 * rgp; const unsigned vo = (unsigned)((row0 + tb) * PW + RW0 + rcol) * 2u; \
            _Pragma("unroll") for (int i = 0; i < 33; ++i) { const unsigned v = __builtin_amdgcn_raw_buffer_load_b32(prs, vo, i * PW * 2, 0); raw[i] = (tb + i >= 1) ? v : 0u; } } } while (0)
    const int mt = w & 3, ntp = w >> 2;
    pg8::f32x4 St[4];
#pragma unroll
    for (int i = 0; i < 4; ++i) St[i] = (pg8::f32x4){0.f, 0.f, 0.f, 0.f};
    RC_LOAD_RAW(0);
    for (int bt = 0; bt < SEQ / 64; ++bt) {
        const int t0 = bt * 64;
        int tid = tid0; asm volatile("" : "+v"(tid));
        const int lane = tid & 63, l15 = lane & 15, lg = lane >> 4, ft = tid >> 3, fp = tid & 7, hc0 = h * 64 + 8 * fp;
        if (is_col) { unsigned ad = (unsigned)(dstb + 32 * rgp * dstride); asm volatile("" : "+v"(ad));
#pragma unroll
            for (int t = 0; t < 32; ++t) { const unsigned rw = raw[t + 1], rp = raw[t]; const f32x2 x = {h2f((h16)(rw & 0xffff)), h2f((h16)(rw >> 16))}, xp = {h2f((h16)(rp & 0xffff)), h2f((h16)(rp >> 16))};
                f32x2 y = x + (xp - x) * mu;
                if (kind == 0) { *(LAS float*)(F.lds + ad) = y.x; *(LAS float*)(F.lds + ad + 4) = y.y; }
                else { if (kind == 2) { y.x = tanhf(y.x); y.y = tanhf(y.y); } else if (kind == 3) { y.x = sigmoidf_(y.x); y.y = sigmoidf_(y.y); } *(LAS unsigned*)(F.lds + ad) = pkh(y.x, y.y); }
                ad += dstride; if ((t & 7) == 7) __builtin_amdgcn_sched_barrier(0); }
        }
        __syncthreads();
#pragma unroll
        for (int q = 0; q < 2; ++q) { const int nt = 2 * ntp + q, n = 16 * nt + l15;
            const h16* w2T = (const h16*)(a.ws + WS_LORA) + (size_t)(h * 64 + n) * 64 + 8 * lg; const h16* a2T = (const h16*)(a.ws + WS_LORA + 131072) + (size_t)(h * 64 + n) * 64 + 8 * lg;
            const h16* g2T = (const h16*)(a.ws + WS_LORA + 262144) + (size_t)(h * 64 + n) * 128 + 8 * lg;
            pg8::f32x4 accw = {0.f, 0.f, 0.f, 0.f}, acca = accw, accg = accw;
#pragma unroll
            for (int ks = 0; ks < 2; ++ks) {
                accw = __builtin_amdgcn_mfma_f32_16x16x32_f16(*(const LAS h16x8*)(HW + (16 * mt + l15) * 72 + 32 * ks + 8 * lg), *(const GAS h16x8*)(w2T + 32 * ks), accw, 0, 0, 0);
                acca = __builtin_amdgcn_mfma_f32_16x16x32_f16(*(const LAS h16x8*)(HA + (16 * mt + l15) * 72 + 32 * ks + 8 * lg), *(const GAS h16x8*)(a2T + 32 * ks), acca, 0, 0, 0); }
#pragma unroll
            for (int ks = 0; ks < 4; ++ks) accg = __builtin_amdgcn_mfma_f32_16x16x32_f16(*(const LAS h16x8*)(HG + (16 * mt + l15) * 136 + 32 * ks + 8 * lg), *(const GAS h16x8*)(g2T + 32 * ks), accg, 0, 0, 0);
            const float c_w0 = a.in[9][h * 64 + n], c_a0 = a.in[11][h * 64 + n];
#pragma unroll
            for (int r = 0; r < 4; ++r) { const int tok = 16 * mt + 4 * lg + r; const float lw = -softplusf_(-(c_w0 + accw[r])) - 0.5f;
                GL[tok * 65 + n] = -__expf(lw); ALR[tok * 65 + n] = sigmoidf_(c_a0 + acca[r]); GATE[tok * 65 + n] = accg[r]; } }
        __syncthreads();
        if (tid < 256) { const int c = tid >> 6, n = tid & 63; float run = 0.f;
#pragma unroll
            for (int i = 0; i < 16; ++i) { run += GL[(16 * c + i) * 65 + n]; GL[(16 * c + i) * 65 + n] = run; } }
        __syncthreads();
        { const int t = ft, c16 = t & ~15, tl = t & 15, c = t >> 4;
            const f32x4 ckk0 = *(const GAS f32x4*)(a.in[14] + hc0), ckk1 = *(const GAS f32x4*)(a.in[14] + hc0 + 4), cka0 = *(const GAS f32x4*)(a.in[15] + hc0), cka1 = *(const GAS f32x4*)(a.in[15] + hc0 + 4),
                        crk0 = *(const GAS f32x4*)(a.in[16] + hc0), crk1 = *(const GAS f32x4*)(a.in[16] + hc0 + 4);
            const float ckk[8] = {ckk0.x, ckk0.y, ckk0.z, ckk0.w, ckk1.x, ckk1.y, ckk1.z, ckk1.w}, cka[8] = {cka0.x, cka0.y, cka0.z, cka0.w, cka1.x, cka1.y, cka1.z, cka1.w}, crk[8] = {crk0.x, crk0.y, crk0.z, crk0.w, crk1.x, crk1.y, crk1.z, crk1.w};
            float pk[8], rr[8], al[8], kk[8], kf[8], bb[8]; float ss = 0.f, bon = 0.f;
#pragma unroll
            for (int i = 0; i < 8; ++i) { pk[i] = PKL[t * 65 + 8 * fp + i]; rr[i] = RL[t * 65 + 8 * fp + i]; al[i] = ALR[t * 65 + 8 * fp + i]; kk[i] = pk[i] * ckk[i]; ss += kk[i] * kk[i]; }
            ss = red8(ss); const float inv = 1.0f / fmaxf(sqrtf(ss), 1e-12f);
#pragma unroll
            for (int i = 0; i < 8; ++i) { kk[i] *= inv; kf[i] = pk[i] * (1.0f + (al[i] - 1.0f) * cka[i]); bb[i] = kk[i] * al[i]; bon += rr[i] * kf[i] * crk[i]; }
            bon = red8(bon); if (fp == 0) BON[t] = bon;
            unsigned oar[4], ort[4], orr[4], obr[4], okr[4];
#pragma unroll
            for (int i = 0; i < 8; i += 2) { float va[2], vr[2], vrr[2], vb[2], vk[2];
#pragma unroll
                for (int e = 0; e < 2; ++e) { const int n = 8 * fp + i + e; const float Gt = GL[t * 65 + n], Gp = tl ? GL[(t - 1) * 65 + n] : 0.f, Gl = GL[(c16 + 15) * 65 + n], Gr = GL[(c16 + 7) * 65 + n];
                    const float ap = -kk[i + e];
                    ATF[t * 65 + n] = ap * __expf(Gp); va[e] = ap * __expf(Gp - Gr); vr[e] = rr[i + e] * __expf(Gt); vrr[e] = rr[i + e] * __expf(Gt - Gr);
                    const float er = __expf(Gr - Gt), el = __expf(Gl - Gt); vb[e] = bb[i + e] * er; vk[e] = kf[i + e] * er;
                    BHT[(c * 64 + n) * 16 + tl] = f2h(bb[i + e] * el); KHT[(c * 64 + n) * 16 + tl] = f2h(kf[i + e] * el);
                    if (tl == 15) WC[c * 64 + n] = __expf(Gl); }
                oar[i >> 1] = pkh(va[0], va[1]); ort[i >> 1] = pkh(vr[0], vr[1]); orr[i >> 1] = pkh(vrr[0], vrr[1]); obr[i >> 1] = pkh(vb[0], vb[1]); okr[i >> 1] = pkh(vk[0], vk[1]); }
            *(LAS v4u*)(AR + t * 72 + 8 * fp) = (v4u){oar[0], oar[1], oar[2], oar[3]}; *(LAS v4u*)(RT + t * 72 + 8 * fp) = (v4u){ort[0], ort[1], ort[2], ort[3]};
            *(LAS v4u*)(RR + t * 72 + 8 * fp) = (v4u){orr[0], orr[1], orr[2], orr[3]}; *(LAS v4u*)(BR + t * 72 + 8 * fp) = (v4u){obr[0], obr[1], obr[2], obr[3]};
            *(LAS v4u*)(KR + t * 72 + 8 * fp) = (v4u){okr[0], okr[1], okr[2], okr[3]}; }
        __syncthreads();
        { const int c = w & 3, rt = w >> 2; const LAS h16* Am = (rt ? RR : AR) + (16 * c + l15) * 72 + 8 * lg;
#pragma unroll
            for (int ct = 0; ct < 2; ++ct) { const LAS h16* Bm = (ct ? KR : BR) + (16 * c + l15) * 72 + 8 * lg; pg8::f32x4 acc = {0.f, 0.f, 0.f, 0.f};
#pragma unroll
                for (int ks = 0; ks < 2; ++ks) acc = __builtin_amdgcn_mfma_f32_16x16x32_f16(*(const LAS h16x8*)(Am + 32 * ks), *(const LAS h16x8*)(Bm + 32 * ks), acc, 0, 0, 0);
#pragma unroll
                for (int r = 0; r < 4; ++r) { const int t = 4 * lg + r, i = l15;
                    if (rt == 0) { const float v = t > i ? acc[r] : 0.f; if (ct == 0) LT[(c * 16 + i) * 17 + t] = v; else RHS2[(c * 16 + t) * 17 + i] = v; }
                    else { const h16 v = f2h(t >= i ? acc[r] : 0.f); if (ct == 0) MRB[(16 * c + t) * 24 + i] = v; else MRK[(16 * c + t) * 24 + i] = v; } } } }
        __syncthreads();
        if (tid < 320) { const int c = tid / 80, col = tid % 80; float x[16];
#pragma unroll
            for (int i = 0; i < 16; ++i) x[i] = col < 64 ? ATF[(16 * c + i) * 65 + col] : RHS2[(c * 16 + i) * 17 + col - 64];
#pragma unroll
            for (int j = 0; j < 15; ++j) { const LAS float* lp = LT + (c * 16 + j) * 17;
#pragma unroll
                for (int i = j + 1; i < 16; ++i) x[i] += lp[i] * x[j]; }
#pragma unroll
            for (int i = 0; i < 16; ++i) { if (col < 64) WP[(16 * c + i) * 72 + col] = f2h(x[i]); else TL[(16 * c + i) * 24 + col - 64] = f2h(x[i]); } }
        __syncthreads();
        if (bt + 1 < SEQ / 64) RC_LOAD_RAW(t0 + 64);
        if (w < 4) {
#pragma unroll 1
            for (int c = 0; c < 4; ++c) { const int T0 = 16 * c;
                h16x8 sf[2];
#pragma unroll
                for (int s = 0; s < 2; ++s) { const v4u t = {pkh(St[2 * s][0], St[2 * s][1]), pkh(St[2 * s][2], St[2 * s][3]), pkh(St[2 * s + 1][0], St[2 * s + 1][1]), pkh(St[2 * s + 1][2], St[2 * s + 1][3])}; sf[s] = __builtin_bit_cast(h16x8, t); }
                float vv[4];
#pragma unroll
                for (int r = 0; r < 4; ++r) vv[r] = h2f(VH[(T0 + 4 * lg + r) * 72 + 16 * w + l15]);
                const h16x8 vf = __builtin_bit_cast(h16x8, (v4u){pkh(vv[0], vv[1]), pkh(vv[2], vv[3]), 0u, 0u});
                pg8::f32x4 U = {0.f, 0.f, 0.f, 0.f}, Y = U;
#pragma unroll
                for (int s = 0; s < 2; ++s) { const LAS h16* wp = WP + (T0 + l15) * 72 + 32 * s + 4 * lg; const v2u lo = *(const LAS v2u*)wp, hi = *(const LAS v2u*)(wp + 16);
                    U = __builtin_amdgcn_mfma_f32_16x16x32_f16(__builtin_bit_cast(h16x8, (v4u){lo.x, lo.y, hi.x, hi.y}), sf[s], U, 0, 0, 0);
                    const LAS h16* rp = RT + (T0 + l15) * 72 + 32 * s + 4 * lg; const v2u rl = *(const LAS v2u*)rp, rh = *(const LAS v2u*)(rp + 16);
                    Y = __builtin_amdgcn_mfma_f32_16x16x32_f16(__builtin_bit_cast(h16x8, (v4u){rl.x, rl.y, rh.x, rh.y}), sf[s], Y, 0, 0, 0); }
                { const v2u tl = *(const LAS v2u*)(TL + (T0 + l15) * 24 + 4 * lg); U = __builtin_amdgcn_mfma_f32_16x16x32_f16(__builtin_bit_cast(h16x8, (v4u){tl.x, tl.y, 0u, 0u}), vf, U, 0, 0, 0); }
                const h16x8 uf = __builtin_bit_cast(h16x8, (v4u){pkh(U[0], U[1]), pkh(U[2], U[3]), 0u, 0u});
                { const v2u mb = *(const LAS v2u*)(MRB + (T0 + l15) * 24 + 4 * lg), mk = *(const LAS v2u*)(MRK + (T0 + l15) * 24 + 4 * lg);
                    Y = __builtin_amdgcn_mfma_f32_16x16x32_f16(__builtin_bit_cast(h16x8, (v4u){mb.x, mb.y, 0u, 0u}), uf, Y, 0, 0, 0);
                    Y = __builtin_amdgcn_mfma_f32_16x16x32_f16(__builtin_bit_cast(h16x8, (v4u){mk.x, mk.y, 0u, 0u}), vf, Y, 0, 0, 0); }
#pragma unroll
                for (int r = 0; r < 4; ++r) YL[(T0 + 4 * lg + r) * 65 + 16 * w + l15] = Y[r];
#pragma unroll
                for (int tau = 0; tau < 4; ++tau) { const f32x4 wc = *(const LAS f32x4*)(WC + c * 64 + 16 * tau + 4 * lg);
                    const v2u bl = *(const LAS v2u*)(BHT + (c * 64 + 16 * tau + l15) * 16 + 4 * lg), kl = *(const LAS v2u*)(KHT + (c * 64 + 16 * tau + l15) * 16 + 4 * lg);
                    pg8::f32x4 sacc = {St[tau][0] * wc.x, St[tau][1] * wc.y, St[tau][2] * wc.z, St[tau][3] * wc.w};
                    sacc = __builtin_amdgcn_mfma_f32_16x16x32_f16(__builtin_bit_cast(h16x8, (v4u){bl.x, bl.y, 0u, 0u}), uf, sacc, 0, 0, 0);
                    St[tau] = __builtin_amdgcn_mfma_f32_16x16x32_f16(__builtin_bit_cast(h16x8, (v4u){kl.x, kl.y, 0u, 0u}), vf, sacc, 0, 0, 0); }
            }
        }
        __syncthreads();
        { const int t = ft; float y[8]; float s = 0.f;
#pragma unroll
            for (int i = 0; i < 8; ++i) { y[i] = YL[t * 65 + 8 * fp + i]; s += y[i]; }
            const float mean = red8(s) * (1.0f / 64.0f); float q = 0.f;
#pragma unroll
            for (int i = 0; i < 8; ++i) { y[i] -= mean; q += y[i] * y[i]; }
            const float rstd = __builtin_amdgcn_rsqf(red8(q) * (1.0f / 64.0f) + 64e-5f), bon = BON[t];
            const f32x4 lw0 = *(const GAS f32x4*)(a.in[17] + hc0), lw1 = *(const GAS f32x4*)(a.in[17] + hc0 + 4), lb0 = *(const GAS f32x4*)(a.in[18] + hc0), lb1 = *(const GAS f32x4*)(a.in[18] + hc0 + 4);
            const float lw[8] = {lw0.x, lw0.y, lw0.z, lw0.w, lw1.x, lw1.y, lw1.z, lw1.w}, lb[8] = {lb0.x, lb0.y, lb0.z, lb0.w, lb1.x, lb1.y, lb1.z, lb1.w};
            const h16x8 v8 = *(const LAS h16x8*)(VH + t * 72 + 8 * fp); float res[8];
#pragma unroll
            for (int i = 0; i < 8; ++i) res[i] = (y[i] * rstd * lw[i] + lb[i] + bon * (float)v8[i]) * GATE[t * 65 + 8 * fp + i];
            *(GAS v4u*)(omix + (row0 + t0 + t) * DM + 1024 + hc0) = (v4u){pkh(res[0], res[1]), pkh(res[2], res[3]), pkh(res[4], res[5]), pkh(res[6], res[7])}; }
        __syncthreads();
    }
#undef RC_LOAD_RAW
}
__device__ __forceinline__ void dn_norm_gate(const Frame& F, const Args& a) {
    const int gw = F.bid * NWAVES + F.wave, NGW = F.G * NWAVES, lane = F.lane;
    const float* oraw = a.out; const h16* P = (const h16*)(a.ws + WS_P); h16* omix = (h16*)(a.ws + WS_OMIX);
    const int cn = (lane & 7) * 16;
    f32x4 nw[4];
#pragma unroll
    for (int j = 0; j < 4; ++j) nw[j] = *(const f32x4*)(a.in[7] + cn + 4 * j);
    for (int m = gw; m < MTOK; m += NGW) {
        const GAS f32x4* op = (const GAS f32x4*)(oraw + (size_t)m * 1024 + lane * 16);
        f32x4 v[4]; float s = 0.f;
#pragma unroll
        for (int j = 0; j < 4; ++j) { v[j] = op[j]; s += (v[j].x * v[j].x + v[j].y * v[j].y) + (v[j].z * v[j].z + v[j].w * v[j].w); }
        s = red8(s);
        const float rstd = __builtin_amdgcn_rsqf(s * (1.0f / 128.0f) + RMS_EPS);
        const GAS v4u* zp = (const GAS v4u*)(P + (size_t)m * PW + 3072 + lane * 16);
        const v4u z0 = zp[0], z1 = zp[1]; const unsigned zz[8] = {z0.x, z0.y, z0.z, z0.w, z1.x, z1.y, z1.z, z1.w};
        unsigned ow[8];
#pragma unroll
        for (int j = 0; j < 4; ++j) {
            const float za = h2f((h16)(zz[2 * j] & 0xffff)), zb = h2f((h16)(zz[2 * j] >> 16)), zc = h2f((h16)(zz[2 * j + 1] & 0xffff)), zd = h2f((h16)(zz[2 * j + 1] >> 16));
            const f32x4 o = v[j] * rstd * nw[j];
            ow[2 * j] = pkh(o.x * za * sigmoidf_(za), o.y * zb * sigmoidf_(zb)); ow[2 * j + 1] = pkh(o.z * zc * sigmoidf_(zc), o.w * zd * sigmoidf_(zd)); }
        GAS v4u* dst = (GAS v4u*)(omix + (size_t)m * DM + lane * 16);
        dst[0] = (v4u){ow[0], ow[1], ow[2], ow[3]}; dst[1] = (v4u){ow[4], ow[5], ow[6], ow[7]};
    }
}

constexpr int XA_KP = 136, XA_VP = 264;
constexpr int XAL_K = 0, XAL_V = XAL_K + 256 * XA_KP * 2, XAL_END = XAL_V + 128 * XA_VP * 2;
__device__ __forceinline__ void xattn_phase(const Frame& F, const Args& a) {
    const int tid = F.tid, lane = F.lane, w = F.wave, l15 = lane & 15, lg = lane >> 4;
    LAS h16* KL = (LAS h16*)(F.lds + XAL_K); LAS h16* VT = (LAS h16*)(F.lds + XAL_V);
    const h16* KV = (const h16*)(a.ws + WS_KV); const h16* Q = (const h16*)(a.ws + WS_Q); h16* AO = (h16*)(a.ws + WS_AO);
    for (int pair = F.bid; pair < 256; pair += F.G) {
        const int bhd = pair >> 3, b = bhd >> 2, hd = bhd & 3;
        __syncthreads();
#pragma unroll
        for (int i = 0; i < 8; ++i) { const int id = tid + 512 * i, mem = id & 255, dc = id >> 8;
            const v4u kv = *(const GAS v4u*)(KV + (size_t)(b * 256 + mem) * 1024 + hd * 128 + dc * 8);
            *(LAS v4u*)(KL + mem * XA_KP + dc * 8) = kv;
            const v4u vv = *(const GAS v4u*)(KV + (size_t)(b * 256 + mem) * 1024 + 512 + hd * 128 + dc * 8);
            const unsigned vw[4] = {vv.x, vv.y, vv.z, vv.w};
#pragma unroll
            for (int e = 0; e < 4; ++e) { VT[(dc * 8 + 2 * e) * XA_VP + mem] = (h16)(vw[e] & 0xffff); VT[(dc * 8 + 2 * e + 1) * XA_VP + mem] = (h16)(vw[e] >> 16); } }
        __syncthreads();
        for (int qi = 0; qi < 2; ++qi) {
            const int qb = (pair & 7) * 2 + qi; const size_t tok = (size_t)b * SEQ + qb * 128 + 16 * w + l15;
            h16x8 qf[4];
#pragma unroll
            for (int ks = 0; ks < 4; ++ks) qf[ks] = *(const GAS h16x8*)(Q + tok * 512 + hd * 128 + 32 * ks + 8 * lg);
            pg8::f32x4 s[16];
#pragma unroll
            for (int mt = 0; mt < 16; ++mt) { s[mt] = (pg8::f32x4){0.f, 0.f, 0.f, 0.f};
#pragma unroll
                for (int ks = 0; ks < 4; ++ks) { const h16x8 kf = *(const LAS h16x8*)(KL + (16 * mt + l15) * XA_KP + 32 * ks + 8 * lg); s[mt] = __builtin_amdgcn_mfma_f32_16x16x32_f16(kf, qf[ks], s[mt], 0, 0, 0); }
                if (mt & 1) __builtin_amdgcn_sched_barrier(0); }
            float mx = -3.0e38f;
#pragma unroll
            for (int mt = 0; mt < 16; ++mt) mx = fmaxf(fmaxf(fmaxf(mx, s[mt][0]), fmaxf(s[mt][1], s[mt][2])), s[mt][3]);
            mx = fmaxf(mx, __shfl_xor(mx, 16)); mx = fmaxf(mx, __shfl_xor(mx, 32));
            const float sc = 0.08838834764831845f * 1.4426950408889634f; float sum = 0.f;
#pragma unroll
            for (int mt = 0; mt < 16; ++mt)
#pragma unroll
                for (int r = 0; r < 4; ++r) { const float p = __builtin_amdgcn_exp2f((s[mt][r] - mx) * sc); s[mt][r] = p; sum += p; }
            sum += __shfl_xor(sum, 16); sum += __shfl_xor(sum, 32);
            const float inv = 1.0f / sum;
            h16x8 pf[8];
#pragma unroll
            for (int ss = 0; ss < 8; ++ss) { v4u t; t.x = pkh(s[2 * ss][0] * inv, s[2 * ss][1] * inv); t.y = pkh(s[2 * ss][2] * inv, s[2 * ss][3] * inv); t.z = pkh(s[2 * ss + 1][0] * inv, s[2 * ss + 1][1] * inv); t.w = pkh(s[2 * ss + 1][2] * inv, s[2 * ss + 1][3] * inv);
                pf[ss] = __builtin_bit_cast(h16x8, t); }
#pragma unroll
            for (int dt = 0; dt < 8; ++dt) { pg8::f32x4 o = {0.f, 0.f, 0.f, 0.f};
#pragma unroll
                for (int ss = 0; ss < 8; ++ss) { const LAS h16* vp = VT + (16 * dt + l15) * XA_VP + 32 * ss + 4 * lg;
                    const v2u lo = *(const LAS v2u*)vp, hi = *(const LAS v2u*)(vp + 16); const v4u t = {lo.x, lo.y, hi.x, hi.y};
                    o = __builtin_amdgcn_mfma_f32_16x16x32_f16(__builtin_bit_cast(h16x8, t), pf[ss], o, 0, 0, 0); }
                v2u ow; ow.x = pkh(o[0], o[1]); ow.y = pkh(o[2], o[3]);
                *(GAS v2u*)(AO + tok * 512 + hd * 128 + 16 * dt + 4 * lg) = ow; __builtin_amdgcn_sched_barrier(0); }
        }
    }
}

__device__ __forceinline__ void final_norm(const Frame& F, const Args& a) {
    const int gw = F.bid * NWAVES + F.wave, NGW = F.G * NWAVES, lane = F.lane;
    const float* ss = (const float*)(a.ws + WS_CTL + CTL_SS3); const GAS f32x4* wr = (const GAS f32x4*)a.in[29] + lane;
    for (int m = gw; m < MTOK; m += NGW) {
        const float rstd = __builtin_amdgcn_rsqf(__hip_atomic_load(ss + m, __ATOMIC_RELAXED, __HIP_MEMORY_SCOPE_AGENT) * (1.0f / DM) + RMS_EPS);
        GAS f32x4* xr = (GAS f32x4*)(a.out + (size_t)m * DM) + lane;
#pragma unroll
        for (int j = 0; j < 8; ++j) { const f32x4 v = xr[64 * j]; xr[64 * j] = v * rstd * wr[64 * j]; }
    }
}
constexpr int N_PHASES = 11;
#ifndef MK_ONE_LAUNCH
#define MK_ONE_LAUNCH 1
#endif
__global__ void __launch_bounds__(NTHREADS, 2) fwd_kernel(Args args) {
    extern __shared__ __attribute__((aligned(16))) unsigned char lds[];
    Frame F; F.lds = (LAS unsigned char*)lds; F.tid = threadIdx.x; F.lane = F.tid & 63; F.wave = __builtin_amdgcn_readfirstlane(F.tid >> 6); F.G = gridDim.x; F.bid = blockIdx.x;
    unsigned char* ws = args.ws;
    const int lo = args.ph_lo, hi = args.ph_hi;
#define IN(k) (lo <= (k) && (k) < hi)
#ifndef REPEAT_PH
#define REPEAT_PH -1
#endif
#ifndef REPEAT_N
#define REPEAT_N 1
#endif
#define REP(k) for (int rep_ = 0; rep_ < ((k) == REPEAT_PH ? 1 + REPEAT_N : 1); ++rep_, ((k) == REPEAT_PH && rep_ <= REPEAT_N ? (cg::this_grid().sync(), 0) : 0))
#if MK_ONE_LAUNCH
#define SEAM(k) do { if (IN(k) && IN((k) + 1)) { cg::this_grid().sync(); } } while (0)
#else
#define SEAM(k) do { } while (0)
#endif
    float* ss1 = (float*)(ws + WS_CTL + CTL_SS1); float* ss2 = (float*)(ws + WS_CTL + CTL_SS2); float* ss3 = (float*)(ws + WS_CTL + CTL_SS3);
    if (IN(0)) REP(0) { p0_prologue(F, args); } SEAM(0);
    if (IN(1)) REP(1) { pg8::Gemm g{(const pg8::h16_t*)args.out, (const pg8::h16_t*)(ws + WS_WALL), DM}; pg8::StaticOrder S; S.init(64, 30, F.G, F.bid, 8, 4);
        pg8::EpiF16<0> E{(pg8::h16_t*)(ws + WS_P), PW, nullptr, 0.f, (pg8::h16_t*)(ws + WS_KV), 1024, 64, 30};
        pg8::gemm_phase(F.lds, g, S, E); } SEAM(1);
    if (IN(2)) REP(2) { if (F.bid < 64) dn_chunked(F, args, F.bid); else if (F.bid < 192) rw_chunked(F, args, F.bid - 64); } SEAM(2);
    if (IN(4)) REP(4) { pg8::Gemm g{(const pg8::h16_t*)(ws + WS_OMIX), (const pg8::h16_t*)(ws + WS_WOUT), DM}; pg8::StaticOrder S; S.init(64, 8, F.G, F.bid);
        pg8::EpiRes E{args.in[0], args.out, (pg8::h16_t*)(ws + WS_H1), ss1, DM};
        pg8::gemm_phase(F.lds, g, S, E); } SEAM(4);
    if (IN(5)) REP(5) { pg8::Gemm g{(const pg8::h16_t*)(ws + WS_H1), (const pg8::h16_t*)(ws + WS_WQ), DM}; pg8::StaticOrder S; S.init(64, 2, F.G, F.bid);
        pg8::EpiF16<0> E{(pg8::h16_t*)(ws + WS_Q), 512, ss1, RMS_EPS, nullptr, 0, 0, 0};
        pg8::gemm_phase(F.lds, g, S, E); } SEAM(5);
    if (IN(6)) REP(6) { xattn_phase(F, args); } SEAM(6);
    if (IN(7)) REP(7) { pg8::Gemm g{(const pg8::h16_t*)(ws + WS_AO), (const pg8::h16_t*)(ws + WS_WO), 512}; pg8::StaticOrder S; S.init(64, 8, F.G, F.bid);
        pg8::EpiRes E{args.out, args.out, (pg8::h16_t*)(ws + WS_H2), ss2, DM};
        pg8::gemm_phase(F.lds, g, S, E); } SEAM(7);
    if (IN(8)) REP(8) { pg8::Gemm g{(const pg8::h16_t*)(ws + WS_H2), (const pg8::h16_t*)(ws + WS_W1), DM}; pg8::StaticOrder S; S.init(64, 32, F.G, F.bid);
        pg8::EpiF16<1> E{(pg8::h16_t*)(ws + WS_HID), FF, ss2, RMS_EPS, nullptr, 0, 0, 0};
        pg8::gemm_phase(F.lds, g, S, E); } SEAM(8);
    if (IN(9)) REP(9) { pg8::Gemm g{(const pg8::h16_t*)(ws + WS_HID), (const pg8::h16_t*)(ws + WS_W2), FF}; pg8::StaticOrder S; S.init(64, 8, F.G, F.bid);
        pg8::EpiRes E{args.out, args.out, nullptr, ss3, DM};
        pg8::gemm_phase(F.lds, g, S, E); } SEAM(9);
    if (IN(10)) REP(10) { final_norm(F, args); }
#undef IN
#undef SEAM
}

extern "C" void kernel_launch(void* const* d_in, const int* in_sizes, int n_in, void* d_out, int out_size, void* d_ws, size_t ws_size, hipStream_t stream) {
    static int grid = 0;
    if (grid == 0) {
        if (n_in != 30 || out_size != MTOK * DM || ws_size < WS_END) { fprintf(stderr, "kernel_launch: unexpected problem (n_in %d, out %d, ws %zu < %zu)\n", n_in, out_size, ws_size, (size_t)WS_END); grid = -1; return; }
        int dev = 0, cus = 0, per_cu = 0;
        hipGetDevice(&dev); hipDeviceGetAttribute(&cus, hipDeviceAttributeMultiprocessorCount, dev);
        if (hipFuncSetAttribute((const void*)fwd_kernel, hipFuncAttributeMaxDynamicSharedMemorySize, LDS_BYTES) != hipSuccess) { fprintf(stderr, "kernel_launch: hipFuncSetAttribute failed\n"); grid = -1; return; }
        if (hipOccupancyMaxActiveBlocksPerMultiprocessor(&per_cu, (const void*)fwd_kernel, NTHREADS, LDS_BYTES) != hipSuccess || per_cu < 1) { fprintf(stderr, "kernel_launch: occupancy query says %d\n", per_cu); per_cu = 1; }
        (void)hipGetLastError();
        grid = cus;
        if (grid > 256) grid = 256;
    }
    if (grid < 0) return;
    hipMemsetAsync((char*)d_ws + WS_CTL, 0, CTL_ZERO_BYTES, stream);
    Args a{};
    for (int i = 0; i < 30; ++i) a.in[i] = (const float*)d_in[i];
    a.out = (float*)d_out; a.ws = (unsigned char*)d_ws;
#if MK_ONE_LAUNCH
    a.ph_lo = 0; a.ph_hi = N_PHASES;
    void* kargs[] = {&a};
    hipError_t e = hipLaunchCooperativeKernel((const void*)fwd_kernel, dim3(grid), dim3(NTHREADS), kargs, LDS_BYTES, stream);
    if (e != hipSuccess) fprintf(stderr, "cooperative launch failed: %s (grid %d)\n", hipGetErrorString(e), grid);
#else
    for (int ph = 0; ph < N_PHASES; ++ph) { a.ph_lo = ph; a.ph_hi = ph + 1; hipLaunchKernelGGL(fwd_kernel, dim3(grid), dim3(NTHREADS), LDS_BYTES, stream, a); }
#endif
}
```

```cpp
#include <hip/hip_runtime.h>
#include <hip/hip_cooperative_groups.h>
#include <cstdio>
#include <cstdint>
namespace cg = cooperative_groups;
namespace pg8 {
#define PG8_LAS __attribute__((address_space(3)))
typedef unsigned short h16_t;
typedef _Float16 h16x8 __attribute__((ext_vector_type(8)));
typedef _Float16 h16x2 __attribute__((ext_vector_type(2)));
typedef _Float16 h16x4 __attribute__((ext_vector_type(4)));
typedef float f32x4 __attribute__((ext_vector_type(4)));
typedef float f32x2 __attribute__((ext_vector_type(2)));
typedef unsigned u32x4 __attribute__((ext_vector_type(4)));
typedef unsigned u32x2 __attribute__((ext_vector_type(2)));
constexpr int BM = 256, BK = 64, HALF = 128, HTB = HALF * BK * 2  , STAGE_BYTES = 8 * HTB, NXCD = 8, WGM = 8;

__host__ __device__ __forceinline__ int lds_byte(int r, int c) { const int st = (r >> 4) * 2 + (c >> 5), rr = r & 15, cc = c & 31, ob = rr * 64 + cc * 2; return st * 1024 + (ob ^ (((ob >> 9) & 1) << 5)); }
__host__ __device__ __forceinline__ void stage_rc(int b, int& R, int& C) { const int st = b / 1024, sb = b % 1024, swz = sb ^ (((sb >> 9) & 1) << 5); R = (st >> 1) * 16 + swz / 64; C = (st & 1) * 32 + (swz % 64) / 2; }
__host__ __device__ __forceinline__ int perm32(int rho) { const int n = rho >> 4, i = rho & 15; return 8 * (i >> 2) + 4 * n + (i & 3); }

struct Unit { int pm, pn, ks; };
struct Gemm { const h16_t* A; const h16_t* Bt; int K, ld; };

struct StaticOrder {
    int nM, nN, nwg, G, c, eM, eN, nK;
    __device__ void init(int nM_, int nN_, int G_, int c_, int eM_ = 0, int eN_ = 0, int nK_ = 1) { nM = nM_; nN = nN_; nwg = nM * nN; G = G_; c = c_; eM = eM_; eN = eN_; nK = nK_; }
    __device__ bool next(int i, Unit& u) const {
        long L = (long)i * G + c; u.ks = 0;
        if (nK > 1) { if (L >= (long)nwg * nK) return false; u.ks = (int)(L / nwg); L -= (long)u.ks * nwg; }
        else if (L >= nwg) { const int e = (int)(L - nwg); if (e >= eM * eN) return false; u.pm = nM + e / eN; u.pn = nN + e % eN; return true; }
        int wgid = (int)L; { const int q = nwg / NXCD, r = nwg % NXCD, xcd = wgid % NXCD, off = wgid / NXCD; wgid = (xcd < r ? xcd * (q + 1) : r * (q + 1) + (xcd - r) * q) + off; }
        const int nig = WGM * nN, gid = wgid / nig, fm = gid * WGM, gsz = (nM - fm) < WGM ? (nM - fm) : WGM;
        u.pm = fm + ((wgid % nig) % gsz); u.pn = (wgid % nig) / gsz; return true;
    }
};

__device__ __forceinline__ unsigned pkh(float lo, float hi) { f32x2 v = {lo, hi}; h16x2 h = __builtin_convertvector(v, h16x2); return __builtin_bit_cast(unsigned, h); }


template <int ACT> struct EpiF16 {
    static constexpr bool PERM = true;
    h16_t* O; int ldc; const float* rs; float eps; h16_t* O2; int ldc2; int splitM, splitN; size_t part_stride;
    __device__ __forceinline__ void prefetch(const Unit& u, int wr, int fr, float (&pf)[8]) const {
        if (rs) {
#pragma unroll
            for (int g_ = 0; g_ < 8; ++g_) pf[g_] = rs[u.pm * BM + (g_ >> 2) * HALF + wr * 64 + (g_ & 3) * 16 + fr]; }
    }
    __device__ __forceinline__ void operator()(const f32x4 (&acc)[2][2][4][2], const Unit& u, int wr, int wc, int fr, int fq, const float (&pf)[8]) const {
        int pm = u.pm, pn = u.pn; h16_t* base = O + (size_t)u.ks * part_stride; int ld = ldc;
        if (O2 && pm >= splitM) { pm -= splitM; pn -= splitN; base = O2; ld = ldc2; }
        const int row0 = pm * BM + wr * 64 + fr; const int col0 = pn * BM + wc * 32 + 8 * fq;
#pragma unroll
        for (int ai = 0; ai < 2; ++ai)
#pragma unroll
            for (int m = 0; m < 4; ++m) { const int row = row0 + ai * HALF + m * 16; h16_t* rowp = base + (size_t)row * ld + col0;
                float sc = 1.f; if (rs) sc = __builtin_amdgcn_rsqf(pf[ai * 4 + m] * (1.0f / 2048.0f) + eps);
#pragma unroll
                for (int bj = 0; bj < 2; ++bj) { f32x4 v0 = acc[ai][bj][m][0] * sc, v1 = acc[ai][bj][m][1] * sc;
                    if (ACT == 1) { v0 = __builtin_elementwise_max(v0, (f32x4){0.f, 0.f, 0.f, 0.f}); v1 = __builtin_elementwise_max(v1, (f32x4){0.f, 0.f, 0.f, 0.f}); v0 = v0 * v0; v1 = v1 * v1; }
                    u32x4 w; w.x = pkh(v0[0], v0[1]); w.y = pkh(v0[2], v0[3]); w.z = pkh(v1[0], v1[1]); w.w = pkh(v1[2], v1[3]);
                    *(u32x4*)(rowp + bj * HALF) = w; } }
    }
};
struct EpiF32Part {
    static constexpr bool PERM = false;
    float* O; int ldc; size_t part_stride;
    __device__ __forceinline__ void prefetch(const Unit&, int, int, float (&)[8]) const {}
    __device__ __forceinline__ void operator()(const f32x4 (&acc)[2][2][4][2], const Unit& u, int wr, int wc, int fr, int fq, const float (&)[8]) const {
        const int col0 = u.pn * BM + wc * 32 + 4 * fq; float* base = O + (size_t)u.ks * part_stride;
#pragma unroll
        for (int ai = 0; ai < 2; ++ai)
#pragma unroll
            for (int m = 0; m < 4; ++m) { float* rowp = base + (size_t)(u.pm * BM + ai * HALF + wr * 64 + m * 16 + fr) * ldc + col0;
#pragma unroll
                for (int bj = 0; bj < 2; ++bj)
#pragma unroll
                    for (int n = 0; n < 2; ++n) *(f32x4*)(rowp + bj * HALF + n * 16) = acc[ai][bj][m][n]; }
    }
};
struct EpiRes {
    static constexpr bool PERM = true;
    const float* base32; const h16_t* base16; float* out32; h16_t* o16; float* ss; int ldc;
    __device__ __forceinline__ void prefetch(const Unit&, int, int, float (&)[8]) const {}
    __device__ __forceinline__ void operator()(const f32x4 (&acc)[2][2][4][2], const Unit& u, int wr, int wc, int fr, int fq, const float (&)[8]) const {
        const int col0 = u.pn * BM + wc * 32 + 8 * fq;
        const size_t off0 = (size_t)(u.pm * BM + wr * 64 + fr) * ldc + col0;
        f32x4 pre[3][4];
#define ER_LOAD(slot, g_) do { const size_t o_ = off0 + (size_t)(((g_) >> 2) * HALF + ((g_) & 3) * 16) * ldc; _Pragma("unroll") for (int bj_ = 0; bj_ < 2; ++bj_) { const size_t e_ = o_ + bj_ * HALF; \
            if (base16) { const h16x8 h_ = *(const h16x8*)(base16 + e_); pre[slot][2 * bj_] = (f32x4){(float)h_[0], (float)h_[1], (float)h_[2], (float)h_[3]}; pre[slot][2 * bj_ + 1] = (f32x4){(float)h_[4], (float)h_[5], (float)h_[6], (float)h_[7]}; } \
            else { pre[slot][2 * bj_] = *(const f32x4*)(base32 + e_); pre[slot][2 * bj_ + 1] = *(const f32x4*)(base32 + e_ + 4); } } } while (0)
        ER_LOAD(0, 0); ER_LOAD(1, 1);
#pragma unroll
        for (int g_ = 0; g_ < 8; ++g_) { const int ai = g_ >> 2, m = g_ & 3; const int row = u.pm * BM + ai * HALF + wr * 64 + m * 16 + fr; const size_t off = (size_t)row * ldc + col0; float q = 0.f;
            if (g_ + 2 < 8) ER_LOAD((g_ + 2) % 3, g_ + 2);
#pragma unroll
            for (int bj = 0; bj < 2; ++bj) { const f32x4 o0 = pre[g_ % 3][2 * bj] + acc[ai][bj][m][0], o1 = pre[g_ % 3][2 * bj + 1] + acc[ai][bj][m][1];
                if (out32) { *(f32x4*)(out32 + off + bj * HALF) = o0; *(f32x4*)(out32 + off + bj * HALF + 4) = o1; }
                q += (o0[0] * o0[0] + o0[1] * o0[1]) + (o0[2] * o0[2] + o0[3] * o0[3]) + (o1[0] * o1[0] + o1[1] * o1[1]) + (o1[2] * o1[2] + o1[3] * o1[3]);
                if (o16) { u32x4 w; w.x = pkh(o0[0], o0[1]); w.y = pkh(o0[2], o0[3]); w.z = pkh(o1[0], o1[1]); w.w = pkh(o1[2], o1[3]); *(u32x4*)(o16 + off + bj * HALF) = w; } }
            q += __shfl_xor(q, 16); q += __shfl_xor(q, 32);
            if (fq == 0) atomicAdd(ss + row, q); }
#undef ER_LOAD
    }
};

template <class Epi, class Sched>
__device__ __forceinline__ void gemm_phase(PG8_LAS unsigned char* lds, const Gemm g, const Sched& S, const Epi& E) {
    const int tid = threadIdx.x, wid = __builtin_amdgcn_readfirstlane(tid >> 6), lane = tid & 63, wr = wid >> 2, wc = wid & 3, fr = lane & 15, fq = lane >> 4;
    const int K = g.K, nt = K / BK, ld = g.ld;
    unsigned voffA[2], voffB[2];
#pragma unroll
    for (int i = 0; i < 2; ++i) { int R, C; stage_rc(tid * 16 + i * 8192, R, C); const int Rb = Epi::PERM ? ((R & ~31) + perm32(R & 31)) : R;
        voffA[i] = (unsigned)(R * ld + C) * 2u; voffB[i] = (unsigned)(Rb * ld + C) * 2u; }
    const size_t kstep = (size_t)(BK * 2);
    const size_t hstep = (size_t)HALF * ld * 2;
    const size_t tstep = 2 * hstep;
    const unsigned ldsw = (unsigned)wid * 1024u;
    const int aoff = lds_byte(wr * 64 + fr, fq * 8), boff = lds_byte(wc * 32 + fr, fq * 8);
#define PG8_SA(b, h) (((b) * 2 + (h)) * HTB)
#define PG8_SB(b, h) ((4 + (b) * 2 + (h)) * HTB)
#define PG8_STAGE(bufoff, gbase, voff) do { _Pragma("unroll") for (int _i = 0; _i < 2; ++_i) \
        __builtin_amdgcn_global_load_lds((const unsigned*)((const char*)(gbase) + (voff)[_i]), (PG8_LAS unsigned*)(lds + (bufoff) + ldsw + _i * 8192), 16, 0, 0); } while (0)
#define PG8_LDA(dst, b, h) do { _Pragma("unroll") for (int m = 0; m < 4; ++m) _Pragma("unroll") for (int k = 0; k < 2; ++k) dst[m][k] = *(const PG8_LAS h16x8*)(lds + PG8_SA(b, h) + aoff + m * 2048 + k * 1024); } while (0)
#define PG8_LDB(dst, b, h) do { _Pragma("unroll") for (int n = 0; n < 2; ++n) _Pragma("unroll") for (int k = 0; k < 2; ++k) dst[n][k] = *(const PG8_LAS h16x8*)(lds + PG8_SB(b, h) + boff + n * 2048 + k * 1024); } while (0)
#define PG8_MMA(ai, bj, At, Bt) do { __builtin_amdgcn_s_setprio(1); _Pragma("unroll") for (int m = 0; m < 4; ++m) _Pragma("unroll") for (int n = 0; n < 2; ++n) _Pragma("unroll") for (int k = 0; k < 2; ++k) \
        acc[ai][bj][m][n] = __builtin_amdgcn_mfma_f32_16x16x32_f16(Bt[n][k], At[m][k], acc[ai][bj][m][n], 0, 0, 0); __builtin_amdgcn_s_setprio(0); } while (0)
#define PG8_WAIT_V(n) asm volatile("s_waitcnt vmcnt(" #n ")" ::: "memory")
#define PG8_WAIT_L(n) asm volatile("s_waitcnt lgkmcnt(" #n ")" ::: "memory")
#define PG8_BAR __builtin_amdgcn_s_barrier()
#define PG8_SCHED __builtin_amdgcn_sched_barrier(0)
    Unit cur, nxt; int ui = 0;
    if (!S.next(0, cur)) return;
    f32x4 acc[2][2][4][2];
#pragma unroll
    for (int a = 0; a < 2; ++a)
#pragma unroll
        for (int b = 0; b < 2; ++b)
#pragma unroll
            for (int m = 0; m < 4; ++m)
#pragma unroll
                for (int n = 0; n < 2; ++n) acc[a][b][m][n] = (f32x4){0.f, 0.f, 0.f, 0.f};
    h16x8 At[4][2], B0[2][2], B1[2][2];
    float pf[8] = {0.f, 0.f, 0.f, 0.f, 0.f, 0.f, 0.f, 0.f};
    E.prefetch(cur, wr, fr, pf);
    const size_t kslice = (size_t)K * 2;
    const char* cA = (const char*)g.A + (size_t)cur.pm * tstep + cur.ks * kslice; const char* cB = (const char*)g.Bt + (size_t)cur.pn * tstep + cur.ks * kslice;
    PG8_STAGE(PG8_SB(0, 0), cB, voffB); PG8_STAGE(PG8_SB(0, 1), cB + hstep, voffB); PG8_STAGE(PG8_SA(0, 0), cA, voffA); PG8_STAGE(PG8_SA(0, 1), cA + hstep, voffA);
    if (wr == 1) PG8_BAR;
    PG8_WAIT_V(2); PG8_BAR;
    PG8_STAGE(PG8_SB(1, 0), cB + kstep, voffB); PG8_STAGE(PG8_SA(1, 0), cA + kstep, voffA); PG8_STAGE(PG8_SB(1, 1), cB + hstep + kstep, voffB);
    PG8_WAIT_V(6); PG8_BAR;
    for (;;) {
        const bool has_next = S.next(ui + 1, nxt);
        const char* nA = has_next ? (const char*)g.A + (size_t)nxt.pm * tstep + nxt.ks * kslice : cA; const char* nB = has_next ? (const char*)g.Bt + (size_t)nxt.pn * tstep + nxt.ks * kslice : cB;
        for (int t = 0; t < nt; t += 2) {
            const bool last = (t == nt - 2);
            const char* a1 = cA + (size_t)(t + 1) * kstep;
            const char* a2 = last ? nA : cA + (size_t)(t + 2) * kstep; const char* b2 = last ? nB : cB + (size_t)(t + 2) * kstep;
            const char* a3 = a2 + kstep; const char* b3 = b2 + kstep;
            PG8_LDB(B0, 0, 0); PG8_LDB(B1, 0, 1); PG8_SCHED; PG8_LDA(At, 0, 0); PG8_STAGE(PG8_SA(1, 1), a1 + hstep, voffA);
            PG8_WAIT_V(8); PG8_WAIT_L(0); PG8_BAR; PG8_MMA(0, 0, At, B0); PG8_MMA(0, 1, At, B1); PG8_BAR; PG8_SCHED;
            PG8_LDA(At, 0, 1); PG8_STAGE(PG8_SB(0, 0), b2, voffB); PG8_STAGE(PG8_SB(0, 1), b2 + hstep, voffB); PG8_STAGE(PG8_SA(0, 0), a2, voffA);
            PG8_WAIT_V(8); PG8_WAIT_L(0); PG8_BAR; PG8_MMA(1, 0, At, B0); PG8_MMA(1, 1, At, B1); PG8_BAR; PG8_SCHED;
            PG8_LDB(B0, 1, 0); PG8_LDB(B1, 1, 1); PG8_SCHED; PG8_LDA(At, 1, 0); PG8_STAGE(PG8_SA(0, 1), a2 + hstep, voffA);
            PG8_WAIT_V(8); PG8_WAIT_L(0); PG8_BAR; PG8_MMA(0, 0, At, B0); PG8_MMA(0, 1, At, B1); PG8_BAR; PG8_SCHED;
            PG8_LDA(At, 1, 1); PG8_STAGE(PG8_SB(1, 0), b3, voffB); PG8_STAGE(PG8_SB(1, 1), b3 + hstep, voffB); PG8_STAGE(PG8_SA(1, 0), a3, voffA);
            PG8_WAIT_V(8); PG8_WAIT_L(0); PG8_BAR; PG8_MMA(1, 0, At, B0); PG8_MMA(1, 1, At, B1); PG8_BAR; PG8_SCHED;
        }
        if (wr == 0) PG8_BAR;
        E(acc, cur, wr, wc, fr, fq, pf);
        if (!has_next) break;
#pragma unroll
        for (int a = 0; a < 2; ++a)
#pragma unroll
            for (int b = 0; b < 2; ++b)
#pragma unroll
                for (int m = 0; m < 4; ++m)
#pragma unroll
                    for (int n = 0; n < 2; ++n) acc[a][b][m][n] = (f32x4){0.f, 0.f, 0.f, 0.f};
        cur = nxt; cA = nA; cB = nB; ++ui; E.prefetch(cur, wr, fr, pf);
        if (wr == 1) PG8_BAR;
    }
    PG8_WAIT_V(0);
    PG8_BAR;
#undef PG8_SA
#undef PG8_SB
#undef PG8_STAGE
#undef PG8_LDA
#undef PG8_LDB
#undef PG8_MMA
#undef PG8_WAIT_V
#undef PG8_WAIT_L
#undef PG8_BAR
#undef PG8_SCHED
}
}
constexpr int NWAVES = 8, NTHREADS = 512;
constexpr int DM = 2048, BATCH = 8, SEQ = 2048, MTOK = BATCH * SEQ, MEMLEN = 256, MMEM = BATCH * MEMLEN;
constexpr int INC = 7440, PW = 7680;
constexpr int RW0 = 4128;
constexpr int FF = 8192;
constexpr float RMS_EPS = 1e-6f;
constexpr size_t MiB = 1u << 20;
constexpr size_t WS_CTL = 0, CTL_ZERO_BYTES = 1 * MiB;
constexpr size_t CTL_SS1 = 65536, CTL_SS2 = 131072, CTL_SS3 = 196608, CTL_BAR = 262144;
constexpr size_t WS_WALL = 2 * MiB;
constexpr size_t WS_WOUT = 36 * MiB, WS_WQ = 44 * MiB, WS_WO = 46 * MiB, WS_W1 = 48 * MiB, WS_W2 = 80 * MiB;
constexpr size_t WS_LORA = 112 * MiB;
constexpr size_t WS_KV = 113 * MiB;
constexpr size_t WS_Q = 117 * MiB, WS_AO = 133 * MiB;
constexpr size_t WS_C = 150 * MiB;
constexpr size_t WS_P = WS_C;
constexpr size_t WS_OMIX = WS_C + 240 * MiB;
constexpr size_t WS_HID = WS_C;
constexpr size_t WS_H1 = WS_C;
constexpr size_t WS_H2 = WS_C + 256 * MiB;
constexpr size_t WS_END = WS_C + 320 * MiB;

constexpr int LDS_BYTES = 163840, LDS_MISC = LDS_BYTES - 64;

#define GAS __attribute__((address_space(1)))
#define LAS __attribute__((address_space(3)))
typedef unsigned short h16;
typedef float f32x4 __attribute__((ext_vector_type(4)));
typedef float f32x2 __attribute__((ext_vector_type(2)));
typedef unsigned v4u __attribute__((ext_vector_type(4)));
typedef unsigned v2u __attribute__((ext_vector_type(2)));
typedef _Float16 h16x8 __attribute__((ext_vector_type(8)));
typedef _Float16 h16x4 __attribute__((ext_vector_type(4)));
using pg8::pkh;
__device__ __forceinline__ float h2f(h16 v) { return (float)__builtin_bit_cast(_Float16, v); }
__device__ __forceinline__ h16 f2h(float v) { return __builtin_bit_cast(h16, (_Float16)v); }
__device__ __forceinline__ float fexp(float x) { return __builtin_amdgcn_exp2f(x * 1.4426950408889634f); }
__device__ __forceinline__ float sigmoidf_(float x) { return __builtin_amdgcn_rcpf(1.0f + fexp(-x)); }
__device__ __forceinline__ float ftanh(float x) { return 2.0f * sigmoidf_(2.0f * x) - 1.0f; }
__device__ __forceinline__ float softplusf_(float x) { return fmaxf(x, 0.f) + __builtin_amdgcn_logf(1.0f + fexp(-fabsf(x))) * 0.6931471805599453f; }
template <int CTRL> __device__ __forceinline__ float dpp_(float v) { return __builtin_bit_cast(float, __builtin_amdgcn_update_dpp(0, __builtin_bit_cast(int, v), CTRL, 0xf, 0xf, true)); }
__device__ __forceinline__ float red8(float x) { x += dpp_<0xB1>(x); x += dpp_<0x4E>(x); x += dpp_<0x141>(x); return x; }
__device__ __forceinline__ float red16(float x) { x += __shfl_xor(x, 1); x += __shfl_xor(x, 2); x += __shfl_xor(x, 4); x += __shfl_xor(x, 8); return x; }
__device__ __forceinline__ float wave_sum(float v) {
#pragma unroll
    for (int o = 1; o < 64; o <<= 1) v += __shfl_xor(v, o);
    return v;
}

#define XB_TMO      128
#define XB_XCNT(j)  (256  + 64 * (j))
#define XB_XSUB(j)  (1280 + 64 * (j))
#define XB_XGEN(j)  (2304 + 64 * (j))
#define XB_TOP      3328
#define XB_TOPGEN   3392
#define XCD_BAR_WORDS 3456
#define XB_SPIN_CAP (1u << 18)

__device__ __forceinline__ unsigned xb_ld(unsigned* p)              { return __hip_atomic_load(p, __ATOMIC_RELAXED, __HIP_MEMORY_SCOPE_AGENT); }
__device__ __forceinline__ unsigned xb_add(unsigned* p, unsigned v) { return __hip_atomic_fetch_add(p, v, __ATOMIC_RELAXED, __HIP_MEMORY_SCOPE_AGENT); }
__device__ __forceinline__ unsigned xb_xcc_id() { return (unsigned)__builtin_amdgcn_s_getreg((3 << 11) | 20) & 0xFu; }
#define XB_SPIN(cond, bar) do { unsigned _sp = 0; while (cond) { __builtin_amdgcn_s_sleep(1); \
    if ((++_sp & 255u) == 0u) { if (xb_ld(&(bar)[XB_TMO])) break; if (_sp > XB_SPIN_CAP) { atomicAdd(&(bar)[XB_TMO], 1u); break; } } } } while (0)

struct XcdBarrier {
    unsigned* bar; unsigned x;
    volatile LAS unsigned* st;
};

__device__ __forceinline__ XcdBarrier xcd_barrier_post(unsigned* bar, volatile LAS unsigned* st) {
    XcdBarrier b; b.bar = bar; b.x = xb_xcc_id(); b.st = st;
    if (threadIdx.x == 0) (void)xb_add(&bar[XB_XCNT(b.x)], 1u);
    return b;
}
__device__ __forceinline__ void xcd_barrier_complete(unsigned* bar, unsigned x, unsigned& nloc, unsigned& nx) {
    const unsigned G = gridDim.x * gridDim.y * gridDim.z;
    unsigned sum, cnt, mine, sp = 0u;
    for (;;) {
        sum = 0u; cnt = 0u; mine = 0u;
#pragma unroll
        for (unsigned j = 0; j < 16; ++j) { const unsigned c = xb_ld(&bar[XB_XCNT(j)]); sum += c; cnt += (c > 0u) ? 1u : 0u; mine = (j == x) ? c : mine; }
        if (sum == G) break;
        __builtin_amdgcn_s_sleep(1);
        if ((++sp & 255u) == 0u) { if (xb_ld(&bar[XB_TMO])) break; if (sp > XB_SPIN_CAP) { atomicAdd(&bar[XB_TMO], 1u); break; } }
    }
    nloc = mine > 0u ? mine : 1u; nx = cnt > 0u ? cnt : 1u;
}

__device__ __forceinline__ void xcd_barrier(const XcdBarrier& b) {
    asm volatile("s_waitcnt vmcnt(0)" ::: "memory");
    __syncthreads();
    if (threadIdx.x == 0) {
        unsigned* bar = b.bar;
        __builtin_amdgcn_s_waitcnt(0);
        unsigned nloc = b.st[0], nx = b.st[1];
        if (nloc == 0u) { xcd_barrier_complete(bar, b.x, nloc, nx); b.st[0] = nloc; b.st[1] = nx; }
        const unsigned old = xb_add(&bar[XB_XSUB(b.x)], 1u);
        const unsigned gen = old / nloc;
        if (old + 1u == (gen + 1u) * nloc) {
            __builtin_amdgcn_fence(__ATOMIC_RELEASE, "agent");
            asm volatile("s_waitcnt vmcnt(0)" ::: "memory");
            const unsigned og = xb_add(&bar[XB_TOP], 1u);
            const unsigned tg = og / nx;
            if (og + 1u == (tg + 1u) * nx) xb_add(&bar[XB_TOPGEN], 1u);
            else XB_SPIN(xb_ld(&bar[XB_TOPGEN]) == tg, bar);
            __builtin_amdgcn_fence(__ATOMIC_ACQUIRE, "agent");
            xb_add(&bar[XB_XGEN(b.x)], 1u);
            asm volatile("s_waitcnt vmcnt(0)" ::: "memory");
        } else {
            XB_SPIN(xb_ld(&bar[XB_XGEN(b.x)]) == gen, bar);
            __builtin_amdgcn_fence(__ATOMIC_ACQUIRE, "agent");
            asm volatile("s_waitcnt vmcnt(0)" ::: "memory");
        }
    }
    __syncthreads();
}

#ifndef LATE_W
#define LATE_W 1
#endif
#define LBAR() do { asm volatile("s_waitcnt lgkmcnt(0)" ::: "memory"); __builtin_amdgcn_s_barrier(); asm volatile("" ::: "memory"); } while (0)
struct Args {
    const float* in[30]; float* out; unsigned char* ws; int ph_lo, ph_hi;
};
struct Frame {
    LAS unsigned char* lds; int tid, lane, wave, G, bid;
};

struct TrItem { const float* W; const float* ksc; h16* WT; int N, K, k0, ns, nv, nd; };
__device__ __forceinline__ void tr_load(const TrItem& P, f32x4 (&v)[8], int lane) {
    const int j4 = lane & 7, kq = lane >> 3;
#pragma unroll
    for (int i = 0; i < 8; ++i) { v[i] = (f32x4){0.f, 0.f, 0.f, 0.f}; if (4 * j4 < P.nv) v[i] = *(const GAS f32x4*)(P.W + (size_t)(P.k0 + kq + 8 * i) * P.N + P.ns + 4 * j4); }
}
__device__ __forceinline__ void tr_finish(const TrItem& P, f32x4 (&v)[8], LAS float* scr, int lane) {
    const int j4 = lane & 7, kq = lane >> 3;
    if (P.ksc) {
#pragma unroll
        for (int i = 0; i < 8; ++i) v[i] = v[i] * P.ksc[P.k0 + kq + 8 * i]; }
#pragma unroll
    for (int i = 0; i < 8; ++i) { LAS float* d = scr + (kq + 8 * i) * 33 + 4 * j4; d[0] = v[i].x; d[1] = v[i].y; d[2] = v[i].z; d[3] = v[i].w; }
    asm volatile("s_waitcnt lgkmcnt(0)" ::: "memory");
    const int c = lane & 7;
#pragma unroll
    for (int jj = 0; jj < 4; ++jj) { const int n = (lane >> 3) + 8 * jj; const LAS float* s = scr + (8 * c) * 33 + n;
        v4u o; o.x = pkh(s[0 * 33], s[1 * 33]); o.y = pkh(s[2 * 33], s[3 * 33]); o.z = pkh(s[4 * 33], s[5 * 33]); o.w = pkh(s[6 * 33], s[7 * 33]);
        *(GAS v4u*)(P.WT + (size_t)(P.nd + n) * P.K + P.k0 + 8 * c) = o; }
    asm volatile("s_waitcnt lgkmcnt(0)" ::: "memory");
}
__device__ __forceinline__ void rms_row_to_f16(const float* xrow, const float* w, h16* orow, int lane) {
    const GAS f32x4* xr = (const GAS f32x4*)xrow + lane; const GAS f32x4* wr = (const GAS f32x4*)w + lane;
    f32x4 v[8]; float s = 0.f;
#pragma unroll
    for (int j = 0; j < 8; ++j) { v[j] = xr[64 * j]; s += (v[j].x * v[j].x + v[j].y * v[j].y) + (v[j].z * v[j].z + v[j].w * v[j].w); }
    const float rstd = __builtin_amdgcn_rsqf(wave_sum(s) * (1.f / DM) + RMS_EPS);
    GAS v2u* o8 = (GAS v2u*)orow + lane;
#pragma unroll
    for (int j = 0; j < 8; ++j) { const f32x4 ww = wr[64 * j]; v2u o; o.x = pkh(v[j].x * rstd * ww.x, v[j].y * rstd * ww.y); o.y = pkh(v[j].z * rstd * ww.z, v[j].w * rstd * ww.w); o8[64 * j] = o; }
}
__device__ __forceinline__ void p0_weights(const Frame& F, const Args& a, int part, int gw, int NGW) {
    LAS float* scr = (LAS float*)(F.lds + F.wave * 16384);
    unsigned char* ws = a.ws; const int lane = F.lane;
    constexpr int I_IN = 240 * 32, I_K = 16 * 32, I_V = 16 * 32, I_LW = 32, I_LA = 32, I_LG = 64, I_OUT = 64 * 32, I_Q = 16 * 32, I_O = 64 * 8, I_1 = 256 * 32, I_2 = 64 * 128;
    constexpr int N_EARLY = I_IN + I_K + I_V + I_LW + I_LA + I_LG, N_LATE = I_OUT + I_Q + I_O + I_1 + I_2;
    h16* wall = (h16*)(ws + WS_WALL);
    const int nitems = part ? N_LATE : N_EARLY;
    auto decode = [&](int it, TrItem& P) {
        int r = it; P.ksc = nullptr; P.nv = 32;
        if (part == 0) {
            if (r < I_IN) { const int nb = r % 240, kb = r / 240;
                if (nb < 128) { P.ns = 32 * nb; } else if (nb == 128) { P.ns = 4096; P.nv = 16; } else if (nb < 233) { P.ns = 4112 + 32 * (nb - 129); } else { P.ns = 0; P.nv = 0; }
                P.W = a.in[3]; P.N = INC; P.K = DM; P.WT = wall; P.k0 = 64 * kb; P.nd = 32 * nb; }
            else if ((r -= I_IN) < I_K) { P.W = a.in[23]; P.N = 512; P.K = DM; P.WT = wall; P.k0 = 64 * (r / 16); P.ns = 32 * (r % 16); P.nd = 7680 + P.ns; }
            else if ((r -= I_K) < I_V) { P.W = a.in[24]; P.N = 512; P.K = DM; P.WT = wall; P.k0 = 64 * (r / 16); P.ns = 32 * (r % 16); P.nd = 8192 + P.ns; }
            else if ((r -= I_V) < I_LW) { P.W = a.in[10]; P.N = 1024; P.K = 64; P.WT = (h16*)(ws + WS_LORA); P.k0 = 0; P.ns = 32 * r; P.nd = P.ns; }
            else if ((r -= I_LW) < I_LA) { P.W = a.in[12]; P.N = 1024; P.K = 64; P.WT = (h16*)(ws + WS_LORA + 131072); P.k0 = 0; P.ns = 32 * r; P.nd = P.ns; }
            else { r -= I_LA; P.W = a.in[13]; P.N = 1024; P.K = 128; P.WT = (h16*)(ws + WS_LORA + 262144); P.k0 = 64 * (r / 32); P.ns = 32 * (r % 32); P.nd = P.ns; }
        } else {
            if (r < I_OUT) { P.W = a.in[19]; P.N = DM; P.K = DM; P.WT = (h16*)(ws + WS_WOUT); P.k0 = 64 * (r / 64); P.ns = 32 * (r % 64); P.nd = P.ns; }
            else if ((r -= I_OUT) < I_Q) { P.W = a.in[22]; P.N = 512; P.K = DM; P.WT = (h16*)(ws + WS_WQ); P.ksc = a.in[20]; P.k0 = 64 * (r / 16); P.ns = 32 * (r % 16); P.nd = P.ns; }
            else if ((r -= I_Q) < I_O) { P.W = a.in[25]; P.N = DM; P.K = 512; P.WT = (h16*)(ws + WS_WO); P.k0 = 64 * (r / 64); P.ns = 32 * (r % 64); P.nd = P.ns; }
            else if ((r -= I_O) < I_1) { P.W = a.in[27]; P.N = FF; P.K = DM; P.WT = (h16*)(ws + WS_W1); P.ksc = a.in[26]; P.k0 = 64 * (r / 256); P.ns = 32 * (r % 256); P.nd = P.ns; }
            else { r -= I_1; P.W = a.in[28]; P.N = DM; P.K = FF; P.WT = (h16*)(ws + WS_W2); P.k0 = 64 * (r / 64); P.ns = 32 * (r % 64); P.nd = P.ns; }
        } };
    if (gw < nitems) {
        TrItem Pc, Pn; f32x4 vc[8], vn[8]; decode(gw, Pc); tr_load(Pc, vc, lane);
        for (int it = gw; it < nitems; it += NGW) { const bool more = it + NGW < nitems;
            if (more) { decode(it + NGW, Pn); tr_load(Pn, vn, lane); }
            tr_finish(Pc, vc, scr, lane);
            if (more) { Pc = Pn;
#pragma unroll
                for (int i = 0; i < 8; ++i) vc[i] = vn[i]; } } }
}
__device__ __forceinline__ void p0_prologue(const Frame& F, const Args& a) {
    const int gw = F.bid * NWAVES + F.wave, NGW = F.G * NWAVES, lane = F.lane;
    p0_weights(F, a, 0, gw, NGW);
    if (!LATE_W) p0_weights(F, a, 1, gw, NGW);
    h16* aall = (h16*)a.out;
#ifndef ROWREP
#define ROWREP 1
#endif
#pragma unroll 1
    for (int rr_ = 0; rr_ < ROWREP; ++rr_)
    {
        auto rowp = [&](int m) -> const float* { return m < MTOK ? a.in[0] + (size_t)m * DM : a.in[1] + (size_t)(m - MTOK) * DM; };
        int m = gw; f32x4 v[8], nv[8];
        if (m < MTOK + MMEM) { const GAS f32x4* xr = (const GAS f32x4*)rowp(m) + lane;
#pragma unroll
            for (int j = 0; j < 8; ++j) v[j] = xr[64 * j]; }
        for (; m < MTOK + MMEM; m += NGW) { const int mn = m + NGW;
            if (mn < MTOK + MMEM) { const GAS f32x4* xr = (const GAS f32x4*)rowp(mn) + lane;
#pragma unroll
                for (int j = 0; j < 8; ++j) nv[j] = xr[64 * j]; }
            float s = 0.f;
#pragma unroll
            for (int j = 0; j < 8; ++j) s += (v[j].x * v[j].x + v[j].y * v[j].y) + (v[j].z * v[j].z + v[j].w * v[j].w);
            const float rstd = __builtin_amdgcn_rsqf(wave_sum(s) * (1.f / DM) + RMS_EPS);
            const GAS f32x4* wr = (const GAS f32x4*)(m < MTOK ? a.in[2] : a.in[21]) + lane; GAS v2u* o8 = (GAS v2u*)(aall + (size_t)m * DM) + lane;
#pragma unroll
            for (int j = 0; j < 8; ++j) { const f32x4 ww = wr[64 * j]; v2u o; o.x = pkh(v[j].x * rstd * ww.x, v[j].y * rstd * ww.y); o.y = pkh(v[j].z * rstd * ww.z, v[j].w * rstd * ww.w); o8[64 * j] = o; }
#pragma unroll
            for (int j = 0; j < 8; ++j) v[j] = nv[j]; } }
}
constexpr int DC_P = 136;
constexpr int DCL_RAWQ = 0, DCL_RAWK = DCL_RAWQ + 64 * DC_P * 2, DCL_VV = DCL_RAWK + 64 * DC_P * 2, DCL_QH = DCL_VV + 64 * DC_P * 2, DCL_KH = DCL_QH + 64 * DC_P * 2, DCL_KBH = DCL_KH + 64 * DC_P * 2,
              DCL_KDT = DCL_KBH + 64 * DC_P * 2, DCL_ATT = DCL_KDT + 4 * 128 * 16 * 2, DCL_AMT = DCL_ATT + 64 * 24 * 2, DCL_SM = DCL_AMT + 4 * 16 * 20 * 4, DCL_END = DCL_SM + 2048;
constexpr int DCL_QG = DCL_RAWQ, DCL_XW = DCL_QH  , DCL_OS = DCL_VV;
static_assert(64 * 264 * 2 <= 2 * 64 * DC_P * 2 && DCL_END <= LDS_BYTES, "DN LDS map");
__device__ __forceinline__ void dn_chunked(const Frame& F, const Args& a, int unit) {
    const int b = unit >> 3, h = unit & 7;
    const int tid = F.tid, lane = F.lane, w = F.wave, l15 = lane & 15, lg = lane >> 4;
    LAS h16* RAWQ = (LAS h16*)(F.lds + DCL_RAWQ); LAS h16* RAWK = (LAS h16*)(F.lds + DCL_RAWK); LAS h16* VV = (LAS h16*)(F.lds + DCL_VV);
    LAS h16* QH = (LAS h16*)(F.lds + DCL_QH); LAS h16* KH = (LAS h16*)(F.lds + DCL_KH); LAS h16* KBH = (LAS h16*)(F.lds + DCL_KBH);
    LAS h16* KDT = (LAS h16*)(F.lds + DCL_KDT); LAS h16* ATT = (LAS h16*)(F.lds + DCL_ATT); LAS float* AMT = (LAS float*)(F.lds + DCL_AMT);
    LAS float* gS = (LAS float*)(F.lds + DCL_SM); LAS float* betaS = gS + 64; LAS float* egcS = gS + 128; LAS float* eclS = gS + 192; LAS float* gcS = gS + 256; LAS float* nwS = gS + 320;
    LAS h16* QG = (LAS h16*)(F.lds + DCL_QG); LAS h16* XW = (LAS h16*)(F.lds + DCL_XW); LAS h16* OS = (LAS h16*)(F.lds + DCL_OS);
    const h16* P = (const h16*)(a.ws + WS_P); h16* omix = (h16*)(a.ws + WS_OMIX);
    const size_t row0 = (size_t)b * SEQ;
    const bool is_col = tid < 384, is_g = (tid >= 384 && tid < 448);
    const int cp = tid % 192, rg = tid / 192;
    int pcol = 0; f32x2 cw0 = {0.f, 0.f}, cw1 = cw0, cw2 = cw0, cw3 = cw0;
    if (is_col) { pcol = (cp >> 6) * 1024 + h * 128 + 2 * (cp & 63); const float* cw = a.in[4]; cw0 = *(const f32x2*)(cw + pcol); cw1 = *(const f32x2*)(cw + 3072 + pcol); cw2 = *(const f32x2*)(cw + 6144 + pcol); cw3 = *(const f32x2*)(cw + 9216 + pcol); }
    const float neg_ea = -fexp(a.in[5][h]), dtb = a.in[6][h];
    const int pt = tid >> 3, pp = tid & 7;
    unsigned raw[35]; h16 rg0 = 0, rg1 = 0;
    pg8::f32x4 S[8];
#pragma unroll
    for (int i = 0; i < 8; ++i) S[i] = (pg8::f32x4){0.f, 0.f, 0.f, 0.f};
    const __amdgpu_buffer_rsrc_t prs = __builtin_amdgcn_make_buffer_rsrc((void*)(P - 3 * PW), (short)0, (MTOK + 3) * PW * 2, 0x00020000);
#define DC_LOAD_RAW(t0_) do { if (is_col) { const int tb = (t0_) + 32 * rg; const unsigned vo = (unsigned)((row0 + tb) * PW + pcol) * 2u; \
            _Pragma("unroll") for (int i = 0; i < 35; ++i) { const unsigned v = __builtin_amdgcn_raw_buffer_load_b32(prs, vo, i * PW * 2, 0); raw[i] = (tb + i >= 3) ? v : 0u; } } \
        else if (is_g) { const int t = (t0_) + (tid - 384); rg0 = P[(row0 + t) * PW + 4096 + h]; rg1 = P[(row0 + t) * PW + 4104 + h]; } } while (0)
    if (tid < 128) nwS[tid] = a.in[7][tid];
    v4u zpre0 = {0u, 0u, 0u, 0u}, zpre1 = zpre0;
#define DC_LOAD_Z(t0_) do { const GAS v4u* zp = (const GAS v4u*)(P + (row0 + (t0_) + pt) * PW + 3072 + h * 128 + 16 * pp); zpre0 = zp[0]; zpre1 = zp[1]; } while (0)
#ifdef DIAG_STG
    unsigned long long stg_t[8] = {0, 0, 0, 0, 0, 0, 0, 0}, stg_last = __builtin_amdgcn_s_memrealtime();
#define STG(i) do { const unsigned long long n_ = __builtin_amdgcn_s_memrealtime(); stg_t[i] += n_ - stg_last; stg_last = n_; } while (0)
#else
#define STG(i) do { } while (0)
#endif
    DC_LOAD_RAW(0); DC_LOAD_Z(0);
    for (int bt = 0; bt < SEQ / 64; ++bt) {
        const int t0 = bt * 64;
        if (is_col) { LAS h16* dst = (cp < 64 ? RAWQ : (cp < 128 ? RAWK : VV)) + 2 * (cp & 63);
#pragma unroll
            for (int t = 0; t < 32; ++t) { f32x2 y = {0.f, 0.f};
#pragma unroll
                for (int j = 0; j < 4; ++j) { const unsigned rw = raw[t + j]; const f32x2 x = {h2f((h16)(rw & 0xffff)), h2f((h16)(rw >> 16))}; y += (j == 0 ? cw0 : j == 1 ? cw1 : j == 2 ? cw2 : cw3) * x; }
                y.x = y.x * sigmoidf_(y.x); y.y = y.y * sigmoidf_(y.y);
                *(LAS unsigned*)(dst + (32 * rg + t) * DC_P) = pkh(y.x, y.y); if ((t & 7) == 7) __builtin_amdgcn_sched_barrier(0); }
        } else if (is_g) { const int t = tid - 384; gS[t] = neg_ea * softplusf_(h2f(rg0) + dtb); betaS[t] = sigmoidf_(h2f(rg1)); }
        LBAR(); STG(0);
        { const int t = pt, c16 = t & ~15; float gc = 0.f, gl = 0.f;
            for (int i = 0; i < 16; ++i) { const float gv = gS[c16 + i]; gl += gv; if (c16 + i <= t) gc += gv; }
            const float egc = fexp(gc), ekd = fexp(gl - gc), beta = betaS[t];
            if (pp == 0) { egcS[t] = egc; gcS[t] = gc; if ((t & 15) == 15) eclS[t >> 4] = fexp(gl); }
            const LAS h16* qp = RAWQ + t * DC_P + 16 * pp; const LAS h16* kp = RAWK + t * DC_P + 16 * pp;
            const h16x8 q0 = *(const LAS h16x8*)qp, q1 = *(const LAS h16x8*)(qp + 8), k0 = *(const LAS h16x8*)kp, k1 = *(const LAS h16x8*)(kp + 8);
            float qf[16], kf[16]; float sq = 0.f, sk = 0.f;
#pragma unroll
            for (int i = 0; i < 8; ++i) { qf[i] = (float)q0[i]; qf[8 + i] = (float)q1[i]; kf[i] = (float)k0[i]; kf[8 + i] = (float)k1[i]; }
#pragma unroll
            for (int i = 0; i < 16; ++i) { sq += qf[i] * qf[i]; sk += kf[i] * kf[i]; }
            sq = red8(sq); sk = red8(sk);
            const float rq = __builtin_amdgcn_rsqf(sq + 1e-6f) * 0.08838834764831845f, rk = __builtin_amdgcn_rsqf(sk + 1e-6f);
            unsigned oq[8], og[8], ok[8], ob[8];
#pragma unroll
            for (int i = 0; i < 8; ++i) { const float qa = qf[2 * i] * rq, qb = qf[2 * i + 1] * rq, ka = kf[2 * i] * rk, kb = kf[2 * i + 1] * rk;
                oq[i] = pkh(qa, qb); og[i] = pkh(qa * egc, qb * egc); ok[i] = pkh(ka, kb); ob[i] = pkh(ka * beta, kb * beta);
                KDT[((t >> 4) * 128 + 16 * pp + 2 * i) * 16 + (t & 15)] = f2h(ka * ekd); KDT[((t >> 4) * 128 + 16 * pp + 2 * i + 1) * 16 + (t & 15)] = f2h(kb * ekd); }
            *(LAS v4u*)(QH + t * DC_P + 16 * pp) = (v4u){oq[0], oq[1], oq[2], oq[3]}; *(LAS v4u*)(QH + t * DC_P + 16 * pp + 8) = (v4u){oq[4], oq[5], oq[6], oq[7]};
            *(LAS v4u*)(QG + t * DC_P + 16 * pp) = (v4u){og[0], og[1], og[2], og[3]}; *(LAS v4u*)(QG + t * DC_P + 16 * pp + 8) = (v4u){og[4], og[5], og[6], og[7]};
            *(LAS v4u*)(KH + t * DC_P + 16 * pp) = (v4u){ok[0], ok[1], ok[2], ok[3]}; *(LAS v4u*)(KH + t * DC_P + 16 * pp + 8) = (v4u){ok[4], ok[5], ok[6], ok[7]};
            *(LAS v4u*)(KBH + t * DC_P + 16 * pp) = (v4u){ob[0], ob[1], ob[2], ob[3]}; *(LAS v4u*)(KBH + t * DC_P + 16 * pp + 8) = (v4u){ob[4], ob[5], ob[6], ob[7]}; }
        LBAR(); STG(1);
        { const int c = w & 3, which = w >> 2; const LAS h16* Am = (which ? QH : KBH) + (16 * c + l15) * DC_P + 8 * lg; const LAS h16* Bm = KH + (16 * c + l15) * DC_P + 8 * lg;
            pg8::f32x4 acc = {0.f, 0.f, 0.f, 0.f};
#pragma unroll
            for (int ks = 0; ks < 4; ++ks) acc = __builtin_amdgcn_mfma_f32_16x16x32_f16(*(const LAS h16x8*)(Am + 32 * ks), *(const LAS h16x8*)(Bm + 32 * ks), acc, 0, 0, 0);
            const float gj = gcS[16 * c + l15];
#pragma unroll
            for (int r = 0; r < 4; ++r) { const int i = 4 * lg + r, j = l15; const float dec = fexp(gcS[16 * c + i] - gj);
                if (which) ATT[(16 * c + i) * 24 + j] = f2h(i >= j ? acc[r] * dec : 0.f); else AMT[(c * 16 + j) * 20 + i] = (i > j ? acc[r] * dec : 0.f); } }
        LBAR(); STG(2);
        { const int c = tid >> 7, cp = tid & 127, col = 2 * cp; f32x2 x[16];
#pragma unroll
            for (int i = 0; i < 16; ++i) { const int t = 16 * c + i; const unsigned rv = col < 128 ? *(const LAS unsigned*)(VV + t * DC_P + col) : *(const LAS unsigned*)(KBH + t * DC_P + col - 128);
                const float sc = col < 128 ? betaS[t] : egcS[t]; x[i] = (f32x2){h2f((h16)(rv & 0xffff)), h2f((h16)(rv >> 16))} * sc; }
#pragma unroll
            for (int j = 0; j < 15; ++j) { const LAS f32x4* ap4 = (const LAS f32x4*)(AMT + (c * 16 + j) * 20); float ap[16];
#pragma unroll
                for (int q = (j + 1) / 4; q < 4; ++q) { const f32x4 v = ap4[q]; ap[4 * q] = v.x; ap[4 * q + 1] = v.y; ap[4 * q + 2] = v.z; ap[4 * q + 3] = v.w; }
#pragma unroll
                for (int i = j + 1; i < 16; ++i) x[i] -= x[j] * ap[i]; }
#pragma unroll
            for (int i = 0; i < 16; ++i) *(LAS unsigned*)(XW + (16 * c + i) * 264 + col) = pkh(x[i].x, x[i].y); }
        LBAR(); STG(3);
        if (bt + 1 < SEQ / 64) DC_LOAD_RAW(t0 + 64);
#pragma unroll 1
        for (int c = 0; c < 4; ++c) { const int T0 = 16 * c;
            h16x8 sf[4];
#pragma unroll
            for (int s = 0; s < 4; ++s) { const v4u t = {pkh(S[2 * s][0], S[2 * s][1]), pkh(S[2 * s][2], S[2 * s][3]), pkh(S[2 * s + 1][0], S[2 * s + 1][1]), pkh(S[2 * s + 1][2], S[2 * s + 1][3])}; sf[s] = __builtin_bit_cast(h16x8, t); }
            pg8::f32x4 av = {0.f, 0.f, 0.f, 0.f}, ao = av;
#pragma unroll
            for (int s = 0; s < 4; ++s) { const LAS h16* wp = XW + (T0 + l15) * 264 + 128 + 32 * s + 4 * lg; const v2u lo = *(const LAS v2u*)wp, hi = *(const LAS v2u*)(wp + 16);
                av = __builtin_amdgcn_mfma_f32_16x16x32_f16(__builtin_bit_cast(h16x8, (v4u){lo.x, lo.y, hi.x, hi.y}), sf[s], av, 0, 0, 0);
                const LAS h16* qp = QG + (T0 + l15) * DC_P + 32 * s + 4 * lg; const v2u ql = *(const LAS v2u*)qp, qh = *(const LAS v2u*)(qp + 16);
                ao = __builtin_amdgcn_mfma_f32_16x16x32_f16(__builtin_bit_cast(h16x8, (v4u){ql.x, ql.y, qh.x, qh.y}), sf[s], ao, 0, 0, 0); }
            float vn[4];
#pragma unroll
            for (int r = 0; r < 4; ++r) vn[r] = h2f(XW[(T0 + 4 * lg + r) * 264 + 16 * w + l15]) - av[r];
            const h16x8 vf = __builtin_bit_cast(h16x8, (v4u){pkh(vn[0], vn[1]), pkh(vn[2], vn[3]), 0u, 0u});
            { const v2u al = *(const LAS v2u*)(ATT + (T0 + l15) * 24 + 4 * lg); ao = __builtin_amdgcn_mfma_f32_16x16x32_f16(__builtin_bit_cast(h16x8, (v4u){al.x, al.y, 0u, 0u}), vf, ao, 0, 0, 0); }
            const float ecl = eclS[c];
#pragma unroll
            for (int tau = 0; tau < 8; ++tau) { const v2u kl = *(const LAS v2u*)(KDT + ((c * 128 + 16 * tau + l15) * 16) + 4 * lg);
                S[tau] = __builtin_amdgcn_mfma_f32_16x16x32_f16(__builtin_bit_cast(h16x8, (v4u){kl.x, kl.y, 0u, 0u}), vf, S[tau] * ecl, 0, 0, 0); }
#pragma unroll
            for (int r = 0; r < 4; ++r) OS[(T0 + 4 * lg + r) * DC_P + 16 * w + l15] = f2h(ao[r]);
        }
        LBAR(); STG(4);
        { const LAS h16* op = OS + pt * DC_P + 16 * pp; const h16x8 o0 = *(const LAS h16x8*)op, o1 = *(const LAS h16x8*)(op + 8);
            const v4u z0 = zpre0, z1 = zpre1;
            f32x4 nw[4];
#pragma unroll
            for (int j = 0; j < 4; ++j) nw[j] = *(const LAS f32x4*)(nwS + 16 * pp + 4 * j);
            float of[16]; float s = 0.f;
#pragma unroll
            for (int i = 0; i < 8; ++i) { of[i] = (float)o0[i]; of[8 + i] = (float)o1[i]; }
#pragma unroll
            for (int i = 0; i < 16; ++i) s += of[i] * of[i];
            s = red8(s); const float rstd = __builtin_amdgcn_rsqf(s * (1.0f / 128.0f) + RMS_EPS);
            const unsigned zz[8] = {z0.x, z0.y, z0.z, z0.w, z1.x, z1.y, z1.z, z1.w}; unsigned ow[8];
#pragma unroll
            for (int i = 0; i < 8; ++i) { const float za = h2f((h16)(zz[i] & 0xffff)), zb = h2f((h16)(zz[i] >> 16)); const float wa = nw[i >> 1][(2 * i) & 3], wb = nw[i >> 1][(2 * i + 1) & 3];
                ow[i] = pkh(of[2 * i] * rstd * wa * za * sigmoidf_(za), of[2 * i + 1] * rstd * wb * zb * sigmoidf_(zb)); }
            GAS v4u* dst = (GAS v4u*)(omix + (row0 + t0 + pt) * DM + h * 128 + 16 * pp);
            dst[0] = (v4u){ow[0], ow[1], ow[2], ow[3]}; dst[1] = (v4u){ow[4], ow[5], ow[6], ow[7]}; }
        if (bt + 1 < SEQ / 64) DC_LOAD_Z(t0 + 64);
        LBAR(); STG(5);
    }
#ifdef DIAG_STG
    if (tid == 0 && unit == 0) { unsigned long long* tsq = (unsigned long long*)(a.ws + WS_CTL + 4096); unsigned long long c_ = 0; tsq[48] = 0;
#pragma unroll
        for (int i = 0; i < 6; ++i) { c_ += stg_t[i]; tsq[49 + i] = c_; } }
#endif
#undef STG
#undef DC_LOAD_Z
#undef DC_LOAD_RAW
}
constexpr int RC_FP = 68, RC_F = RC_FP * 64 * 4, RC_H = 72 * 64 * 2;
constexpr int RCL_RL = 0, RCL_PKL = RCL_RL + RC_F, RCL_GL = RCL_PKL + RC_F, RCL_ALR = RCL_GL + RC_F, RCL_GATE = RCL_ALR + RC_F, RCL_VH = RCL_GATE + RC_F, RCL_HW = RCL_VH + RC_H, RCL_HA = RCL_HW + RC_H,
              RCL_HG = RCL_HA + RC_H, RCL_BR = RCL_HG + 64 * 136 * 2, RCL_KR = RCL_BR + RC_H, RCL_KHT = RCL_KR + RC_H, RCL_WC = RCL_KHT + 8192, RCL_BON = RCL_WC + 1024, RCL_CST = RCL_BON + 256, RCL_END = RCL_CST + 7 * 256;
constexpr int RCL_LT = RCL_RL, RCL_RHS2 = RCL_LT + 5120, RCL_MRB = RCL_RHS2 + 5120, RCL_MRK = RCL_MRB + 3072;
constexpr int RCL_WP = RCL_PKL, RCL_TL = RCL_WP + RC_H;
constexpr int RCL_YL = RCL_GL, RCL_ATF = RCL_ALR, RCL_AR = RCL_HW, RCL_RT = RCL_HA, RCL_RR = RCL_HG, RCL_BHT = RCL_HG + RC_H;
static_assert(RCL_MRK + 3072 <= RCL_PKL && RCL_TL + 3072 <= RCL_GL && RCL_BHT + 8192 <= RCL_BR && RCL_END <= LDS_BYTES, "RW LDS map");
__device__ __forceinline__ void rw_chunked(const Frame& F, const Args& a, int unit) {
    const int b = unit >> 4, h = unit & 15;
    const int tid0 = F.tid, w = F.wave;
    LAS float* RL = (LAS float*)(F.lds + RCL_RL); LAS float* PKL = (LAS float*)(F.lds + RCL_PKL); LAS float* GL = (LAS float*)(F.lds + RCL_GL); LAS float* ALR = (LAS float*)(F.lds + RCL_ALR);
    LAS float* GATE = (LAS float*)(F.lds + RCL_GATE); LAS h16* VH = (LAS h16*)(F.lds + RCL_VH); LAS h16* HW = (LAS h16*)(F.lds + RCL_HW); LAS h16* HA = (LAS h16*)(F.lds + RCL_HA); LAS h16* HG = (LAS h16*)(F.lds + RCL_HG);
    LAS h16* BR = (LAS h16*)(F.lds + RCL_BR); LAS h16* KR = (LAS h16*)(F.lds + RCL_KR); LAS h16* KHT = (LAS h16*)(F.lds + RCL_KHT); LAS float* WC = (LAS float*)(F.lds + RCL_WC); LAS float* BON = (LAS float*)(F.lds + RCL_BON);
    LAS float* LT = (LAS float*)(F.lds + RCL_LT); LAS float* RHS2 = (LAS float*)(F.lds + RCL_RHS2); LAS h16* MRB = (LAS h16*)(F.lds + RCL_MRB); LAS h16* MRK = (LAS h16*)(F.lds + RCL_MRK);
    LAS h16* WP = (LAS h16*)(F.lds + RCL_WP); LAS h16* TL = (LAS h16*)(F.lds + RCL_TL); LAS float* YL = (LAS float*)(F.lds + RCL_YL); LAS float* ATF = (LAS float*)(F.lds + RCL_ATF);
    LAS h16* AR = (LAS h16*)(F.lds + RCL_AR); LAS h16* RT = (LAS h16*)(F.lds + RCL_RT); LAS h16* RR = (LAS h16*)(F.lds + RCL_RR); LAS h16* BHT = (LAS h16*)(F.lds + RCL_BHT);
    const h16* P = (const h16*)(a.ws + WS_P); h16* omix = (h16*)(a.ws + WS_OMIX);
    const size_t row0 = (size_t)b * SEQ;
    const bool is_col = tid0 < 448; const int cp = tid0 % 224, rgp = tid0 / 224;
    int rcol = 0; f32x2 mu = {0.f, 0.f};
    if (is_col) { rcol = cp < 96 ? (cp >> 5) * 1024 + h * 64 + 2 * (cp & 31) : 3072 + 2 * (cp - 96); mu = *(const f32x2*)(a.in[8] + rcol); }
    int kind = 0, dstb = 0, dstride = RC_FP * 4;
    if (cp < 32) { dstb = RCL_RL + 8 * cp; } else if (cp < 64) { dstb = RCL_PKL + 8 * (cp - 32); } else if (cp < 96) { kind = 1; dstb = RCL_VH + 4 * (cp - 64); dstride = 144; }
    else if (cp < 128) { kind = 2; dstb = RCL_HW + 4 * (cp - 96); dstride = 144; } else if (cp < 160) { kind = 1; dstb = RCL_HA + 4 * (cp - 128); dstride = 144; } else { kind = 3; dstb = RCL_HG + 4 * (cp - 160); dstride = 272; }
    const __amdgpu_buffer_rsrc_t prs = __builtin_amdgcn_make_buffer_rsrc((void*)(P - PW), (short)0, (MTOK + 1) * PW * 2, 0x00020000);
    unsigned raw[33];
#define RC_LOAD_RAW(t0_) do { if (is_col) { const int tb = (t0_) + 32 * rgp; const unsigned vo = (unsigned)((row0 + tb) * PW + RW0 + rcol) * 2u; \
            _Pragma("unroll") for (int i = 0; i < 33; ++i) { const unsigned v = __builtin_amdgcn_raw_buffer_load_b32(prs, vo, i * PW * 2, 0); raw[i] = (tb + i >= 1) ? v : 0u; } } } while (0)
    pg8::f32x4 St[4];
#pragma unroll
    for (int i = 0; i < 4; ++i) St[i] = (pg8::f32x4){0.f, 0.f, 0.f, 0.f};
    h16x8 bq[4];
    { const int n = h * 64 + 16 * (w & 3) + (F.lane & 15), lg0 = F.lane >> 4;
        if (w < 4) { const h16* w2T = (const h16*)(a.ws + WS_LORA) + (size_t)n * 64 + 8 * lg0; const h16* a2T = (const h16*)(a.ws + WS_LORA + 131072) + (size_t)n * 64 + 8 * lg0;
            bq[0] = *(const GAS h16x8*)w2T; bq[1] = *(const GAS h16x8*)(w2T + 32); bq[2] = *(const GAS h16x8*)a2T; bq[3] = *(const GAS h16x8*)(a2T + 32); }
        else { const h16* g2T = (const h16*)(a.ws + WS_LORA + 262144) + (size_t)n * 128 + 8 * lg0;
#pragma unroll
            for (int ks = 0; ks < 4; ++ks) bq[ks] = *(const GAS h16x8*)(g2T + 32 * ks); } }
    LAS float* CST = (LAS float*)(F.lds + RCL_CST);
    if (tid0 < 448) { const int q = tid0 >> 6, n = tid0 & 63; const int src[7] = {14, 15, 16, 17, 18, 9, 11}; CST[q * 64 + n] = a.in[src[q]][h * 64 + n]; }
#ifdef DIAG_STG
    unsigned long long stg_t[10] = {0, 0, 0, 0, 0, 0, 0, 0, 0, 0}, stg_last = __builtin_amdgcn_s_memrealtime();
#define STG(i) do { const unsigned long long n_ = __builtin_amdgcn_s_memrealtime(); stg_t[i] += n_ - stg_last; stg_last = n_; } while (0)
#else
#define STG(i) do { } while (0)
#endif
    RC_LOAD_RAW(0);
    for (int bt = 0; bt < SEQ / 64; ++bt) {
        const int t0 = bt * 64;
        int tid = tid0; asm volatile("" : "+v"(tid));
        const int lane = tid & 63, l15 = lane & 15, lg = lane >> 4, ft = tid >> 3, fp = tid & 7, hc0 = h * 64 + 8 * fp;
#ifndef S1REP
#define S1REP 1
#endif
#ifdef S1UNROLL
#pragma unroll
#else
#pragma unroll 1
#endif
        for (int rep_ = 0; rep_ < S1REP; ++rep_)
        if (is_col) { unsigned ad = (unsigned)(dstb + 32 * rgp * dstride); asm volatile("" : "+v"(ad));
#pragma unroll
            for (int t = 0; t < 32; ++t) { const unsigned rw = raw[t + 1], rp = raw[t]; const f32x2 x = {h2f((h16)(rw & 0xffff)), h2f((h16)(rw >> 16))}, xp = {h2f((h16)(rp & 0xffff)), h2f((h16)(rp >> 16))};
                f32x2 y = x + (xp - x) * mu;
                if (kind == 0) { *(LAS f32x2*)(F.lds + ad) = y; }
                else { *(LAS unsigned*)(F.lds + ad) = pkh(y.x, y.y); }
                ad += dstride; if ((t & 7) == 7) __builtin_amdgcn_sched_barrier(0); }
        }
        LBAR(); STG(0);
#pragma unroll 2
        for (int i = tid; i < 64 * 32; i += NTHREADS) { LAS unsigned* p = (LAS unsigned*)(HW + (i >> 5) * 72 + 2 * (i & 31)); const unsigned v = *p; *p = pkh(ftanh(h2f((h16)(v & 0xffff))), ftanh(h2f((h16)(v >> 16)))); }
#pragma unroll 2
        for (int i = tid; i < 64 * 64; i += NTHREADS) { LAS unsigned* p = (LAS unsigned*)(HG + (i >> 6) * 136 + 2 * (i & 63)); const unsigned v = *p; *p = pkh(sigmoidf_(h2f((h16)(v & 0xffff))), sigmoidf_(h2f((h16)(v >> 16)))); }
        LBAR();
        { const int nt = w & 3, n = 16 * nt + l15;
            if (w < 4) { const float c_w0 = CST[320 + n], c_a0 = CST[384 + n];
#pragma unroll
                for (int mt = 0; mt < 4; ++mt) { pg8::f32x4 accw = {0.f, 0.f, 0.f, 0.f}, acca = accw;
#pragma unroll
                    for (int ks = 0; ks < 2; ++ks) { accw = __builtin_amdgcn_mfma_f32_16x16x32_f16(*(const LAS h16x8*)(HW + (16 * mt + l15) * 72 + 32 * ks + 8 * lg), bq[ks], accw, 0, 0, 0);
                        acca = __builtin_amdgcn_mfma_f32_16x16x32_f16(*(const LAS h16x8*)(HA + (16 * mt + l15) * 72 + 32 * ks + 8 * lg), bq[2 + ks], acca, 0, 0, 0); }
                    float ld[4];
#pragma unroll
                    for (int r = 0; r < 4; ++r) { const float lw = -softplusf_(-(c_w0 + accw[r])) - 0.5f; ld[r] = -fexp(lw); }
                    ld[1] += ld[0]; ld[2] += ld[1]; ld[3] += ld[2];
                    { const float tot = ld[3]; const float t1 = __shfl_up(tot, 16), t2 = __shfl_up(tot, 32), t3 = __shfl_up(tot, 48);
                      const float off = (lg >= 1 ? t1 : 0.f) + (lg >= 2 ? t2 : 0.f) + (lg >= 3 ? t3 : 0.f);
#pragma unroll
                      for (int r = 0; r < 4; ++r) { const int tok = 16 * mt + 4 * lg + r; GL[tok * RC_FP + n] = ld[r] + off; ALR[tok * RC_FP + n] = sigmoidf_(c_a0 + acca[r]); } } }
            } else {
#pragma unroll
                for (int mt = 0; mt < 4; ++mt) { pg8::f32x4 accg = {0.f, 0.f, 0.f, 0.f};
#pragma unroll
                    for (int ks = 0; ks < 4; ++ks) accg = __builtin_amdgcn_mfma_f32_16x16x32_f16(*(const LAS h16x8*)(HG + (16 * mt + l15) * 136 + 32 * ks + 8 * lg), bq[ks], accg, 0, 0, 0);
#pragma unroll
                    for (int r = 0; r < 4; ++r) GATE[(16 * mt + 4 * lg + r) * RC_FP + n] = accg[r]; } } }
        LBAR(); STG(1);
        { const int t = ft, c16 = t & ~15, tl = t & 15, c = t >> 4;
            const f32x4 ckk0 = *(const LAS f32x4*)(CST + 8 * fp), ckk1 = *(const LAS f32x4*)(CST + 8 * fp + 4), cka0 = *(const LAS f32x4*)(CST + 64 + 8 * fp), cka1 = *(const LAS f32x4*)(CST + 64 + 8 * fp + 4),
                        crk0 = *(const LAS f32x4*)(CST + 128 + 8 * fp), crk1 = *(const LAS f32x4*)(CST + 128 + 8 * fp + 4);
            const float ckk[8] = {ckk0.x, ckk0.y, ckk0.z, ckk0.w, ckk1.x, ckk1.y, ckk1.z, ckk1.w}, cka[8] = {cka0.x, cka0.y, cka0.z, cka0.w, cka1.x, cka1.y, cka1.z, cka1.w}, crk[8] = {crk0.x, crk0.y, crk0.z, crk0.w, crk1.x, crk1.y, crk1.z, crk1.w};
            float pk[8], rr[8], al[8], kk[8], kf[8], bb[8], gt[8], gp[8], gl[8], gr[8]; float ss = 0.f, bon = 0.f;
#pragma unroll
            for (int q = 0; q < 2; ++q) { const int o = t * RC_FP + 8 * fp + 4 * q;
                const f32x4 a_ = *(const LAS f32x4*)(PKL + o), b_ = *(const LAS f32x4*)(RL + o), c_ = *(const LAS f32x4*)(ALR + o), g0 = *(const LAS f32x4*)(GL + o),
                            g2 = *(const LAS f32x4*)(GL + (c16 + 15) * RC_FP + 8 * fp + 4 * q), g3 = *(const LAS f32x4*)(GL + (c16 + 7) * RC_FP + 8 * fp + 4 * q);
                f32x4 g1 = {0.f, 0.f, 0.f, 0.f}; if (tl) g1 = *(const LAS f32x4*)(GL + o - RC_FP);
#pragma unroll
                for (int e = 0; e < 4; ++e) { pk[4 * q + e] = a_[e]; rr[4 * q + e] = b_[e]; al[4 * q + e] = c_[e]; gt[4 * q + e] = g0[e]; gp[4 * q + e] = g1[e]; gl[4 * q + e] = g2[e]; gr[4 * q + e] = g3[e]; } }
#pragma unroll
            for (int i = 0; i < 8; ++i) { kk[i] = pk[i] * ckk[i]; ss += kk[i] * kk[i]; }
            ss = red8(ss); const float inv = 1.0f / fmaxf(__builtin_amdgcn_sqrtf(ss), 1e-12f);
#pragma unroll
            for (int i = 0; i < 8; ++i) { kk[i] *= inv; kf[i] = pk[i] * (1.0f + (al[i] - 1.0f) * cka[i]); bb[i] = kk[i] * al[i]; bon += rr[i] * kf[i] * crk[i]; }
            bon = red8(bon); if (fp == 0) BON[t] = bon;
            unsigned oar[4], ort[4], orr[4], obr[4], okr[4]; float atf[8];
#pragma unroll
            for (int i = 0; i < 8; i += 2) { float va[2], vr[2], vrr[2], vb[2], vk[2];
#pragma unroll
                for (int e = 0; e < 2; ++e) { const int n = 8 * fp + i + e; const float Gt = gt[i + e], Gp = gp[i + e], Gl = gl[i + e], Gr = gr[i + e];
                    const float ap = -kk[i + e];
                    atf[i + e] = ap * fexp(Gp); va[e] = ap * fexp(Gp - Gr); vr[e] = rr[i + e] * fexp(Gt); vrr[e] = rr[i + e] * fexp(Gt - Gr);
                    const float er = fexp(Gr - Gt), el = fexp(Gl - Gt); vb[e] = bb[i + e] * er; vk[e] = kf[i + e] * er;
                    BHT[(c * 64 + n) * 16 + tl] = f2h(bb[i + e] * el); KHT[(c * 64 + n) * 16 + tl] = f2h(kf[i + e] * el); }
                oar[i >> 1] = pkh(va[0], va[1]); ort[i >> 1] = pkh(vr[0], vr[1]); orr[i >> 1] = pkh(vrr[0], vrr[1]); obr[i >> 1] = pkh(vb[0], vb[1]); okr[i >> 1] = pkh(vk[0], vk[1]); }
            *(LAS f32x4*)(ATF + t * RC_FP + 8 * fp) = (f32x4){atf[0], atf[1], atf[2], atf[3]}; *(LAS f32x4*)(ATF + t * RC_FP + 8 * fp + 4) = (f32x4){atf[4], atf[5], atf[6], atf[7]};
            if (tl == 15) { *(LAS f32x4*)(WC + c * 64 + 8 * fp) = (f32x4){fexp(gl[0]), fexp(gl[1]), fexp(gl[2]), fexp(gl[3])}; *(LAS f32x4*)(WC + c * 64 + 8 * fp + 4) = (f32x4){fexp(gl[4]), fexp(gl[5]), fexp(gl[6]), fexp(gl[7])}; }
            *(LAS v4u*)(AR + t * 72 + 8 * fp) = (v4u){oar[0], oar[1], oar[2], oar[3]}; *(LAS v4u*)(RT + t * 72 + 8 * fp) = (v4u){ort[0], ort[1], ort[2], ort[3]};
            *(LAS v4u*)(RR + t * 72 + 8 * fp) = (v4u){orr[0], orr[1], orr[2], orr[3]}; *(LAS v4u*)(BR + t * 72 + 8 * fp) = (v4u){obr[0], obr[1], obr[2], obr[3]};
            *(LAS v4u*)(KR + t * 72 + 8 * fp) = (v4u){okr[0], okr[1], okr[2], okr[3]}; }
        LBAR(); STG(3);
        { const int c = w & 3, rt = w >> 2; const LAS h16* Am = (rt ? RR : AR) + (16 * c + l15) * 72 + 8 * lg;
#pragma unroll
            for (int ct = 0; ct < 2; ++ct) { const LAS h16* Bm = (ct ? KR : BR) + (16 * c + l15) * 72 + 8 * lg; pg8::f32x4 acc = {0.f, 0.f, 0.f, 0.f};
#pragma unroll
                for (int ks = 0; ks < 2; ++ks) acc = __builtin_amdgcn_mfma_f32_16x16x32_f16(*(const LAS h16x8*)(Am + 32 * ks), *(const LAS h16x8*)(Bm + 32 * ks), acc, 0, 0, 0);
#pragma unroll
                for (int r = 0; r < 4; ++r) { const int t = 4 * lg + r, i = l15;
                    if (rt == 0) { const float v = t > i ? acc[r] : 0.f; if (ct == 0) LT[(c * 16 + i) * 20 + t] = v; else RHS2[(c * 16 + t) * 20 + i] = v; }
                    else { const h16 v = f2h(t >= i ? acc[r] : 0.f); if (ct == 0) MRB[(16 * c + t) * 24 + i] = v; else MRK[(16 * c + t) * 24 + i] = v; } } } }
        LBAR(); STG(4);
        if (tid < 320) { const int c = tid / 80, col = tid % 80; float x[16];
#pragma unroll
            for (int i = 0; i < 16; ++i) x[i] = col < 64 ? ATF[(16 * c + i) * RC_FP + col] : RHS2[(c * 16 + i) * 20 + col - 64];
#pragma unroll
            for (int j = 0; j < 15; ++j) { const LAS f32x4* lp4 = (const LAS f32x4*)(LT + (c * 16 + j) * 20); float lp[16];
#pragma unroll
                for (int q = (j + 1) / 4; q < 4; ++q) { const f32x4 v = lp4[q]; lp[4 * q] = v.x; lp[4 * q + 1] = v.y; lp[4 * q + 2] = v.z; lp[4 * q + 3] = v.w; }
#pragma unroll
                for (int i = j + 1; i < 16; ++i) x[i] += lp[i] * x[j]; }
#pragma unroll
            for (int i = 0; i < 16; ++i) { if (col < 64) WP[(16 * c + i) * 72 + col] = f2h(x[i]); else TL[(16 * c + i) * 24 + col - 64] = f2h(x[i]); } }
        LBAR(); STG(5);
        if (bt + 1 < SEQ / 64) RC_LOAD_RAW(t0 + 64);
        if (w < 4) {
#pragma unroll 1
            for (int c = 0; c < 4; ++c) { const int T0 = 16 * c;
                h16x8 sf[2];
#pragma unroll
                for (int s = 0; s < 2; ++s) { const v4u t = {pkh(St[2 * s][0], St[2 * s][1]), pkh(St[2 * s][2], St[2 * s][3]), pkh(St[2 * s + 1][0], St[2 * s + 1][1]), pkh(St[2 * s + 1][2], St[2 * s + 1][3])}; sf[s] = __builtin_bit_cast(h16x8, t); }
                float vv[4];
#pragma unroll
                for (int r = 0; r < 4; ++r) vv[r] = h2f(VH[(T0 + 4 * lg + r) * 72 + 16 * w + l15]);
                const h16x8 vf = __builtin_bit_cast(h16x8, (v4u){pkh(vv[0], vv[1]), pkh(vv[2], vv[3]), 0u, 0u});
                pg8::f32x4 U = {0.f, 0.f, 0.f, 0.f}, Y = U;
#pragma unroll
                for (int s = 0; s < 2; ++s) { const LAS h16* wp = WP + (T0 + l15) * 72 + 32 * s + 4 * lg; const v2u lo = *(const LAS v2u*)wp, hi = *(const LAS v2u*)(wp + 16);
                    U = __builtin_amdgcn_mfma_f32_16x16x32_f16(__builtin_bit_cast(h16x8, (v4u){lo.x, lo.y, hi.x, hi.y}), sf[s], U, 0, 0, 0);
                    const LAS h16* rp = RT + (T0 + l15) * 72 + 32 * s + 4 * lg; const v2u rl = *(const LAS v2u*)rp, rh = *(const LAS v2u*)(rp + 16);
                    Y = __builtin_amdgcn_mfma_f32_16x16x32_f16(__builtin_bit_cast(h16x8, (v4u){rl.x, rl.y, rh.x, rh.y}), sf[s], Y, 0, 0, 0); }
                { const v2u tl = *(const LAS v2u*)(TL + (T0 + l15) * 24 + 4 * lg); U = __builtin_amdgcn_mfma_f32_16x16x32_f16(__builtin_bit_cast(h16x8, (v4u){tl.x, tl.y, 0u, 0u}), vf, U, 0, 0, 0); }
                const h16x8 uf = __builtin_bit_cast(h16x8, (v4u){pkh(U[0], U[1]), pkh(U[2], U[3]), 0u, 0u});
                { const v2u mb = *(const LAS v2u*)(MRB + (T0 + l15) * 24 + 4 * lg), mk = *(const LAS v2u*)(MRK + (T0 + l15) * 24 + 4 * lg);
                    Y = __builtin_amdgcn_mfma_f32_16x16x32_f16(__builtin_bit_cast(h16x8, (v4u){mb.x, mb.y, 0u, 0u}), uf, Y, 0, 0, 0);
                    Y = __builtin_amdgcn_mfma_f32_16x16x32_f16(__builtin_bit_cast(h16x8, (v4u){mk.x, mk.y, 0u, 0u}), vf, Y, 0, 0, 0); }
#pragma unroll
                for (int r = 0; r < 4; ++r) YL[(T0 + 4 * lg + r) * RC_FP + 16 * w + l15] = Y[r];
#pragma unroll
                for (int tau = 0; tau < 4; ++tau) { const f32x4 wc = *(const LAS f32x4*)(WC + c * 64 + 16 * tau + 4 * lg);
                    const v2u bl = *(const LAS v2u*)(BHT + (c * 64 + 16 * tau + l15) * 16 + 4 * lg), kl = *(const LAS v2u*)(KHT + (c * 64 + 16 * tau + l15) * 16 + 4 * lg);
                    pg8::f32x4 sacc = {St[tau][0] * wc.x, St[tau][1] * wc.y, St[tau][2] * wc.z, St[tau][3] * wc.w};
                    sacc = __builtin_amdgcn_mfma_f32_16x16x32_f16(__builtin_bit_cast(h16x8, (v4u){bl.x, bl.y, 0u, 0u}), uf, sacc, 0, 0, 0);
                    St[tau] = __builtin_amdgcn_mfma_f32_16x16x32_f16(__builtin_bit_cast(h16x8, (v4u){kl.x, kl.y, 0u, 0u}), vf, sacc, 0, 0, 0); }
            }
        }
        LBAR(); STG(6);
        { const int t = ft; float y[8]; float s = 0.f;
#pragma unroll
            for (int q = 0; q < 2; ++q) { const f32x4 yv = *(const LAS f32x4*)(YL + t * RC_FP + 8 * fp + 4 * q);
#pragma unroll
                for (int e = 0; e < 4; ++e) { y[4 * q + e] = yv[e]; s += yv[e]; } }
            const float mean = red8(s) * (1.0f / 64.0f); float q = 0.f;
#pragma unroll
            for (int i = 0; i < 8; ++i) { y[i] -= mean; q += y[i] * y[i]; }
            const float rstd = __builtin_amdgcn_rsqf(red8(q) * (1.0f / 64.0f) + 64e-5f), bon = BON[t];
            const f32x4 lw0 = *(const LAS f32x4*)(CST + 192 + 8 * fp), lw1 = *(const LAS f32x4*)(CST + 192 + 8 * fp + 4), lb0 = *(const LAS f32x4*)(CST + 256 + 8 * fp), lb1 = *(const LAS f32x4*)(CST + 256 + 8 * fp + 4);
            const float lw[8] = {lw0.x, lw0.y, lw0.z, lw0.w, lw1.x, lw1.y, lw1.z, lw1.w}, lb[8] = {lb0.x, lb0.y, lb0.z, lb0.w, lb1.x, lb1.y, lb1.z, lb1.w};
            const h16x8 v8 = *(const LAS h16x8*)(VH + t * 72 + 8 * fp); float res[8];
            const f32x4 gq0 = *(const LAS f32x4*)(GATE + t * RC_FP + 8 * fp), gq1 = *(const LAS f32x4*)(GATE + t * RC_FP + 8 * fp + 4); const float gq[8] = {gq0.x, gq0.y, gq0.z, gq0.w, gq1.x, gq1.y, gq1.z, gq1.w};
#pragma unroll
            for (int i = 0; i < 8; ++i) res[i] = (y[i] * rstd * lw[i] + lb[i] + bon * (float)v8[i]) * gq[i];
            *(GAS v4u*)(omix + (row0 + t0 + t) * DM + 1024 + hc0) = (v4u){pkh(res[0], res[1]), pkh(res[2], res[3]), pkh(res[4], res[5]), pkh(res[6], res[7])}; }
        LBAR(); STG(7);
    }
#ifdef DIAG_STG
    if (tid0 == 0 && unit == 0) { unsigned long long* tsq = (unsigned long long*)(a.ws + WS_CTL + 4096); unsigned long long c_ = 0; tsq[32] = 0;
#pragma unroll
        for (int i = 0; i < 10; ++i) { c_ += stg_t[i]; tsq[33 + i] = c_; } }
#endif
#undef STG
#undef RC_LOAD_RAW
}
__device__ __forceinline__ void dn_norm_gate(const Frame& F, const Args& a) {
    const int gw = F.bid * NWAVES + F.wave, NGW = F.G * NWAVES, lane = F.lane;
    const float* oraw = a.out; const h16* P = (const h16*)(a.ws + WS_P); h16* omix = (h16*)(a.ws + WS_OMIX);
    const int cn = (lane & 7) * 16;
    f32x4 nw[4];
#pragma unroll
    for (int j = 0; j < 4; ++j) nw[j] = *(const f32x4*)(a.in[7] + cn + 4 * j);
    for (int m = gw; m < MTOK; m += NGW) {
        const GAS f32x4* op = (const GAS f32x4*)(oraw + (size_t)m * 1024 + lane * 16);
        f32x4 v[4]; float s = 0.f;
#pragma unroll
        for (int j = 0; j < 4; ++j) { v[j] = op[j]; s += (v[j].x * v[j].x + v[j].y * v[j].y) + (v[j].z * v[j].z + v[j].w * v[j].w); }
        s = red8(s);
        const float rstd = __builtin_amdgcn_rsqf(s * (1.0f / 128.0f) + RMS_EPS);
        const GAS v4u* zp = (const GAS v4u*)(P + (size_t)m * PW + 3072 + lane * 16);
        const v4u z0 = zp[0], z1 = zp[1]; const unsigned zz[8] = {z0.x, z0.y, z0.z, z0.w, z1.x, z1.y, z1.z, z1.w};
        unsigned ow[8];
#pragma unroll
        for (int j = 0; j < 4; ++j) {
            const float za = h2f((h16)(zz[2 * j] & 0xffff)), zb = h2f((h16)(zz[2 * j] >> 16)), zc = h2f((h16)(zz[2 * j + 1] & 0xffff)), zd = h2f((h16)(zz[2 * j + 1] >> 16));
            const f32x4 o = v[j] * rstd * nw[j];
            ow[2 * j] = pkh(o.x * za * sigmoidf_(za), o.y * zb * sigmoidf_(zb)); ow[2 * j + 1] = pkh(o.z * zc * sigmoidf_(zc), o.w * zd * sigmoidf_(zd)); }
        GAS v4u* dst = (GAS v4u*)(omix + (size_t)m * DM + lane * 16);
        dst[0] = (v4u){ow[0], ow[1], ow[2], ow[3]}; dst[1] = (v4u){ow[4], ow[5], ow[6], ow[7]};
    }
}

constexpr int XA_KP = 136, XA_VP = 264;
constexpr int XAL_K = 0, XAL_V = XAL_K + 256 * XA_KP * 2, XAL_END = XAL_V + 128 * XA_VP * 2;
__device__ __forceinline__ void xattn_phase(const Frame& F, const Args& a) {
    const int tid = F.tid, lane = F.lane, w = F.wave, l15 = lane & 15, lg = lane >> 4;
    LAS h16* KL = (LAS h16*)(F.lds + XAL_K); LAS h16* VT = (LAS h16*)(F.lds + XAL_V);
    const h16* KV = (const h16*)(a.ws + WS_KV); const h16* Q = (const h16*)a.out; h16* AO = (h16*)(a.ws + WS_AO);
    for (int pair = F.bid; pair < 256; pair += F.G) {
        const int bhd = pair >> 3, b = bhd >> 2, hd = bhd & 3;
        __syncthreads();
#pragma unroll
        for (int i = 0; i < 8; ++i) { const int id = tid + 512 * i, mem = id & 255, dc = id >> 8;
            const v4u kv = *(const GAS v4u*)(KV + (size_t)(b * 256 + mem) * 1024 + hd * 128 + dc * 8);
            *(LAS v4u*)(KL + mem * XA_KP + dc * 8) = kv;
            const v4u vv = *(const GAS v4u*)(KV + (size_t)(b * 256 + mem) * 1024 + 512 + hd * 128 + dc * 8);
            const unsigned vw[4] = {vv.x, vv.y, vv.z, vv.w};
#pragma unroll
            for (int e = 0; e < 4; ++e) { VT[(dc * 8 + 2 * e) * XA_VP + mem] = (h16)(vw[e] & 0xffff); VT[(dc * 8 + 2 * e + 1) * XA_VP + mem] = (h16)(vw[e] >> 16); } }
        __syncthreads();
        for (int qi = 0; qi < 2; ++qi) {
            const int qb = (pair & 7) * 2 + qi; const size_t tok = (size_t)b * SEQ + qb * 128 + 16 * w + l15;
            h16x8 qf[4];
            { const h16* q0 = Q + tok * 512 + hd * 128 + 8 * lg; const h16* q1 = q0 + (size_t)MTOK * 512;
              const float rstd = __builtin_amdgcn_rsqf(((const float*)(a.ws + WS_CTL + CTL_SS1))[tok] * (1.0f / DM) + RMS_EPS);
#pragma unroll
              for (int ks = 0; ks < 4; ++ks) { const h16x8 a0 = *(const GAS h16x8*)(q0 + 32 * ks), b0 = *(const GAS h16x8*)(q1 + 32 * ks); float sv[8];
#pragma unroll
                  for (int e = 0; e < 8; ++e) sv[e] = ((float)a0[e] + (float)b0[e]) * rstd;
                  const v4u t = {pkh(sv[0], sv[1]), pkh(sv[2], sv[3]), pkh(sv[4], sv[5]), pkh(sv[6], sv[7])}; qf[ks] = __builtin_bit_cast(h16x8, t); } }
            pg8::f32x4 s[16];
#pragma unroll
            for (int mt = 0; mt < 16; ++mt) { s[mt] = (pg8::f32x4){0.f, 0.f, 0.f, 0.f};
#pragma unroll
                for (int ks = 0; ks < 4; ++ks) { const h16x8 kf = *(const LAS h16x8*)(KL + (16 * mt + l15) * XA_KP + 32 * ks + 8 * lg); s[mt] = __builtin_amdgcn_mfma_f32_16x16x32_f16(kf, qf[ks], s[mt], 0, 0, 0); }
                if (mt & 1) __builtin_amdgcn_sched_barrier(0); }
            float mx = -3.0e38f;
#pragma unroll
            for (int mt = 0; mt < 16; ++mt) mx = fmaxf(fmaxf(fmaxf(mx, s[mt][0]), fmaxf(s[mt][1], s[mt][2])), s[mt][3]);
            mx = fmaxf(mx, __shfl_xor(mx, 16)); mx = fmaxf(mx, __shfl_xor(mx, 32));
            const float sc = 0.08838834764831845f * 1.4426950408889634f; float sum = 0.f;
#pragma unroll
            for (int mt = 0; mt < 16; ++mt)
#pragma unroll
                for (int r = 0; r < 4; ++r) { const float p = __builtin_amdgcn_exp2f((s[mt][r] - mx) * sc); s[mt][r] = p; sum += p; }
            sum += __shfl_xor(sum, 16); sum += __shfl_xor(sum, 32);
            const float inv = 1.0f / sum;
            h16x8 pf[8];
#pragma unroll
            for (int ss = 0; ss < 8; ++ss) { v4u t; t.x = pkh(s[2 * ss][0] * inv, s[2 * ss][1] * inv); t.y = pkh(s[2 * ss][2] * inv, s[2 * ss][3] * inv); t.z = pkh(s[2 * ss + 1][0] * inv, s[2 * ss + 1][1] * inv); t.w = pkh(s[2 * ss + 1][2] * inv, s[2 * ss + 1][3] * inv);
                pf[ss] = __builtin_bit_cast(h16x8, t); }
#pragma unroll
            for (int dt = 0; dt < 8; ++dt) { pg8::f32x4 o = {0.f, 0.f, 0.f, 0.f};
#pragma unroll
                for (int ss = 0; ss < 8; ++ss) { const LAS h16* vp = VT + (16 * dt + l15) * XA_VP + 32 * ss + 4 * lg;
                    const v2u lo = *(const LAS v2u*)vp, hi = *(const LAS v2u*)(vp + 16); const v4u t = {lo.x, lo.y, hi.x, hi.y};
                    o = __builtin_amdgcn_mfma_f32_16x16x32_f16(__builtin_bit_cast(h16x8, t), pf[ss], o, 0, 0, 0); }
                v2u ow; ow.x = pkh(o[0], o[1]); ow.y = pkh(o[2], o[3]);
                *(GAS v2u*)(AO + tok * 512 + hd * 128 + 16 * dt + 4 * lg) = ow; __builtin_amdgcn_sched_barrier(0); }
        }
    }
}

__device__ __forceinline__ void final_norm(const Frame& F, const Args& a) {
    const int gw = F.bid * NWAVES + F.wave, NGW = F.G * NWAVES, lane = F.lane;
    const float* ss = (const float*)(a.ws + WS_CTL + CTL_SS3); const h16* H3 = (const h16*)(a.ws + WS_H2);
    f32x4 wv[4][2];
#pragma unroll
    for (int j = 0; j < 4; ++j) { wv[j][0] = *(const GAS f32x4*)(a.in[29] + 512 * j + 8 * lane); wv[j][1] = *(const GAS f32x4*)(a.in[29] + 512 * j + 8 * lane + 4); }
    for (int m = gw; m < MTOK; m += NGW) {
        const float rstd = __builtin_amdgcn_rsqf(ss[m] * (1.0f / DM) + RMS_EPS);
        const GAS h16x8* xr = (const GAS h16x8*)(H3 + (size_t)m * DM) + lane; GAS f32x4* orow = (GAS f32x4*)(a.out + (size_t)m * DM) + 2 * lane;
        h16x8 v[4];
#pragma unroll
        for (int j = 0; j < 4; ++j) v[j] = xr[64 * j];
#pragma unroll
        for (int j = 0; j < 4; ++j) { const f32x4 lo = {(float)v[j][0], (float)v[j][1], (float)v[j][2], (float)v[j][3]}, hi = {(float)v[j][4], (float)v[j][5], (float)v[j][6], (float)v[j][7]};
            orow[128 * j] = lo * rstd * wv[j][0]; orow[128 * j + 1] = hi * rstd * wv[j][1]; }
    }
}
constexpr int N_PHASES = 11;
#ifndef MK_ONE_LAUNCH
#define MK_ONE_LAUNCH 1
#endif
__global__ void __launch_bounds__(NTHREADS, 2) fwd_kernel(Args args) {
    extern __shared__ __attribute__((aligned(16))) unsigned char lds[];
    Frame F; F.lds = (LAS unsigned char*)lds; F.tid = threadIdx.x; F.lane = F.tid & 63; F.wave = __builtin_amdgcn_readfirstlane(F.tid >> 6); F.G = gridDim.x; F.bid = blockIdx.x;
    unsigned char* ws = args.ws;
    const int lo = args.ph_lo, hi = args.ph_hi;
    volatile LAS unsigned* misc = (volatile LAS unsigned*)(F.lds + LDS_MISC);
    if (F.tid < 16) misc[F.tid] = 0u;
    __syncthreads();
    XcdBarrier xbar = xcd_barrier_post((unsigned*)(ws + WS_CTL + CTL_BAR), misc);
#define IN(k) (lo <= (k) && (k) < hi)
#ifndef REPEAT_PH
#define REPEAT_PH -1
#endif
#ifndef REPEAT_N
#define REPEAT_N 1
#endif
#define REP(k) for (int rep_ = 0; rep_ < ((k) == REPEAT_PH ? 1 + REPEAT_N : 1); ++rep_, ((k) == REPEAT_PH && rep_ <= REPEAT_N ? (cg::this_grid().sync(), 0) : 0))
#if MK_ONE_LAUNCH
#define SEAM(k) do { if (IN(k) && IN((k) + 1)) { if ((k) == 0) cg::this_grid().sync(); else xcd_barrier(xbar); } } while (0)
#else
#define SEAM(k) do { } while (0)
#endif
#ifdef DIAG_A
    unsigned long long* ts = (unsigned long long*)(ws + WS_CTL + 4096);
#define STAMP(i) do { if (F.bid == 0 && F.tid == 0) { ts[i] = __builtin_amdgcn_s_memrealtime(); ts[64 + (i)] = __builtin_amdgcn_s_memtime(); } } while (0)
#else
#define STAMP(i) do { } while (0)
#endif
    STAMP(0);
    float* ss1 = (float*)(ws + WS_CTL + CTL_SS1); float* ss2 = (float*)(ws + WS_CTL + CTL_SS2); float* ss3 = (float*)(ws + WS_CTL + CTL_SS3);
    if (IN(0)) REP(0) { p0_prologue(F, args); } SEAM(0); STAMP(1);
    if (IN(1)) REP(1) { pg8::Gemm g{(const pg8::h16_t*)args.out, (const pg8::h16_t*)(ws + WS_WALL), DM, DM}; pg8::StaticOrder S; S.init(64, 30, F.G, F.bid, 8, 4);
        pg8::EpiF16<0> E{(pg8::h16_t*)(ws + WS_P), PW, nullptr, 0.f, (pg8::h16_t*)(ws + WS_KV), 1024, 64, 30, 0};
        pg8::gemm_phase(F.lds, g, S, E); } SEAM(1); STAMP(2);
    if (IN(2)) REP(2) {
#ifdef DIAG_A
        const unsigned long long tq0 = __builtin_amdgcn_s_memrealtime();
#endif
        if (F.bid < 64) dn_chunked(F, args, F.bid); else if (F.bid < 192) rw_chunked(F, args, F.bid - 64); else if (LATE_W) p0_weights(F, args, 1, (F.bid - 192) * NWAVES + F.wave, 64 * NWAVES);
#ifdef DIAG_A
        if (F.tid == 0 && F.bid == 0) { ts[16] = tq0; ts[17] = __builtin_amdgcn_s_memrealtime(); }
        if (F.tid == 0 && F.bid == 64) { ts[18] = tq0; ts[19] = __builtin_amdgcn_s_memrealtime(); }
        if (F.tid == 0 && F.bid == 192) { ts[20] = tq0; ts[21] = __builtin_amdgcn_s_memrealtime(); }
#endif
        } SEAM(2); STAMP(3); STAMP(4);
    if (IN(4)) REP(4) { pg8::Gemm g{(const pg8::h16_t*)(ws + WS_OMIX), (const pg8::h16_t*)(ws + WS_WOUT), DM, DM}; pg8::StaticOrder S; S.init(64, 8, F.G, F.bid);
        pg8::EpiRes E{args.in[0], nullptr, nullptr, (pg8::h16_t*)(ws + WS_H1), ss1, DM};
        pg8::gemm_phase(F.lds, g, S, E); } SEAM(4); STAMP(5);
    if (IN(5)) REP(5) { pg8::Gemm g{(const pg8::h16_t*)(ws + WS_H1), (const pg8::h16_t*)(ws + WS_WQ), DM / 2, DM}; pg8::StaticOrder S; S.init(64, 2, F.G, F.bid, 0, 0, 2);
        pg8::EpiF16<0> E{(pg8::h16_t*)args.out, 512, nullptr, 0.f, nullptr, 0, 0, 0, (size_t)MTOK * 512};
        pg8::gemm_phase(F.lds, g, S, E); } SEAM(5); STAMP(6);
    if (IN(6)) REP(6) { xattn_phase(F, args); } SEAM(6); STAMP(7);
    if (IN(7)) REP(7) { pg8::Gemm g{(const pg8::h16_t*)(ws + WS_AO), (const pg8::h16_t*)(ws + WS_WO), 512, 512}; pg8::StaticOrder S; S.init(64, 8, F.G, F.bid);
        pg8::EpiRes E{nullptr, (const pg8::h16_t*)(ws + WS_H1), nullptr, (pg8::h16_t*)(ws + WS_H2), ss2, DM};
        pg8::gemm_phase(F.lds, g, S, E); } SEAM(7); STAMP(8);
    if (IN(8)) REP(8) { pg8::Gemm g{(const pg8::h16_t*)(ws + WS_H2), (const pg8::h16_t*)(ws + WS_W1), DM, DM}; pg8::StaticOrder S; S.init(64, 32, F.G, F.bid);
        pg8::EpiF16<1> E{(pg8::h16_t*)(ws + WS_HID), FF, ss2, RMS_EPS, nullptr, 0, 0, 0, 0};
        pg8::gemm_phase(F.lds, g, S, E); } SEAM(8); STAMP(9);
    if (IN(9)) REP(9) { pg8::Gemm g{(const pg8::h16_t*)(ws + WS_HID), (const pg8::h16_t*)(ws + WS_W2), FF, FF}; pg8::StaticOrder S; S.init(64, 8, F.G, F.bid);
        pg8::EpiRes E{nullptr, (const pg8::h16_t*)(ws + WS_H2), nullptr, (pg8::h16_t*)(ws + WS_H2), ss3, DM};
        pg8::gemm_phase(F.lds, g, S, E); } SEAM(9); STAMP(10);
    if (IN(10)) REP(10) { final_norm(F, args); }
#ifdef DIAG_A
    STAMP(11);
    if (F.bid == 0 && F.tid == 0) {
#ifdef DIAG_CLK
        const unsigned long long d = (ts[64 + DIAG_A + 1] - ts[64 + DIAG_A]) / 100ull, t1 = __builtin_amdgcn_s_memrealtime() + d;
#else
        const unsigned long long d = 4ull * (ts[DIAG_A + 1] - ts[DIAG_A]), t1 = __builtin_amdgcn_s_memrealtime() + d;
#endif
        while (__builtin_amdgcn_s_memrealtime() < t1) __builtin_amdgcn_s_sleep(32); }
#endif
#undef IN
#undef SEAM
}

extern "C" void kernel_launch(void* const* d_in, const int* in_sizes, int n_in, void* d_out, int out_size, void* d_ws, size_t ws_size, hipStream_t stream) {
    static int grid = 0;
    if (grid == 0) {
        if (n_in != 30 || out_size != MTOK * DM || ws_size < WS_END) { fprintf(stderr, "kernel_launch: unexpected problem (n_in %d, out %d, ws %zu < %zu)\n", n_in, out_size, ws_size, (size_t)WS_END); grid = -1; return; }
        int dev = 0, cus = 0, per_cu = 0;
        hipGetDevice(&dev); hipDeviceGetAttribute(&cus, hipDeviceAttributeMultiprocessorCount, dev);
        if (hipFuncSetAttribute((const void*)fwd_kernel, hipFuncAttributeMaxDynamicSharedMemorySize, LDS_BYTES) != hipSuccess) { fprintf(stderr, "kernel_launch: hipFuncSetAttribute failed\n"); grid = -1; return; }
        if (hipOccupancyMaxActiveBlocksPerMultiprocessor(&per_cu, (const void*)fwd_kernel, NTHREADS, LDS_BYTES) != hipSuccess || per_cu < 1) { fprintf(stderr, "kernel_launch: occupancy query says %d\n", per_cu); per_cu = 1; }
        (void)hipGetLastError();
        if (cus < 256 || per_cu < 1) { fprintf(stderr, "kernel_launch: needs 256 CUs with one resident workgroup each (cus %d, per_cu %d); nothing launched\n", cus, per_cu); grid = -1; return; }
        grid = 256;
    }
    if (grid < 0) return;
    hipMemsetAsync((char*)d_ws + WS_CTL, 0, CTL_ZERO_BYTES, stream);
    Args a{};
    for (int i = 0; i < 30; ++i) a.in[i] = (const float*)d_in[i];
    a.out = (float*)d_out; a.ws = (unsigned char*)d_ws;
#if MK_ONE_LAUNCH
    a.ph_lo = 0; a.ph_hi = N_PHASES;
    void* kargs[] = {&a};
    hipError_t e = hipLaunchCooperativeKernel((const void*)fwd_kernel, dim3(grid), dim3(NTHREADS), kargs, LDS_BYTES, stream);
    if (e != hipSuccess) fprintf(stderr, "cooperative launch failed: %s (grid %d)\n", hipGetErrorString(e), grid);
#else
    for (int ph = 0; ph < N_PHASES; ++ph) { a.ph_lo = ph; a.ph_hi = ph + 1; hipLaunchKernelGGL(fwd_kernel, dim3(grid), dim3(NTHREADS), LDS_BYTES, stream, a); }
#endif
}
```

```cpp
#include <hip/hip_runtime.h>
#include <hip/hip_cooperative_groups.h>
#include <cstdio>
#include <cstdint>
namespace cg = cooperative_groups;
namespace pg8 {
#define PG8_LAS __attribute__((address_space(3)))
typedef unsigned short h16_t;
typedef _Float16 h16x8 __attribute__((ext_vector_type(8)));
typedef _Float16 h16x2 __attribute__((ext_vector_type(2)));
typedef _Float16 h16x4 __attribute__((ext_vector_type(4)));
typedef float f32x4 __attribute__((ext_vector_type(4)));
typedef float f32x2 __attribute__((ext_vector_type(2)));
typedef unsigned u32x4 __attribute__((ext_vector_type(4)));
typedef unsigned u32x2 __attribute__((ext_vector_type(2)));
constexpr int BM = 256, BK = 64, HALF = 128, HTB = HALF * BK * 2  , STAGE_BYTES = 8 * HTB, NXCD = 8, WGM = 8;

__host__ __device__ __forceinline__ int lds_byte(int r, int c) { const int st = (r >> 4) * 2 + (c >> 5), rr = r & 15, cc = c & 31, ob = rr * 64 + cc * 2; return st * 1024 + (ob ^ (((ob >> 9) & 1) << 5)); }
__host__ __device__ __forceinline__ void stage_rc(int b, int& R, int& C) { const int st = b / 1024, sb = b % 1024, swz = sb ^ (((sb >> 9) & 1) << 5); R = (st >> 1) * 16 + swz / 64; C = (st & 1) * 32 + (swz % 64) / 2; }
__host__ __device__ __forceinline__ int perm32(int rho) { const int n = rho >> 4, i = rho & 15; return 8 * (i >> 2) + 4 * n + (i & 3); }

struct Unit { int pm, pn, ks; };
struct Gemm { const h16_t* A; const h16_t* Bt; int K, ld; };

struct StaticOrder {
    int nM, nN, nwg, G, c, eM, eN, nK;
    __device__ void init(int nM_, int nN_, int G_, int c_, int eM_ = 0, int eN_ = 0, int nK_ = 1) { nM = nM_; nN = nN_; nwg = nM * nN; G = G_; c = c_; eM = eM_; eN = eN_; nK = nK_; }
    __device__ bool next(int i, Unit& u) const {
        long L = (long)i * G + c; u.ks = 0;
        if (nK > 1) { if (L >= (long)nwg * nK) return false; u.ks = (int)(L / nwg); L -= (long)u.ks * nwg; }
        else if (L >= nwg) { const int e = (int)(L - nwg); if (e >= eM * eN) return false; u.pm = nM + e / eN; u.pn = nN + e % eN; return true; }
        int wgid = (int)L; { const int q = nwg / NXCD, r = nwg % NXCD, xcd = wgid % NXCD, off = wgid / NXCD; wgid = (xcd < r ? xcd * (q + 1) : r * (q + 1) + (xcd - r) * q) + off; }
        const int nig = WGM * nN, gid = wgid / nig, fm = gid * WGM, gsz = (nM - fm) < WGM ? (nM - fm) : WGM;
        u.pm = fm + ((wgid % nig) % gsz); u.pn = (wgid % nig) / gsz; return true;
    }
};

__device__ __forceinline__ unsigned pkh(float lo, float hi) { f32x2 v = {lo, hi}; h16x2 h = __builtin_convertvector(v, h16x2); return __builtin_bit_cast(unsigned, h); }


template <int ACT> struct EpiF16 {
    static constexpr bool PERM = true;
    h16_t* O; int ldc; const float* rs; float eps; h16_t* O2; int ldc2; int splitM, splitN; size_t part_stride;
    __device__ __forceinline__ void prefetch(const Unit& u, int wr, int fr, float (&pf)[8]) const {
        if (rs) {
#pragma unroll
            for (int g_ = 0; g_ < 8; ++g_) pf[g_] = rs[u.pm * BM + (g_ >> 2) * HALF + wr * 64 + (g_ & 3) * 16 + fr]; }
    }
    __device__ __forceinline__ void operator()(const f32x4 (&acc)[2][2][4][2], const Unit& u, int wr, int wc, int fr, int fq, const float (&pf)[8]) const {
        int pm = u.pm, pn = u.pn; h16_t* base = O + (size_t)u.ks * part_stride; int ld = ldc;
        if (O2 && pm >= splitM) { pm -= splitM; pn -= splitN; base = O2; ld = ldc2; }
        const int row0 = pm * BM + wr * 64 + fr; const int col0 = pn * BM + wc * 32 + 8 * fq;
#pragma unroll
        for (int ai = 0; ai < 2; ++ai)
#pragma unroll
            for (int m = 0; m < 4; ++m) { const int row = row0 + ai * HALF + m * 16; h16_t* rowp = base + (size_t)row * ld + col0;
                float sc = 1.f; if (rs) sc = __builtin_amdgcn_rsqf(pf[ai * 4 + m] * (1.0f / 2048.0f) + eps);
#pragma unroll
                for (int bj = 0; bj < 2; ++bj) { f32x4 v0 = acc[ai][bj][m][0] * sc, v1 = acc[ai][bj][m][1] * sc;
                    if (ACT == 1) { v0 = __builtin_elementwise_max(v0, (f32x4){0.f, 0.f, 0.f, 0.f}); v1 = __builtin_elementwise_max(v1, (f32x4){0.f, 0.f, 0.f, 0.f}); v0 = v0 * v0; v1 = v1 * v1; }
                    u32x4 w; w.x = pkh(v0[0], v0[1]); w.y = pkh(v0[2], v0[3]); w.z = pkh(v1[0], v1[1]); w.w = pkh(v1[2], v1[3]);
                    *(u32x4*)(rowp + bj * HALF) = w; } }
    }
};
struct EpiF32Part {
    static constexpr bool PERM = false;
    float* O; int ldc; size_t part_stride;
    __device__ __forceinline__ void prefetch(const Unit&, int, int, float (&)[8]) const {}
    __device__ __forceinline__ void operator()(const f32x4 (&acc)[2][2][4][2], const Unit& u, int wr, int wc, int fr, int fq, const float (&)[8]) const {
        const int col0 = u.pn * BM + wc * 32 + 4 * fq; float* base = O + (size_t)u.ks * part_stride;
#pragma unroll
        for (int ai = 0; ai < 2; ++ai)
#pragma unroll
            for (int m = 0; m < 4; ++m) { float* rowp = base + (size_t)(u.pm * BM + ai * HALF + wr * 64 + m * 16 + fr) * ldc + col0;
#pragma unroll
                for (int bj = 0; bj < 2; ++bj)
#pragma unroll
                    for (int n = 0; n < 2; ++n) *(f32x4*)(rowp + bj * HALF + n * 16) = acc[ai][bj][m][n]; }
    }
};
struct EpiRes {
    static constexpr bool PERM = true;
    const float* base32; const h16_t* base16; float* out32; h16_t* o16; float* ss; int ldc;
    __device__ __forceinline__ void prefetch(const Unit&, int, int, float (&)[8]) const {}
    __device__ __forceinline__ void operator()(const f32x4 (&acc)[2][2][4][2], const Unit& u, int wr, int wc, int fr, int fq, const float (&)[8]) const {
        const int col0 = u.pn * BM + wc * 32 + 8 * fq;
        const size_t off0 = (size_t)(u.pm * BM + wr * 64 + fr) * ldc + col0;
        f32x4 pre[3][4];
#define ER_LOAD(slot, g_) do { const size_t o_ = off0 + (size_t)(((g_) >> 2) * HALF + ((g_) & 3) * 16) * ldc; _Pragma("unroll") for (int bj_ = 0; bj_ < 2; ++bj_) { const size_t e_ = o_ + bj_ * HALF; \
            if (base16) { const h16x8 h_ = *(const h16x8*)(base16 + e_); pre[slot][2 * bj_] = (f32x4){(float)h_[0], (float)h_[1], (float)h_[2], (float)h_[3]}; pre[slot][2 * bj_ + 1] = (f32x4){(float)h_[4], (float)h_[5], (float)h_[6], (float)h_[7]}; } \
            else { pre[slot][2 * bj_] = *(const f32x4*)(base32 + e_); pre[slot][2 * bj_ + 1] = *(const f32x4*)(base32 + e_ + 4); } } } while (0)
        ER_LOAD(0, 0); ER_LOAD(1, 1);
#pragma unroll
        for (int g_ = 0; g_ < 8; ++g_) { const int ai = g_ >> 2, m = g_ & 3; const int row = u.pm * BM + ai * HALF + wr * 64 + m * 16 + fr; const size_t off = (size_t)row * ldc + col0; float q = 0.f;
            if (g_ + 2 < 8) ER_LOAD((g_ + 2) % 3, g_ + 2);
#pragma unroll
            for (int bj = 0; bj < 2; ++bj) { const f32x4 o0 = pre[g_ % 3][2 * bj] + acc[ai][bj][m][0], o1 = pre[g_ % 3][2 * bj + 1] + acc[ai][bj][m][1];
                if (out32) { *(f32x4*)(out32 + off + bj * HALF) = o0; *(f32x4*)(out32 + off + bj * HALF + 4) = o1; }
                q += (o0[0] * o0[0] + o0[1] * o0[1]) + (o0[2] * o0[2] + o0[3] * o0[3]) + (o1[0] * o1[0] + o1[1] * o1[1]) + (o1[2] * o1[2] + o1[3] * o1[3]);
                if (o16) { u32x4 w; w.x = pkh(o0[0], o0[1]); w.y = pkh(o0[2], o0[3]); w.z = pkh(o1[0], o1[1]); w.w = pkh(o1[2], o1[3]); *(u32x4*)(o16 + off + bj * HALF) = w; } }
            q += __shfl_xor(q, 16); q += __shfl_xor(q, 32);
            if (fq == 0) atomicAdd(ss + row, q); }
#undef ER_LOAD
    }
};

template <class Epi, class Sched>
__device__ __forceinline__ void gemm_phase(PG8_LAS unsigned char* lds, const Gemm g, const Sched& S, const Epi& E) {
    const int tid = threadIdx.x, wid = __builtin_amdgcn_readfirstlane(tid >> 6), lane = tid & 63, wr = wid >> 2, wc = wid & 3, fr = lane & 15, fq = lane >> 4;
    const int K = g.K, nt = K / BK, ld = g.ld;
    unsigned voffA[2], voffB[2];
#pragma unroll
    for (int i = 0; i < 2; ++i) { int R, C; stage_rc(tid * 16 + i * 8192, R, C); const int Rb = Epi::PERM ? ((R & ~31) + perm32(R & 31)) : R;
        voffA[i] = (unsigned)(R * ld + C) * 2u; voffB[i] = (unsigned)(Rb * ld + C) * 2u; }
    const size_t kstep = (size_t)(BK * 2);
    const size_t hstep = (size_t)HALF * ld * 2;
    const size_t tstep = 2 * hstep;
    const unsigned ldsw = (unsigned)wid * 1024u;
    const int aoff = lds_byte(wr * 64 + fr, fq * 8), boff = lds_byte(wc * 32 + fr, fq * 8);
#define PG8_SA(b, h) (((b) * 2 + (h)) * HTB)
#define PG8_SB(b, h) ((4 + (b) * 2 + (h)) * HTB)
#define PG8_STAGE(bufoff, gbase, voff) do { _Pragma("unroll") for (int _i = 0; _i < 2; ++_i) \
        __builtin_amdgcn_global_load_lds((const unsigned*)((const char*)(gbase) + (voff)[_i]), (PG8_LAS unsigned*)(lds + (bufoff) + ldsw + _i * 8192), 16, 0, 0); } while (0)
#define PG8_LDA(dst, b, h) do { _Pragma("unroll") for (int m = 0; m < 4; ++m) _Pragma("unroll") for (int k = 0; k < 2; ++k) dst[m][k] = *(const PG8_LAS h16x8*)(lds + PG8_SA(b, h) + aoff + m * 2048 + k * 1024); } while (0)
#define PG8_LDB(dst, b, h) do { _Pragma("unroll") for (int n = 0; n < 2; ++n) _Pragma("unroll") for (int k = 0; k < 2; ++k) dst[n][k] = *(const PG8_LAS h16x8*)(lds + PG8_SB(b, h) + boff + n * 2048 + k * 1024); } while (0)
#define PG8_MMA(ai, bj, At, Bt) do { __builtin_amdgcn_s_setprio(1); _Pragma("unroll") for (int m = 0; m < 4; ++m) _Pragma("unroll") for (int n = 0; n < 2; ++n) _Pragma("unroll") for (int k = 0; k < 2; ++k) \
        acc[ai][bj][m][n] = __builtin_amdgcn_mfma_f32_16x16x32_f16(Bt[n][k], At[m][k], acc[ai][bj][m][n], 0, 0, 0); __builtin_amdgcn_s_setprio(0); } while (0)
#define PG8_WAIT_V(n) asm volatile("s_waitcnt vmcnt(" #n ")" ::: "memory")
#define PG8_WAIT_L(n) asm volatile("s_waitcnt lgkmcnt(" #n ")" ::: "memory")
#define PG8_BAR __builtin_amdgcn_s_barrier()
#define PG8_SCHED __builtin_amdgcn_sched_barrier(0)
    Unit cur, nxt; int ui = 0;
    if (!S.next(0, cur)) return;
    f32x4 acc[2][2][4][2];
#pragma unroll
    for (int a = 0; a < 2; ++a)
#pragma unroll
        for (int b = 0; b < 2; ++b)
#pragma unroll
            for (int m = 0; m < 4; ++m)
#pragma unroll
                for (int n = 0; n < 2; ++n) acc[a][b][m][n] = (f32x4){0.f, 0.f, 0.f, 0.f};
    h16x8 At[4][2], B0[2][2], B1[2][2];
    float pf[8] = {0.f, 0.f, 0.f, 0.f, 0.f, 0.f, 0.f, 0.f};
    E.prefetch(cur, wr, fr, pf);
    const size_t kslice = (size_t)K * 2;
    const char* cA = (const char*)g.A + (size_t)cur.pm * tstep + cur.ks * kslice; const char* cB = (const char*)g.Bt + (size_t)cur.pn * tstep + cur.ks * kslice;
    PG8_STAGE(PG8_SB(0, 0), cB, voffB); PG8_STAGE(PG8_SB(0, 1), cB + hstep, voffB); PG8_STAGE(PG8_SA(0, 0), cA, voffA); PG8_STAGE(PG8_SA(0, 1), cA + hstep, voffA);
    if (wr == 1) PG8_BAR;
    PG8_WAIT_V(2); PG8_BAR;
    PG8_STAGE(PG8_SB(1, 0), cB + kstep, voffB); PG8_STAGE(PG8_SA(1, 0), cA + kstep, voffA); PG8_STAGE(PG8_SB(1, 1), cB + hstep + kstep, voffB);
    PG8_WAIT_V(6); PG8_BAR;
    for (;;) {
        const bool has_next = S.next(ui + 1, nxt);
        const char* nA = has_next ? (const char*)g.A + (size_t)nxt.pm * tstep + nxt.ks * kslice : cA; const char* nB = has_next ? (const char*)g.Bt + (size_t)nxt.pn * tstep + nxt.ks * kslice : cB;
        for (int t = 0; t < nt; t += 2) {
            const bool last = (t == nt - 2);
            const char* a1 = cA + (size_t)(t + 1) * kstep;
            const char* a2 = last ? nA : cA + (size_t)(t + 2) * kstep; const char* b2 = last ? nB : cB + (size_t)(t + 2) * kstep;
            const char* a3 = a2 + kstep; const char* b3 = b2 + kstep;
            PG8_LDB(B0, 0, 0); PG8_LDB(B1, 0, 1); PG8_SCHED; PG8_LDA(At, 0, 0); PG8_STAGE(PG8_SA(1, 1), a1 + hstep, voffA);
            PG8_WAIT_V(8); PG8_WAIT_L(0); PG8_BAR; PG8_MMA(0, 0, At, B0); PG8_MMA(0, 1, At, B1); PG8_BAR; PG8_SCHED;
            PG8_LDA(At, 0, 1); PG8_STAGE(PG8_SB(0, 0), b2, voffB); PG8_STAGE(PG8_SB(0, 1), b2 + hstep, voffB); PG8_STAGE(PG8_SA(0, 0), a2, voffA);
            PG8_WAIT_V(8); PG8_WAIT_L(0); PG8_BAR; PG8_MMA(1, 0, At, B0); PG8_MMA(1, 1, At, B1); PG8_BAR; PG8_SCHED;
            PG8_LDB(B0, 1, 0); PG8_LDB(B1, 1, 1); PG8_SCHED; PG8_LDA(At, 1, 0); PG8_STAGE(PG8_SA(0, 1), a2 + hstep, voffA);
            PG8_WAIT_V(8); PG8_WAIT_L(0); PG8_BAR; PG8_MMA(0, 0, At, B0); PG8_MMA(0, 1, At, B1); PG8_BAR; PG8_SCHED;
            PG8_LDA(At, 1, 1); PG8_STAGE(PG8_SB(1, 0), b3, voffB); PG8_STAGE(PG8_SB(1, 1), b3 + hstep, voffB); PG8_STAGE(PG8_SA(1, 0), a3, voffA);
            PG8_WAIT_V(8); PG8_WAIT_L(0); PG8_BAR; PG8_MMA(1, 0, At, B0); PG8_MMA(1, 1, At, B1); PG8_BAR; PG8_SCHED;
        }
        if (wr == 0) PG8_BAR;
        E(acc, cur, wr, wc, fr, fq, pf);
        if (!has_next) break;
#pragma unroll
        for (int a = 0; a < 2; ++a)
#pragma unroll
            for (int b = 0; b < 2; ++b)
#pragma unroll
                for (int m = 0; m < 4; ++m)
#pragma unroll
                    for (int n = 0; n < 2; ++n) acc[a][b][m][n] = (f32x4){0.f, 0.f, 0.f, 0.f};
        cur = nxt; cA = nA; cB = nB; ++ui; E.prefetch(cur, wr, fr, pf);
        if (wr == 1) PG8_BAR;
    }
    PG8_WAIT_V(0);
    PG8_BAR;
#undef PG8_SA
#undef PG8_SB
#undef PG8_STAGE
#undef PG8_LDA
#undef PG8_LDB
#undef PG8_MMA
#undef PG8_WAIT_V
#undef PG8_WAIT_L
#undef PG8_BAR
#undef PG8_SCHED
}
}
constexpr int NWAVES = 8, NTHREADS = 512;
constexpr int DM = 2048, BATCH = 8, SEQ = 2048, MTOK = BATCH * SEQ, MEMLEN = 256, MMEM = BATCH * MEMLEN;
constexpr int INC = 7440, PW = 7680;
constexpr int RW0 = 4128;
constexpr int FF = 8192;
constexpr float RMS_EPS = 1e-6f;
constexpr size_t MiB = 1u << 20;
constexpr size_t WS_CTL = 0, CTL_ZERO_BYTES = 1 * MiB;
constexpr size_t CTL_SS1 = 65536, CTL_SS2 = 131072, CTL_SS3 = 196608, CTL_BAR = 262144;
constexpr size_t WS_WALL = 2 * MiB;
constexpr size_t WS_WOUT = 36 * MiB, WS_WQ = 44 * MiB, WS_WO = 46 * MiB, WS_W1 = 48 * MiB, WS_W2 = 80 * MiB;
constexpr size_t WS_LORA = 112 * MiB;
constexpr size_t WS_KV = 113 * MiB;
constexpr size_t WS_Q = 117 * MiB, WS_AO = 133 * MiB;
constexpr size_t WS_C = 150 * MiB;
constexpr size_t WS_P = WS_C;
constexpr size_t WS_OMIX = WS_C + 240 * MiB;
constexpr size_t WS_HID = WS_C;
constexpr size_t WS_H1 = WS_C;
constexpr size_t WS_H2 = WS_C + 256 * MiB;
constexpr size_t WS_END = WS_C + 320 * MiB;

constexpr int LDS_BYTES = 163840, LDS_MISC = LDS_BYTES - 64;

#define GAS __attribute__((address_space(1)))
#define LAS __attribute__((address_space(3)))
typedef unsigned short h16;
typedef float f32x4 __attribute__((ext_vector_type(4)));
typedef float f32x2 __attribute__((ext_vector_type(2)));
typedef unsigned v4u __attribute__((ext_vector_type(4)));
typedef unsigned v2u __attribute__((ext_vector_type(2)));
typedef _Float16 h16x8 __attribute__((ext_vector_type(8)));
typedef _Float16 h16x4 __attribute__((ext_vector_type(4)));
using pg8::pkh;
__device__ __forceinline__ float h2f(h16 v) { return (float)__builtin_bit_cast(_Float16, v); }
__device__ __forceinline__ h16 f2h(float v) { return __builtin_bit_cast(h16, (_Float16)v); }
__device__ __forceinline__ float fexp(float x) { return __builtin_amdgcn_exp2f(x * 1.4426950408889634f); }
__device__ __forceinline__ float sigmoidf_(float x) { return __builtin_amdgcn_rcpf(1.0f + fexp(-x)); }
__device__ __forceinline__ float ftanh(float x) { return 2.0f * sigmoidf_(2.0f * x) - 1.0f; }
__device__ __forceinline__ float softplusf_(float x) { return fmaxf(x, 0.f) + __builtin_amdgcn_logf(1.0f + fexp(-fabsf(x))) * 0.6931471805599453f; }
template <int CTRL> __device__ __forceinline__ float dpp_(float v) { return __builtin_bit_cast(float, __builtin_amdgcn_update_dpp(0, __builtin_bit_cast(int, v), CTRL, 0xf, 0xf, true)); }
__device__ __forceinline__ float red8(float x) { x += dpp_<0xB1>(x); x += dpp_<0x4E>(x); x += dpp_<0x141>(x); return x; }
__device__ __forceinline__ float red16(float x) { x += __shfl_xor(x, 1); x += __shfl_xor(x, 2); x += __shfl_xor(x, 4); x += __shfl_xor(x, 8); return x; }
__device__ __forceinline__ float wave_sum(float v) {
#pragma unroll
    for (int o = 1; o < 64; o <<= 1) v += __shfl_xor(v, o);
    return v;
}

#define XB_TMO      128
#define XB_XCNT(j)  (256  + 64 * (j))
#define XB_XSUB(j)  (1280 + 64 * (j))
#define XB_XGEN(j)  (2304 + 64 * (j))
#define XB_TOP      3328
#define XB_TOPGEN   3392
#define XCD_BAR_WORDS 3456
#define XB_SPIN_CAP (1u << 18)

__device__ __forceinline__ unsigned xb_ld(unsigned* p)              { return __hip_atomic_load(p, __ATOMIC_RELAXED, __HIP_MEMORY_SCOPE_AGENT); }
__device__ __forceinline__ unsigned xb_add(unsigned* p, unsigned v) { return __hip_atomic_fetch_add(p, v, __ATOMIC_RELAXED, __HIP_MEMORY_SCOPE_AGENT); }
__device__ __forceinline__ unsigned xb_xcc_id() { return (unsigned)__builtin_amdgcn_s_getreg((3 << 11) | 20) & 0xFu; }
#define XB_SPIN(cond, bar) do { unsigned _sp = 0; while (cond) { __builtin_amdgcn_s_sleep(1); \
    if ((++_sp & 255u) == 0u) { if (xb_ld(&(bar)[XB_TMO])) break; if (_sp > XB_SPIN_CAP) { atomicAdd(&(bar)[XB_TMO], 1u); break; } } } } while (0)

struct XcdBarrier {
    unsigned* bar; unsigned x;
    volatile LAS unsigned* st;
};

__device__ __forceinline__ XcdBarrier xcd_barrier_post(unsigned* bar, volatile LAS unsigned* st) {
    XcdBarrier b; b.bar = bar; b.x = xb_xcc_id(); b.st = st;
    if (threadIdx.x == 0) (void)xb_add(&bar[XB_XCNT(b.x)], 1u);
    return b;
}
__device__ __forceinline__ void xcd_barrier_complete(unsigned* bar, unsigned x, unsigned& nloc, unsigned& nx) {
    const unsigned G = gridDim.x * gridDim.y * gridDim.z;
    unsigned sum, cnt, mine, sp = 0u;
    for (;;) {
        sum = 0u; cnt = 0u; mine = 0u;
#pragma unroll
        for (unsigned j = 0; j < 16; ++j) { const unsigned c = xb_ld(&bar[XB_XCNT(j)]); sum += c; cnt += (c > 0u) ? 1u : 0u; mine = (j == x) ? c : mine; }
        if (sum == G) break;
        __builtin_amdgcn_s_sleep(1);
        if ((++sp & 255u) == 0u) { if (xb_ld(&bar[XB_TMO])) break; if (sp > XB_SPIN_CAP) { atomicAdd(&bar[XB_TMO], 1u); break; } }
    }
    nloc = mine > 0u ? mine : 1u; nx = cnt > 0u ? cnt : 1u;
}

__device__ __forceinline__ void xcd_barrier(const XcdBarrier& b) {
    asm volatile("s_waitcnt vmcnt(0)" ::: "memory");
    __syncthreads();
    if (threadIdx.x == 0) {
        unsigned* bar = b.bar;
        __builtin_amdgcn_s_waitcnt(0);
        unsigned nloc = b.st[0], nx = b.st[1];
        if (nloc == 0u) { xcd_barrier_complete(bar, b.x, nloc, nx); b.st[0] = nloc; b.st[1] = nx; }
        const unsigned old = xb_add(&bar[XB_XSUB(b.x)], 1u);
        const unsigned gen = old / nloc;
        if (old + 1u == (gen + 1u) * nloc) {
            __builtin_amdgcn_fence(__ATOMIC_RELEASE, "agent");
            asm volatile("s_waitcnt vmcnt(0)" ::: "memory");
            const unsigned og = xb_add(&bar[XB_TOP], 1u);
            const unsigned tg = og / nx;
            if (og + 1u == (tg + 1u) * nx) xb_add(&bar[XB_TOPGEN], 1u);
            else XB_SPIN(xb_ld(&bar[XB_TOPGEN]) == tg, bar);
            __builtin_amdgcn_fence(__ATOMIC_ACQUIRE, "agent");
            xb_add(&bar[XB_XGEN(b.x)], 1u);
            asm volatile("s_waitcnt vmcnt(0)" ::: "memory");
        } else {
            XB_SPIN(xb_ld(&bar[XB_XGEN(b.x)]) == gen, bar);
            __builtin_amdgcn_fence(__ATOMIC_ACQUIRE, "agent");
            asm volatile("s_waitcnt vmcnt(0)" ::: "memory");
        }
    }
    __syncthreads();
}

#ifndef LATE_W
#define LATE_W 1
#endif
#define LBAR() do { asm volatile("s_waitcnt lgkmcnt(0)" ::: "memory"); __builtin_amdgcn_s_barrier(); asm volatile("" ::: "memory"); } while (0)
struct Args {
    const float* in[30]; float* out; unsigned char* ws; int ph_lo, ph_hi;
};
struct Frame {
    LAS unsigned char* lds; int tid, lane, wave, G, bid;
};

struct TrItem { const float* W; const float* ksc; h16* WT; int N, K, k0, ns, nv, nd; };
__device__ __forceinline__ void tr_load(const TrItem& P, f32x4 (&v)[8], int lane) {
    const int j4 = lane & 7, kq = lane >> 3;
#pragma unroll
    for (int i = 0; i < 8; ++i) { v[i] = (f32x4){0.f, 0.f, 0.f, 0.f}; if (4 * j4 < P.nv) v[i] = *(const GAS f32x4*)(P.W + (size_t)(P.k0 + kq + 8 * i) * P.N + P.ns + 4 * j4); }
}
__device__ __forceinline__ void tr_finish(const TrItem& P, f32x4 (&v)[8], LAS float* scr, int lane) {
    const int j4 = lane & 7, kq = lane >> 3;
    if (P.ksc) {
#pragma unroll
        for (int i = 0; i < 8; ++i) v[i] = v[i] * P.ksc[P.k0 + kq + 8 * i]; }
#pragma unroll
    for (int i = 0; i < 8; ++i) { LAS float* d = scr + (kq + 8 * i) * 33 + 4 * j4; d[0] = v[i].x; d[1] = v[i].y; d[2] = v[i].z; d[3] = v[i].w; }
    asm volatile("s_waitcnt lgkmcnt(0)" ::: "memory");
    const int c = lane & 7;
#pragma unroll
    for (int jj = 0; jj < 4; ++jj) { const int n = (lane >> 3) + 8 * jj; const LAS float* s = scr + (8 * c) * 33 + n;
        v4u o; o.x = pkh(s[0 * 33], s[1 * 33]); o.y = pkh(s[2 * 33], s[3 * 33]); o.z = pkh(s[4 * 33], s[5 * 33]); o.w = pkh(s[6 * 33], s[7 * 33]);
        *(GAS v4u*)(P.WT + (size_t)(P.nd + n) * P.K + P.k0 + 8 * c) = o; }
    asm volatile("s_waitcnt lgkmcnt(0)" ::: "memory");
}
__device__ __forceinline__ void rms_row_to_f16(const float* xrow, const float* w, h16* orow, int lane) {
    const GAS f32x4* xr = (const GAS f32x4*)xrow + lane; const GAS f32x4* wr = (const GAS f32x4*)w + lane;
    f32x4 v[8]; float s = 0.f;
#pragma unroll
    for (int j = 0; j < 8; ++j) { v[j] = xr[64 * j]; s += (v[j].x * v[j].x + v[j].y * v[j].y) + (v[j].z * v[j].z + v[j].w * v[j].w); }
    const float rstd = __builtin_amdgcn_rsqf(wave_sum(s) * (1.f / DM) + RMS_EPS);
    GAS v2u* o8 = (GAS v2u*)orow + lane;
#pragma unroll
    for (int j = 0; j < 8; ++j) { const f32x4 ww = wr[64 * j]; v2u o; o.x = pkh(v[j].x * rstd * ww.x, v[j].y * rstd * ww.y); o.y = pkh(v[j].z * rstd * ww.z, v[j].w * rstd * ww.w); o8[64 * j] = o; }
}
__device__ __forceinline__ void p0_weights(const Frame& F, const Args& a, int part, int gw, int NGW) {
    LAS float* scr = (LAS float*)(F.lds + F.wave * 16384);
    unsigned char* ws = a.ws; const int lane = F.lane;
    constexpr int I_IN = 240 * 32, I_K = 16 * 32, I_V = 16 * 32, I_LW = 32, I_LA = 32, I_LG = 64, I_OUT = 64 * 32, I_Q = 16 * 32, I_O = 64 * 8, I_1 = 256 * 32, I_2 = 64 * 128;
    constexpr int N_EARLY = I_IN + I_K + I_V + I_LW + I_LA + I_LG, N_LATE = I_OUT + I_Q + I_O + I_1 + I_2;
    h16* wall = (h16*)(ws + WS_WALL);
    const int nitems = part ? N_LATE : N_EARLY;
    auto decode = [&](int it, TrItem& P) {
        int r = it; P.ksc = nullptr; P.nv = 32;
        if (part == 0) {
            if (r < I_IN) { const int nb = r % 240, kb = r / 240;
                if (nb < 128) { P.ns = 32 * nb; } else if (nb == 128) { P.ns = 4096; P.nv = 16; } else if (nb < 233) { P.ns = 4112 + 32 * (nb - 129); } else { P.ns = 0; P.nv = 0; }
                P.W = a.in[3]; P.N = INC; P.K = DM; P.WT = wall; P.k0 = 64 * kb; P.nd = 32 * nb; }
            else if ((r -= I_IN) < I_K) { P.W = a.in[23]; P.N = 512; P.K = DM; P.WT = wall; P.k0 = 64 * (r / 16); P.ns = 32 * (r % 16); P.nd = 7680 + P.ns; }
            else if ((r -= I_K) < I_V) { P.W = a.in[24]; P.N = 512; P.K = DM; P.WT = wall; P.k0 = 64 * (r / 16); P.ns = 32 * (r % 16); P.nd = 8192 + P.ns; }
            else if ((r -= I_V) < I_LW) { P.W = a.in[10]; P.N = 1024; P.K = 64; P.WT = (h16*)(ws + WS_LORA); P.k0 = 0; P.ns = 32 * r; P.nd = P.ns; }
            else if ((r -= I_LW) < I_LA) { P.W = a.in[12]; P.N = 1024; P.K = 64; P.WT = (h16*)(ws + WS_LORA + 131072); P.k0 = 0; P.ns = 32 * r; P.nd = P.ns; }
            else { r -= I_LA; P.W = a.in[13]; P.N = 1024; P.K = 128; P.WT = (h16*)(ws + WS_LORA + 262144); P.k0 = 64 * (r / 32); P.ns = 32 * (r % 32); P.nd = P.ns; }
        } else {
            if (r < I_OUT) { P.W = a.in[19]; P.N = DM; P.K = DM; P.WT = (h16*)(ws + WS_WOUT); P.k0 = 64 * (r / 64); P.ns = 32 * (r % 64); P.nd = P.ns; }
            else if ((r -= I_OUT) < I_Q) { P.W = a.in[22]; P.N = 512; P.K = DM; P.WT = (h16*)(ws + WS_WQ); P.ksc = a.in[20]; P.k0 = 64 * (r / 16); P.ns = 32 * (r % 16); P.nd = P.ns; }
            else if ((r -= I_Q) < I_O) { P.W = a.in[25]; P.N = DM; P.K = 512; P.WT = (h16*)(ws + WS_WO); P.k0 = 64 * (r / 64); P.ns = 32 * (r % 64); P.nd = P.ns; }
            else if ((r -= I_O) < I_1) { P.W = a.in[27]; P.N = FF; P.K = DM; P.WT = (h16*)(ws + WS_W1); P.ksc = a.in[26]; P.k0 = 64 * (r / 256); P.ns = 32 * (r % 256); P.nd = P.ns; }
            else { r -= I_1; P.W = a.in[28]; P.N = DM; P.K = FF; P.WT = (h16*)(ws + WS_W2); P.k0 = 64 * (r / 64); P.ns = 32 * (r % 64); P.nd = P.ns; }
        } };
    if (gw < nitems) {
        TrItem Pc, Pn; f32x4 vc[8], vn[8]; decode(gw, Pc); tr_load(Pc, vc, lane);
        for (int it = gw; it < nitems; it += NGW) { const bool more = it + NGW < nitems;
            if (more) { decode(it + NGW, Pn); tr_load(Pn, vn, lane); }
            tr_finish(Pc, vc, scr, lane);
            if (more) { Pc = Pn;
#pragma unroll
                for (int i = 0; i < 8; ++i) vc[i] = vn[i]; } } }
}
__device__ __forceinline__ void p0_prologue(const Frame& F, const Args& a) {
    const int gw = F.bid * NWAVES + F.wave, NGW = F.G * NWAVES, lane = F.lane;
    p0_weights(F, a, 0, gw, NGW);
    if (!LATE_W) p0_weights(F, a, 1, gw, NGW);
    h16* aall = (h16*)a.out;
#ifndef ROWREP
#define ROWREP 1
#endif
#pragma unroll 1
    for (int rr_ = 0; rr_ < ROWREP; ++rr_)
    {
        auto rowp = [&](int m) -> const float* { return m < MTOK ? a.in[0] + (size_t)m * DM : a.in[1] + (size_t)(m - MTOK) * DM; };
        int m = gw; f32x4 v[8], nv[8];
        if (m < MTOK + MMEM) { const GAS f32x4* xr = (const GAS f32x4*)rowp(m) + lane;
#pragma unroll
            for (int j = 0; j < 8; ++j) v[j] = xr[64 * j]; }
        for (; m < MTOK + MMEM; m += NGW) { const int mn = m + NGW;
            if (mn < MTOK + MMEM) { const GAS f32x4* xr = (const GAS f32x4*)rowp(mn) + lane;
#pragma unroll
                for (int j = 0; j < 8; ++j) nv[j] = xr[64 * j]; }
            float s = 0.f;
#pragma unroll
            for (int j = 0; j < 8; ++j) s += (v[j].x * v[j].x + v[j].y * v[j].y) + (v[j].z * v[j].z + v[j].w * v[j].w);
            const float rstd = __builtin_amdgcn_rsqf(wave_sum(s) * (1.f / DM) + RMS_EPS);
            const GAS f32x4* wr = (const GAS f32x4*)(m < MTOK ? a.in[2] : a.in[21]) + lane; GAS v2u* o8 = (GAS v2u*)(aall + (size_t)m * DM) + lane;
#pragma unroll
            for (int j = 0; j < 8; ++j) { const f32x4 ww = wr[64 * j]; v2u o; o.x = pkh(v[j].x * rstd * ww.x, v[j].y * rstd * ww.y); o.y = pkh(v[j].z * rstd * ww.z, v[j].w * rstd * ww.w); o8[64 * j] = o; }
#pragma unroll
            for (int j = 0; j < 8; ++j) v[j] = nv[j]; } }
}
constexpr int DC_P = 136;
constexpr int DCL_RAWQ = 0, DCL_RAWK = DCL_RAWQ + 64 * DC_P * 2, DCL_VV = DCL_RAWK + 64 * DC_P * 2, DCL_QH = DCL_VV + 64 * DC_P * 2, DCL_KH = DCL_QH + 64 * DC_P * 2, DCL_KBH = DCL_KH + 64 * DC_P * 2,
              DCL_KDT = DCL_KBH + 64 * DC_P * 2, DCL_ATT = DCL_KDT + 4 * 128 * 16 * 2, DCL_AMT = DCL_ATT + 64 * 24 * 2, DCL_SM = DCL_AMT + 4 * 16 * 20 * 4, DCL_END = DCL_SM + 2048;
constexpr int DCL_QG = DCL_RAWQ, DCL_XW = DCL_QH  , DCL_OS = DCL_VV;
static_assert(64 * 264 * 2 <= 2 * 64 * DC_P * 2 && DCL_END <= LDS_BYTES, "DN LDS map");
__device__ __forceinline__ void dn_chunked(const Frame& F, const Args& a, int unit) {
    const int b = unit >> 3, h = unit & 7;
    const int tid = F.tid, lane = F.lane, w = F.wave, l15 = lane & 15, lg = lane >> 4;
    LAS h16* RAWQ = (LAS h16*)(F.lds + DCL_RAWQ); LAS h16* RAWK = (LAS h16*)(F.lds + DCL_RAWK); LAS h16* VV = (LAS h16*)(F.lds + DCL_VV);
    LAS h16* QH = (LAS h16*)(F.lds + DCL_QH); LAS h16* KH = (LAS h16*)(F.lds + DCL_KH); LAS h16* KBH = (LAS h16*)(F.lds + DCL_KBH);
    LAS h16* KDT = (LAS h16*)(F.lds + DCL_KDT); LAS h16* ATT = (LAS h16*)(F.lds + DCL_ATT); LAS float* AMT = (LAS float*)(F.lds + DCL_AMT);
    LAS float* gS = (LAS float*)(F.lds + DCL_SM); LAS float* betaS = gS + 64; LAS float* egcS = gS + 128; LAS float* eclS = gS + 192; LAS float* gcS = gS + 256; LAS float* nwS = gS + 320;
    LAS h16* QG = (LAS h16*)(F.lds + DCL_QG); LAS h16* XW = (LAS h16*)(F.lds + DCL_XW); LAS h16* OS = (LAS h16*)(F.lds + DCL_OS);
    const h16* P = (const h16*)(a.ws + WS_P); h16* omix = (h16*)(a.ws + WS_OMIX);
    const size_t row0 = (size_t)b * SEQ;
    const bool is_col = tid < 384, is_g = (tid >= 384 && tid < 448);
    const int cp = tid % 192, rg = tid / 192;
    int pcol = 0; f32x2 cw0 = {0.f, 0.f}, cw1 = cw0, cw2 = cw0, cw3 = cw0;
    if (is_col) { pcol = (cp >> 6) * 1024 + h * 128 + 2 * (cp & 63); const float* cw = a.in[4]; cw0 = *(const f32x2*)(cw + pcol); cw1 = *(const f32x2*)(cw + 3072 + pcol); cw2 = *(const f32x2*)(cw + 6144 + pcol); cw3 = *(const f32x2*)(cw + 9216 + pcol); }
    const float neg_ea = -fexp(a.in[5][h]), dtb = a.in[6][h];
    const int pt = tid >> 3, pp = tid & 7;
    unsigned raw[35]; h16 rg0 = 0, rg1 = 0;
    pg8::f32x4 S[8];
#pragma unroll
    for (int i = 0; i < 8; ++i) S[i] = (pg8::f32x4){0.f, 0.f, 0.f, 0.f};
    const __amdgpu_buffer_rsrc_t prs = __builtin_amdgcn_make_buffer_rsrc((void*)(P - 3 * PW), (short)0, (MTOK + 3) * PW * 2, 0x00020000);
#define DC_LOAD_RAW(t0_) do { if (is_col) { const int tb = (t0_) + 32 * rg; const unsigned vo = (unsigned)((row0 + tb) * PW + pcol) * 2u; \
            _Pragma("unroll") for (int i = 0; i < 35; ++i) { const unsigned v = __builtin_amdgcn_raw_buffer_load_b32(prs, vo, i * PW * 2, 0); raw[i] = (tb + i >= 3) ? v : 0u; } } \
        else if (is_g) { const int t = (t0_) + (tid - 384); rg0 = P[(row0 + t) * PW + 4096 + h]; rg1 = P[(row0 + t) * PW + 4104 + h]; } } while (0)
    if (tid < 128) nwS[tid] = a.in[7][tid];
    v4u zpre0 = {0u, 0u, 0u, 0u}, zpre1 = zpre0;
#define DC_LOAD_Z(t0_) do { const GAS v4u* zp = (const GAS v4u*)(P + (row0 + (t0_) + pt) * PW + 3072 + h * 128 + 16 * pp); zpre0 = zp[0]; zpre1 = zp[1]; } while (0)
#ifdef DIAG_STG
    unsigned long long stg_t[8] = {0, 0, 0, 0, 0, 0, 0, 0}, stg_last = __builtin_amdgcn_s_memrealtime();
#define STG(i) do { const unsigned long long n_ = __builtin_amdgcn_s_memrealtime(); stg_t[i] += n_ - stg_last; stg_last = n_; } while (0)
#else
#define STG(i) do { } while (0)
#endif
    DC_LOAD_RAW(0); DC_LOAD_Z(0);
    for (int bt = 0; bt < SEQ / 64; ++bt) {
        const int t0 = bt * 64;
        if (is_col) { LAS h16* dst = (cp < 64 ? RAWQ : (cp < 128 ? RAWK : VV)) + 2 * (cp & 63);
#pragma unroll
            for (int t = 0; t < 32; ++t) { f32x2 y = {0.f, 0.f};
#pragma unroll
                for (int j = 0; j < 4; ++j) { const unsigned rw = raw[t + j]; const f32x2 x = {h2f((h16)(rw & 0xffff)), h2f((h16)(rw >> 16))}; y += (j == 0 ? cw0 : j == 1 ? cw1 : j == 2 ? cw2 : cw3) * x; }
                y.x = y.x * sigmoidf_(y.x); y.y = y.y * sigmoidf_(y.y);
                *(LAS unsigned*)(dst + (32 * rg + t) * DC_P) = pkh(y.x, y.y); if ((t & 7) == 7) __builtin_amdgcn_sched_barrier(0); }
        } else if (is_g) { const int t = tid - 384; gS[t] = neg_ea * softplusf_(h2f(rg0) + dtb); betaS[t] = sigmoidf_(h2f(rg1)); }
        LBAR(); STG(0);
        { const int t = pt, c16 = t & ~15; float gc = 0.f, gl = 0.f;
            for (int i = 0; i < 16; ++i) { const float gv = gS[c16 + i]; gl += gv; if (c16 + i <= t) gc += gv; }
            const float egc = fexp(gc), ekd = fexp(gl - gc), beta = betaS[t];
            if (pp == 0) { egcS[t] = egc; gcS[t] = gc; if ((t & 15) == 15) eclS[t >> 4] = fexp(gl); }
            const LAS h16* qp = RAWQ + t * DC_P + 16 * pp; const LAS h16* kp = RAWK + t * DC_P + 16 * pp;
            const h16x8 q0 = *(const LAS h16x8*)qp, q1 = *(const LAS h16x8*)(qp + 8), k0 = *(const LAS h16x8*)kp, k1 = *(const LAS h16x8*)(kp + 8);
            float qf[16], kf[16]; float sq = 0.f, sk = 0.f;
#pragma unroll
            for (int i = 0; i < 8; ++i) { qf[i] = (float)q0[i]; qf[8 + i] = (float)q1[i]; kf[i] = (float)k0[i]; kf[8 + i] = (float)k1[i]; }
#pragma unroll
            for (int i = 0; i < 16; ++i) { sq += qf[i] * qf[i]; sk += kf[i] * kf[i]; }
            sq = red8(sq); sk = red8(sk);
            const float rq = __builtin_amdgcn_rsqf(sq + 1e-6f) * 0.08838834764831845f, rk = __builtin_amdgcn_rsqf(sk + 1e-6f);
            unsigned oq[8], og[8], ok[8], ob[8];
#pragma unroll
            for (int i = 0; i < 8; ++i) { const float qa = qf[2 * i] * rq, qb = qf[2 * i + 1] * rq, ka = kf[2 * i] * rk, kb = kf[2 * i + 1] * rk;
                oq[i] = pkh(qa, qb); og[i] = pkh(qa * egc, qb * egc); ok[i] = pkh(ka, kb); ob[i] = pkh(ka * beta, kb * beta);
                KDT[((t >> 4) * 128 + 16 * pp + 2 * i) * 16 + (t & 15)] = f2h(ka * ekd); KDT[((t >> 4) * 128 + 16 * pp + 2 * i + 1) * 16 + (t & 15)] = f2h(kb * ekd); }
            *(LAS v4u*)(QH + t * DC_P + 16 * pp) = (v4u){oq[0], oq[1], oq[2], oq[3]}; *(LAS v4u*)(QH + t * DC_P + 16 * pp + 8) = (v4u){oq[4], oq[5], oq[6], oq[7]};
            *(LAS v4u*)(QG + t * DC_P + 16 * pp) = (v4u){og[0], og[1], og[2], og[3]}; *(LAS v4u*)(QG + t * DC_P + 16 * pp + 8) = (v4u){og[4], og[5], og[6], og[7]};
            *(LAS v4u*)(KH + t * DC_P + 16 * pp) = (v4u){ok[0], ok[1], ok[2], ok[3]}; *(LAS v4u*)(KH + t * DC_P + 16 * pp + 8) = (v4u){ok[4], ok[5], ok[6], ok[7]};
            *(LAS v4u*)(KBH + t * DC_P + 16 * pp) = (v4u){ob[0], ob[1], ob[2], ob[3]}; *(LAS v4u*)(KBH + t * DC_P + 16 * pp + 8) = (v4u){ob[4], ob[5], ob[6], ob[7]}; }
        LBAR(); STG(1);
        { const int c = w & 3, which = w >> 2; const LAS h16* Am = (which ? QH : KBH) + (16 * c + l15) * DC_P + 8 * lg; const LAS h16* Bm = KH + (16 * c + l15) * DC_P + 8 * lg;
            pg8::f32x4 acc = {0.f, 0.f, 0.f, 0.f};
#pragma unroll
            for (int ks = 0; ks < 4; ++ks) acc = __builtin_amdgcn_mfma_f32_16x16x32_f16(*(const LAS h16x8*)(Am + 32 * ks), *(const LAS h16x8*)(Bm + 32 * ks), acc, 0, 0, 0);
            const float gj = gcS[16 * c + l15];
#pragma unroll
            for (int r = 0; r < 4; ++r) { const int i = 4 * lg + r, j = l15; const float dec = fexp(gcS[16 * c + i] - gj);
                if (which) ATT[(16 * c + i) * 24 + j] = f2h(i >= j ? acc[r] * dec : 0.f); else AMT[(c * 16 + j) * 20 + i] = (i > j ? acc[r] * dec : 0.f); } }
        LBAR(); STG(2);
        { const int c = tid >> 7, cp = tid & 127, col = 2 * cp; f32x2 x[16];
#pragma unroll
            for (int i = 0; i < 16; ++i) { const int t = 16 * c + i; const unsigned rv = col < 128 ? *(const LAS unsigned*)(VV + t * DC_P + col) : *(const LAS unsigned*)(KBH + t * DC_P + col - 128);
                const float sc = col < 128 ? betaS[t] : egcS[t]; x[i] = (f32x2){h2f((h16)(rv & 0xffff)), h2f((h16)(rv >> 16))} * sc; }
#pragma unroll
            for (int j = 0; j < 15; ++j) { const LAS f32x4* ap4 = (const LAS f32x4*)(AMT + (c * 16 + j) * 20); float ap[16];
#pragma unroll
                for (int q = (j + 1) / 4; q < 4; ++q) { const f32x4 v = ap4[q]; ap[4 * q] = v.x; ap[4 * q + 1] = v.y; ap[4 * q + 2] = v.z; ap[4 * q + 3] = v.w; }
#pragma unroll
                for (int i = j + 1; i < 16; ++i) x[i] -= x[j] * ap[i]; }
#pragma unroll
            for (int i = 0; i < 16; ++i) *(LAS unsigned*)(XW + (16 * c + i) * 264 + col) = pkh(x[i].x, x[i].y); }
        LBAR(); STG(3);
        if (bt + 1 < SEQ / 64) DC_LOAD_RAW(t0 + 64);
#pragma unroll 1
        for (int c = 0; c < 4; ++c) { const int T0 = 16 * c;
            h16x8 sf[4];
#pragma unroll
            for (int s = 0; s < 4; ++s) { const v4u t = {pkh(S[2 * s][0], S[2 * s][1]), pkh(S[2 * s][2], S[2 * s][3]), pkh(S[2 * s + 1][0], S[2 * s + 1][1]), pkh(S[2 * s + 1][2], S[2 * s + 1][3])}; sf[s] = __builtin_bit_cast(h16x8, t); }
            pg8::f32x4 av = {0.f, 0.f, 0.f, 0.f}, ao = av;
#pragma unroll
            for (int s = 0; s < 4; ++s) { const LAS h16* wp = XW + (T0 + l15) * 264 + 128 + 32 * s + 4 * lg; const v2u lo = *(const LAS v2u*)wp, hi = *(const LAS v2u*)(wp + 16);
                av = __builtin_amdgcn_mfma_f32_16x16x32_f16(__builtin_bit_cast(h16x8, (v4u){lo.x, lo.y, hi.x, hi.y}), sf[s], av, 0, 0, 0);
                const LAS h16* qp = QG + (T0 + l15) * DC_P + 32 * s + 4 * lg; const v2u ql = *(const LAS v2u*)qp, qh = *(const LAS v2u*)(qp + 16);
                ao = __builtin_amdgcn_mfma_f32_16x16x32_f16(__builtin_bit_cast(h16x8, (v4u){ql.x, ql.y, qh.x, qh.y}), sf[s], ao, 0, 0, 0); }
            float vn[4];
#pragma unroll
            for (int r = 0; r < 4; ++r) vn[r] = h2f(XW[(T0 + 4 * lg + r) * 264 + 16 * w + l15]) - av[r];
            const h16x8 vf = __builtin_bit_cast(h16x8, (v4u){pkh(vn[0], vn[1]), pkh(vn[2], vn[3]), 0u, 0u});
            { const v2u al = *(const LAS v2u*)(ATT + (T0 + l15) * 24 + 4 * lg); ao = __builtin_amdgcn_mfma_f32_16x16x32_f16(__builtin_bit_cast(h16x8, (v4u){al.x, al.y, 0u, 0u}), vf, ao, 0, 0, 0); }
            const float ecl = eclS[c];
#pragma unroll
            for (int tau = 0; tau < 8; ++tau) { const v2u kl = *(const LAS v2u*)(KDT + ((c * 128 + 16 * tau + l15) * 16) + 4 * lg);
                S[tau] = __builtin_amdgcn_mfma_f32_16x16x32_f16(__builtin_bit_cast(h16x8, (v4u){kl.x, kl.y, 0u, 0u}), vf, S[tau] * ecl, 0, 0, 0); }
#pragma unroll
            for (int r = 0; r < 4; ++r) OS[(T0 + 4 * lg + r) * DC_P + 16 * w + l15] = f2h(ao[r]);
        }
        LBAR(); STG(4);
        { const LAS h16* op = OS + pt * DC_P + 16 * pp; const h16x8 o0 = *(const LAS h16x8*)op, o1 = *(const LAS h16x8*)(op + 8);
            const v4u z0 = zpre0, z1 = zpre1;
            f32x4 nw[4];
#pragma unroll
            for (int j = 0; j < 4; ++j) nw[j] = *(const LAS f32x4*)(nwS + 16 * pp + 4 * j);
            float of[16]; float s = 0.f;
#pragma unroll
            for (int i = 0; i < 8; ++i) { of[i] = (float)o0[i]; of[8 + i] = (float)o1[i]; }
#pragma unroll
            for (int i = 0; i < 16; ++i) s += of[i] * of[i];
            s = red8(s); const float rstd = __builtin_amdgcn_rsqf(s * (1.0f / 128.0f) + RMS_EPS);
            const unsigned zz[8] = {z0.x, z0.y, z0.z, z0.w, z1.x, z1.y, z1.z, z1.w}; unsigned ow[8];
#pragma unroll
            for (int i = 0; i < 8; ++i) { const float za = h2f((h16)(zz[i] & 0xffff)), zb = h2f((h16)(zz[i] >> 16)); const float wa = nw[i >> 1][(2 * i) & 3], wb = nw[i >> 1][(2 * i + 1) & 3];
                ow[i] = pkh(of[2 * i] * rstd * wa * za * sigmoidf_(za), of[2 * i + 1] * rstd * wb * zb * sigmoidf_(zb)); }
            GAS v4u* dst = (GAS v4u*)(omix + (row0 + t0 + pt) * DM + h * 128 + 16 * pp);
            dst[0] = (v4u){ow[0], ow[1], ow[2], ow[3]}; dst[1] = (v4u){ow[4], ow[5], ow[6], ow[7]}; }
        if (bt + 1 < SEQ / 64) DC_LOAD_Z(t0 + 64);
        LBAR(); STG(5);
    }
#ifdef DIAG_STG
    if (tid == 0 && unit == 0) { unsigned long long* tsq = (unsigned long long*)(a.ws + WS_CTL + 4096); unsigned long long c_ = 0; tsq[48] = 0;
#pragma unroll
        for (int i = 0; i < 6; ++i) { c_ += stg_t[i]; tsq[49 + i] = c_; } }
#endif
#undef STG
#undef DC_LOAD_Z
#undef DC_LOAD_RAW
}
constexpr int RC_FP = 68, RC_F = RC_FP * 64 * 4, RC_H = 72 * 64 * 2;
constexpr int RCL_RL = 0, RCL_PKL = RCL_RL + RC_F, RCL_GL = RCL_PKL + RC_F, RCL_ALR = RCL_GL + RC_F, RCL_GATE = RCL_ALR + RC_F, RCL_VH = RCL_GATE + RC_F, RCL_HW = RCL_VH + RC_H, RCL_HA = RCL_HW + RC_H,
              RCL_HG = RCL_HA + RC_H, RCL_BR = RCL_HG + 64 * 136 * 2, RCL_KR = RCL_BR + RC_H, RCL_KHT = RCL_KR + RC_H, RCL_WC = RCL_KHT + 8192, RCL_BON = RCL_WC + 1024, RCL_CST = RCL_BON + 256, RCL_END = RCL_CST + 7 * 256;
constexpr int RCL_LT = RCL_RL, RCL_RHS2 = RCL_LT + 5120, RCL_MRB = RCL_RHS2 + 5120, RCL_MRK = RCL_MRB + 3072;
constexpr int RCL_WP = RCL_PKL, RCL_TL = RCL_WP + RC_H;
constexpr int RCL_YL = RCL_GL, RCL_ATF = RCL_ALR, RCL_AR = RCL_HW, RCL_RT = RCL_HA, RCL_RR = RCL_HG, RCL_BHT = RCL_HG + RC_H;
static_assert(RCL_MRK + 3072 <= RCL_PKL && RCL_TL + 3072 <= RCL_GL && RCL_BHT + 8192 <= RCL_BR && RCL_END <= LDS_BYTES, "RW LDS map");
__device__ __forceinline__ void rw_chunked(const Frame& F, const Args& a, int unit) {
    const int b = unit >> 4, h = unit & 15;
    const int tid0 = F.tid, w = F.wave;
    LAS float* RL = (LAS float*)(F.lds + RCL_RL); LAS float* PKL = (LAS float*)(F.lds + RCL_PKL); LAS float* GL = (LAS float*)(F.lds + RCL_GL); LAS float* ALR = (LAS float*)(F.lds + RCL_ALR);
    LAS float* GATE = (LAS float*)(F.lds + RCL_GATE); LAS h16* VH = (LAS h16*)(F.lds + RCL_VH); LAS h16* HW = (LAS h16*)(F.lds + RCL_HW); LAS h16* HA = (LAS h16*)(F.lds + RCL_HA); LAS h16* HG = (LAS h16*)(F.lds + RCL_HG);
    LAS h16* BR = (LAS h16*)(F.lds + RCL_BR); LAS h16* KR = (LAS h16*)(F.lds + RCL_KR); LAS h16* KHT = (LAS h16*)(F.lds + RCL_KHT); LAS float* WC = (LAS float*)(F.lds + RCL_WC); LAS float* BON = (LAS float*)(F.lds + RCL_BON);
    LAS float* LT = (LAS float*)(F.lds + RCL_LT); LAS float* RHS2 = (LAS float*)(F.lds + RCL_RHS2); LAS h16* MRB = (LAS h16*)(F.lds + RCL_MRB); LAS h16* MRK = (LAS h16*)(F.lds + RCL_MRK);
    LAS h16* WP = (LAS h16*)(F.lds + RCL_WP); LAS h16* TL = (LAS h16*)(F.lds + RCL_TL); LAS float* YL = (LAS float*)(F.lds + RCL_YL); LAS float* ATF = (LAS float*)(F.lds + RCL_ATF);
    LAS h16* AR = (LAS h16*)(F.lds + RCL_AR); LAS h16* RT = (LAS h16*)(F.lds + RCL_RT); LAS h16* RR = (LAS h16*)(F.lds + RCL_RR); LAS h16* BHT = (LAS h16*)(F.lds + RCL_BHT);
    const h16* P = (const h16*)(a.ws + WS_P); h16* omix = (h16*)(a.ws + WS_OMIX);
    const size_t row0 = (size_t)b * SEQ;
    const bool is_col = tid0 < 448; const int cp = tid0 % 224, rgp = tid0 / 224;
    int rcol = 0; f32x2 mu = {0.f, 0.f};
    if (is_col) { rcol = cp < 96 ? (cp >> 5) * 1024 + h * 64 + 2 * (cp & 31) : 3072 + 2 * (cp - 96); mu = *(const f32x2*)(a.in[8] + rcol); }
    int kind = 0, dstb = 0, dstride = RC_FP * 4;
    if (cp < 32) { dstb = RCL_RL + 8 * cp; } else if (cp < 64) { dstb = RCL_PKL + 8 * (cp - 32); } else if (cp < 96) { kind = 1; dstb = RCL_VH + 4 * (cp - 64); dstride = 144; }
    else if (cp < 128) { kind = 2; dstb = RCL_HW + 4 * (cp - 96); dstride = 144; } else if (cp < 160) { kind = 1; dstb = RCL_HA + 4 * (cp - 128); dstride = 144; } else { kind = 3; dstb = RCL_HG + 4 * (cp - 160); dstride = 272; }
    const __amdgpu_buffer_rsrc_t prs = __builtin_amdgcn_make_buffer_rsrc((void*)(P - PW), (short)0, (MTOK + 1) * PW * 2, 0x00020000);
    unsigned raw[33];
#define RC_LOAD_RAW(t0_) do { if (is_col) { const int tb = (t0_) + 32 * rgp; const unsigned vo = (unsigned)((row0 + tb) * PW + RW0 + rcol) * 2u; \
            _Pragma("unroll") for (int i = 0; i < 33; ++i) { const unsigned v = __builtin_amdgcn_raw_buffer_load_b32(prs, vo, i * PW * 2, 0); raw[i] = (tb + i >= 1) ? v : 0u; } } } while (0)
    pg8::f32x4 St[4];
#pragma unroll
    for (int i = 0; i < 4; ++i) St[i] = (pg8::f32x4){0.f, 0.f, 0.f, 0.f};
    h16x8 bq[4];
    { const int n = h * 64 + 16 * (w & 3) + (F.lane & 15), lg0 = F.lane >> 4;
        if (w < 4) { const h16* w2T = (const h16*)(a.ws + WS_LORA) + (size_t)n * 64 + 8 * lg0; const h16* a2T = (const h16*)(a.ws + WS_LORA + 131072) + (size_t)n * 64 + 8 * lg0;
            bq[0] = *(const GAS h16x8*)w2T; bq[1] = *(const GAS h16x8*)(w2T + 32); bq[2] = *(const GAS h16x8*)a2T; bq[3] = *(const GAS h16x8*)(a2T + 32); }
        else { const h16* g2T = (const h16*)(a.ws + WS_LORA + 262144) + (size_t)n * 128 + 8 * lg0;
#pragma unroll
            for (int ks = 0; ks < 4; ++ks) bq[ks] = *(const GAS h16x8*)(g2T + 32 * ks); } }
    LAS float* CST = (LAS float*)(F.lds + RCL_CST);
    if (tid0 < 448) { const int q = tid0 >> 6, n = tid0 & 63; const int src[7] = {14, 15, 16, 17, 18, 9, 11}; CST[q * 64 + n] = a.in[src[q]][h * 64 + n]; }
#ifdef DIAG_STG
    unsigned long long stg_t[10] = {0, 0, 0, 0, 0, 0, 0, 0, 0, 0}, stg_last = __builtin_amdgcn_s_memrealtime();
#define STG(i) do { const unsigned long long n_ = __builtin_amdgcn_s_memrealtime(); stg_t[i] += n_ - stg_last; stg_last = n_; } while (0)
#else
#define STG(i) do { } while (0)
#endif
    RC_LOAD_RAW(0);
    for (int bt = 0; bt < SEQ / 64; ++bt) {
        const int t0 = bt * 64;
        int tid = tid0; asm volatile("" : "+v"(tid));
        const int lane = tid & 63, l15 = lane & 15, lg = lane >> 4, ft = tid >> 3, fp = tid & 7, hc0 = h * 64 + 8 * fp;
#ifndef S1REP
#define S1REP 1
#endif
#ifdef S1UNROLL
#pragma unroll
#else
#pragma unroll 1
#endif
        for (int rep_ = 0; rep_ < S1REP; ++rep_)
        if (is_col) { unsigned ad = (unsigned)(dstb + 32 * rgp * dstride); asm volatile("" : "+v"(ad));
#pragma unroll
            for (int t = 0; t < 32; ++t) { const unsigned rw = raw[t + 1], rp = raw[t]; const f32x2 x = {h2f((h16)(rw & 0xffff)), h2f((h16)(rw >> 16))}, xp = {h2f((h16)(rp & 0xffff)), h2f((h16)(rp >> 16))};
                f32x2 y = x + (xp - x) * mu;
                if (kind == 0) { *(LAS f32x2*)(F.lds + ad) = y; }
                else { *(LAS unsigned*)(F.lds + ad) = pkh(y.x, y.y); }
                ad += dstride; if ((t & 7) == 7) __builtin_amdgcn_sched_barrier(0); }
        }
        LBAR(); STG(0);
#pragma unroll 2
        for (int i = tid; i < 64 * 32; i += NTHREADS) { LAS unsigned* p = (LAS unsigned*)(HW + (i >> 5) * 72 + 2 * (i & 31)); const unsigned v = *p; *p = pkh(ftanh(h2f((h16)(v & 0xffff))), ftanh(h2f((h16)(v >> 16)))); }
#pragma unroll 2
        for (int i = tid; i < 64 * 64; i += NTHREADS) { LAS unsigned* p = (LAS unsigned*)(HG + (i >> 6) * 136 + 2 * (i & 63)); const unsigned v = *p; *p = pkh(sigmoidf_(h2f((h16)(v & 0xffff))), sigmoidf_(h2f((h16)(v >> 16)))); }
        LBAR();
        { const int nt = w & 3, n = 16 * nt + l15;
            if (w < 4) { const float c_w0 = CST[320 + n], c_a0 = CST[384 + n];
#pragma unroll
                for (int mt = 0; mt < 4; ++mt) { pg8::f32x4 accw = {0.f, 0.f, 0.f, 0.f}, acca = accw;
#pragma unroll
                    for (int ks = 0; ks < 2; ++ks) { accw = __builtin_amdgcn_mfma_f32_16x16x32_f16(*(const LAS h16x8*)(HW + (16 * mt + l15) * 72 + 32 * ks + 8 * lg), bq[ks], accw, 0, 0, 0);
                        acca = __builtin_amdgcn_mfma_f32_16x16x32_f16(*(const LAS h16x8*)(HA + (16 * mt + l15) * 72 + 32 * ks + 8 * lg), bq[2 + ks], acca, 0, 0, 0); }
                    float ld[4];
#pragma unroll
                    for (int r = 0; r < 4; ++r) { const float lw = -softplusf_(-(c_w0 + accw[r])) - 0.5f; ld[r] = -fexp(lw); }
                    ld[1] += ld[0]; ld[2] += ld[1]; ld[3] += ld[2];
                    { const float tot = ld[3]; const float t1 = __shfl_up(tot, 16), t2 = __shfl_up(tot, 32), t3 = __shfl_up(tot, 48);
                      const float off = (lg >= 1 ? t1 : 0.f) + (lg >= 2 ? t2 : 0.f) + (lg >= 3 ? t3 : 0.f);
#pragma unroll
                      for (int r = 0; r < 4; ++r) { const int tok = 16 * mt + 4 * lg + r; GL[tok * RC_FP + n] = ld[r] + off; ALR[tok * RC_FP + n] = sigmoidf_(c_a0 + acca[r]); } } }
            } else {
#pragma unroll
                for (int mt = 0; mt < 4; ++mt) { pg8::f32x4 accg = {0.f, 0.f, 0.f, 0.f};
#pragma unroll
                    for (int ks = 0; ks < 4; ++ks) accg = __builtin_amdgcn_mfma_f32_16x16x32_f16(*(const LAS h16x8*)(HG + (16 * mt + l15) * 136 + 32 * ks + 8 * lg), bq[ks], accg, 0, 0, 0);
#pragma unroll
                    for (int r = 0; r < 4; ++r) GATE[(16 * mt + 4 * lg + r) * RC_FP + n] = accg[r]; } } }
        LBAR(); STG(1);
        { const int t = ft, c16 = t & ~15, tl = t & 15, c = t >> 4;
            const f32x4 ckk0 = *(const LAS f32x4*)(CST + 8 * fp), ckk1 = *(const LAS f32x4*)(CST + 8 * fp + 4), cka0 = *(const LAS f32x4*)(CST + 64 + 8 * fp), cka1 = *(const LAS f32x4*)(CST + 64 + 8 * fp + 4),
                        crk0 = *(const LAS f32x4*)(CST + 128 + 8 * fp), crk1 = *(const LAS f32x4*)(CST + 128 + 8 * fp + 4);
            const float ckk[8] = {ckk0.x, ckk0.y, ckk0.z, ckk0.w, ckk1.x, ckk1.y, ckk1.z, ckk1.w}, cka[8] = {cka0.x, cka0.y, cka0.z, cka0.w, cka1.x, cka1.y, cka1.z, cka1.w}, crk[8] = {crk0.x, crk0.y, crk0.z, crk0.w, crk1.x, crk1.y, crk1.z, crk1.w};
            float pk[8], rr[8], al[8], kk[8], kf[8], bb[8], gt[8], gp[8], gl[8], gr[8]; float ss = 0.f, bon = 0.f;
#pragma unroll
            for (int q = 0; q < 2; ++q) { const int o = t * RC_FP + 8 * fp + 4 * q;
                const f32x4 a_ = *(const LAS f32x4*)(PKL + o), b_ = *(const LAS f32x4*)(RL + o), c_ = *(const LAS f32x4*)(ALR + o), g0 = *(const LAS f32x4*)(GL + o),
                            g2 = *(const LAS f32x4*)(GL + (c16 + 15) * RC_FP + 8 * fp + 4 * q), g3 = *(const LAS f32x4*)(GL + (c16 + 7) * RC_FP + 8 * fp + 4 * q);
                f32x4 g1 = {0.f, 0.f, 0.f, 0.f}; if (tl) g1 = *(const LAS f32x4*)(GL + o - RC_FP);
#pragma unroll
                for (int e = 0; e < 4; ++e) { pk[4 * q + e] = a_[e]; rr[4 * q + e] = b_[e]; al[4 * q + e] = c_[e]; gt[4 * q + e] = g0[e]; gp[4 * q + e] = g1[e]; gl[4 * q + e] = g2[e]; gr[4 * q + e] = g3[e]; } }
#pragma unroll
            for (int i = 0; i < 8; ++i) { kk[i] = pk[i] * ckk[i]; ss += kk[i] * kk[i]; }
            ss = red8(ss); const float inv = 1.0f / fmaxf(__builtin_amdgcn_sqrtf(ss), 1e-12f);
#pragma unroll
            for (int i = 0; i < 8; ++i) { kk[i] *= inv; kf[i] = pk[i] * (1.0f + (al[i] - 1.0f) * cka[i]); bb[i] = kk[i] * al[i]; bon += rr[i] * kf[i] * crk[i]; }
            bon = red8(bon); if (fp == 0) BON[t] = bon;
            unsigned oar[4], ort[4], orr[4], obr[4], okr[4]; float atf[8];
#pragma unroll
            for (int i = 0; i < 8; i += 2) { float va[2], vr[2], vrr[2], vb[2], vk[2];
#pragma unroll
                for (int e = 0; e < 2; ++e) { const int n = 8 * fp + i + e; const float Gt = gt[i + e], Gp = gp[i + e], Gl = gl[i + e], Gr = gr[i + e];
                    const float ap = -kk[i + e];
                    atf[i + e] = ap * fexp(Gp); va[e] = ap * fexp(Gp - Gr); vr[e] = rr[i + e] * fexp(Gt); vrr[e] = rr[i + e] * fexp(Gt - Gr);
                    const float er = fexp(Gr - Gt), el = fexp(Gl - Gt); vb[e] = bb[i + e] * er; vk[e] = kf[i + e] * er;
                    BHT[(c * 64 + n) * 16 + tl] = f2h(bb[i + e] * el); KHT[(c * 64 + n) * 16 + tl] = f2h(kf[i + e] * el); }
                oar[i >> 1] = pkh(va[0], va[1]); ort[i >> 1] = pkh(vr[0], vr[1]); orr[i >> 1] = pkh(vrr[0], vrr[1]); obr[i >> 1] = pkh(vb[0], vb[1]); okr[i >> 1] = pkh(vk[0], vk[1]); }
            *(LAS f32x4*)(ATF + t * RC_FP + 8 * fp) = (f32x4){atf[0], atf[1], atf[2], atf[3]}; *(LAS f32x4*)(ATF + t * RC_FP + 8 * fp + 4) = (f32x4){atf[4], atf[5], atf[6], atf[7]};
            if (tl == 15) { *(LAS f32x4*)(WC + c * 64 + 8 * fp) = (f32x4){fexp(gl[0]), fexp(gl[1]), fexp(gl[2]), fexp(gl[3])}; *(LAS f32x4*)(WC + c * 64 + 8 * fp + 4) = (f32x4){fexp(gl[4]), fexp(gl[5]), fexp(gl[6]), fexp(gl[7])}; }
            *(LAS v4u*)(AR + t * 72 + 8 * fp) = (v4u){oar[0], oar[1], oar[2], oar[3]}; *(LAS v4u*)(RT + t * 72 + 8 * fp) = (v4u){ort[0], ort[1], ort[2], ort[3]};
            *(LAS v4u*)(RR + t * 72 + 8 * fp) = (v4u){orr[0], orr[1], orr[2], orr[3]}; *(LAS v4u*)(BR + t * 72 + 8 * fp) = (v4u){obr[0], obr[1], obr[2], obr[3]};
            *(LAS v4u*)(KR + t * 72 + 8 * fp) = (v4u){okr[0], okr[1], okr[2], okr[3]}; }
        LBAR(); STG(3);
        { const int c = w & 3, rt = w >> 2; const LAS h16* Am = (rt ? RR : AR) + (16 * c + l15) * 72 + 8 * lg;
#pragma unroll
            for (int ct = 0; ct < 2; ++ct) { const LAS h16* Bm = (ct ? KR : BR) + (16 * c + l15) * 72 + 8 * lg; pg8::f32x4 acc = {0.f, 0.f, 0.f, 0.f};
#pragma unroll
                for (int ks = 0; ks < 2; ++ks) acc = __builtin_amdgcn_mfma_f32_16x16x32_f16(*(const LAS h16x8*)(Am + 32 * ks), *(const LAS h16x8*)(Bm + 32 * ks), acc, 0, 0, 0);
#pragma unroll
                for (int r = 0; r < 4; ++r) { const int t = 4 * lg + r, i = l15;
                    if (rt == 0) { const float v = t > i ? acc[r] : 0.f; if (ct == 0) LT[(c * 16 + i) * 20 + t] = v; else RHS2[(c * 16 + t) * 20 + i] = v; }
                    else { const h16 v = f2h(t >= i ? acc[r] : 0.f); if (ct == 0) MRB[(16 * c + t) * 24 + i] = v; else MRK[(16 * c + t) * 24 + i] = v; } } } }
        LBAR(); STG(4);
        if (tid < 320) { const int c = tid / 80, col = tid % 80; float x[16];
#pragma unroll
            for (int i = 0; i < 16; ++i) x[i] = col < 64 ? ATF[(16 * c + i) * RC_FP + col] : RHS2[(c * 16 + i) * 20 + col - 64];
#pragma unroll
            for (int j = 0; j < 15; ++j) { const LAS f32x4* lp4 = (const LAS f32x4*)(LT + (c * 16 + j) * 20); float lp[16];
#pragma unroll
                for (int q = (j + 1) / 4; q < 4; ++q) { const f32x4 v = lp4[q]; lp[4 * q] = v.x; lp[4 * q + 1] = v.y; lp[4 * q + 2] = v.z; lp[4 * q + 3] = v.w; }
#pragma unroll
                for (int i = j + 1; i < 16; ++i) x[i] += lp[i] * x[j]; }
#pragma unroll
            for (int i = 0; i < 16; ++i) { if (col < 64) WP[(16 * c + i) * 72 + col] = f2h(x[i]); else TL[(16 * c + i) * 24 + col - 64] = f2h(x[i]); } }
        LBAR(); STG(5);
        if (bt + 1 < SEQ / 64) RC_LOAD_RAW(t0 + 64);
        if (w < 4) {
#pragma unroll 1
            for (int c = 0; c < 4; ++c) { const int T0 = 16 * c;
                h16x8 sf[2];
#pragma unroll
                for (int s = 0; s < 2; ++s) { const v4u t = {pkh(St[2 * s][0], St[2 * s][1]), pkh(St[2 * s][2], St[2 * s][3]), pkh(St[2 * s + 1][0], St[2 * s + 1][1]), pkh(St[2 * s + 1][2], St[2 * s + 1][3])}; sf[s] = __builtin_bit_cast(h16x8, t); }
                float vv[4];
#pragma unroll
                for (int r = 0; r < 4; ++r) vv[r] = h2f(VH[(T0 + 4 * lg + r) * 72 + 16 * w + l15]);
                const h16x8 vf = __builtin_bit_cast(h16x8, (v4u){pkh(vv[0], vv[1]), pkh(vv[2], vv[3]), 0u, 0u});
                pg8::f32x4 U = {0.f, 0.f, 0.f, 0.f}, Y = U;
#pragma unroll
                for (int s = 0; s < 2; ++s) { const LAS h16* wp = WP + (T0 + l15) * 72 + 32 * s + 4 * lg; const v2u lo = *(const LAS v2u*)wp, hi = *(const LAS v2u*)(wp + 16);
                    U = __builtin_amdgcn_mfma_f32_16x16x32_f16(__builtin_bit_cast(h16x8, (v4u){lo.x, lo.y, hi.x, hi.y}), sf[s], U, 0, 0, 0);
                    const LAS h16* rp = RT + (T0 + l15) * 72 + 32 * s + 4 * lg; const v2u rl = *(const LAS v2u*)rp, rh = *(const LAS v2u*)(rp + 16);
                    Y = __builtin_amdgcn_mfma_f32_16x16x32_f16(__builtin_bit_cast(h16x8, (v4u){rl.x, rl.y, rh.x, rh.y}), sf[s], Y, 0, 0, 0); }
                { const v2u tl = *(const LAS v2u*)(TL + (T0 + l15) * 24 + 4 * lg); U = __builtin_amdgcn_mfma_f32_16x16x32_f16(__builtin_bit_cast(h16x8, (v4u){tl.x, tl.y, 0u, 0u}), vf, U, 0, 0, 0); }
                const h16x8 uf = __builtin_bit_cast(h16x8, (v4u){pkh(U[0], U[1]), pkh(U[2], U[3]), 0u, 0u});
                { const v2u mb = *(const LAS v2u*)(MRB + (T0 + l15) * 24 + 4 * lg), mk = *(const LAS v2u*)(MRK + (T0 + l15) * 24 + 4 * lg);
                    Y = __builtin_amdgcn_mfma_f32_16x16x32_f16(__builtin_bit_cast(h16x8, (v4u){mb.x, mb.y, 0u, 0u}), uf, Y, 0, 0, 0);
                    Y = __builtin_amdgcn_mfma_f32_16x16x32_f16(__builtin_bit_cast(h16x8, (v4u){mk.x, mk.y, 0u, 0u}), vf, Y, 0, 0, 0); }
#pragma unroll
                for (int r = 0; r < 4; ++r) YL[(T0 + 4 * lg + r) * RC_FP + 16 * w + l15] = Y[r];
#pragma unroll
                for (int tau = 0; tau < 4; ++tau) { const f32x4 wc = *(const LAS f32x4*)(WC + c * 64 + 16 * tau + 4 * lg);
                    const v2u bl = *(const LAS v2u*)(BHT + (c * 64 + 16 * tau + l15) * 16 + 4 * lg), kl = *(const LAS v2u*)(KHT + (c * 64 + 16 * tau + l15) * 16 + 4 * lg);
                    pg8::f32x4 sacc = {St[tau][0] * wc.x, St[tau][1] * wc.y, St[tau][2] * wc.z, St[tau][3] * wc.w};
                    sacc = __builtin_amdgcn_mfma_f32_16x16x32_f16(__builtin_bit_cast(h16x8, (v4u){bl.x, bl.y, 0u, 0u}), uf, sacc, 0, 0, 0);
                    St[tau] = __builtin_amdgcn_mfma_f32_16x16x32_f16(__builtin_bit_cast(h16x8, (v4u){kl.x, kl.y, 0u, 0u}), vf, sacc, 0, 0, 0); }
            }
        }
        LBAR(); STG(6);
        { const int t = ft; float y[8]; float s = 0.f;
#pragma unroll
            for (int q = 0; q < 2; ++q) { const f32x4 yv = *(const LAS f32x4*)(YL + t * RC_FP + 8 * fp + 4 * q);
#pragma unroll
                for (int e = 0; e < 4; ++e) { y[4 * q + e] = yv[e]; s += yv[e]; } }
            const float mean = red8(s) * (1.0f / 64.0f); float q = 0.f;
#pragma unroll
            for (int i = 0; i < 8; ++i) { y[i] -= mean; q += y[i] * y[i]; }
            const float rstd = __builtin_amdgcn_rsqf(red8(q) * (1.0f / 64.0f) + 64e-5f), bon = BON[t];
            const f32x4 lw0 = *(const LAS f32x4*)(CST + 192 + 8 * fp), lw1 = *(const LAS f32x4*)(CST + 192 + 8 * fp + 4), lb0 = *(const LAS f32x4*)(CST + 256 + 8 * fp), lb1 = *(const LAS f32x4*)(CST + 256 + 8 * fp + 4);
            const float lw[8] = {lw0.x, lw0.y, lw0.z, lw0.w, lw1.x, lw1.y, lw1.z, lw1.w}, lb[8] = {lb0.x, lb0.y, lb0.z, lb0.w, lb1.x, lb1.y, lb1.z, lb1.w};
            const h16x8 v8 = *(const LAS h16x8*)(VH + t * 72 + 8 * fp); float res[8];
            const f32x4 gq0 = *(const LAS f32x4*)(GATE + t * RC_FP + 8 * fp), gq1 = *(const LAS f32x4*)(GATE + t * RC_FP + 8 * fp + 4); const float gq[8] = {gq0.x, gq0.y, gq0.z, gq0.w, gq1.x, gq1.y, gq1.z, gq1.w};
#pragma unroll
            for (int i = 0; i < 8; ++i) res[i] = (y[i] * rstd * lw[i] + lb[i] + bon * (float)v8[i]) * gq[i];
            *(GAS v4u*)(omix + (row0 + t0 + t) * DM + 1024 + hc0) = (v4u){pkh(res[0], res[1]), pkh(res[2], res[3]), pkh(res[4], res[5]), pkh(res[6], res[7])}; }
        LBAR(); STG(7);
    }
#ifdef DIAG_STG
    if (tid0 == 0 && unit == 0) { unsigned long long* tsq = (unsigned long long*)(a.ws + WS_CTL + 4096); unsigned long long c_ = 0; tsq[32] = 0;
#pragma unroll
        for (int i = 0; i < 10; ++i) { c_ += stg_t[i]; tsq[33 + i] = c_; } }
#endif
#undef STG
#undef RC_LOAD_RAW
}
__device__ __forceinline__ void dn_norm_gate(const Frame& F, const Args& a) {
    const int gw = F.bid * NWAVES + F.wave, NGW = F.G * NWAVES, lane = F.lane;
    const float* oraw = a.out; const h16* P = (const h16*)(a.ws + WS_P); h16* omix = (h16*)(a.ws + WS_OMIX);
    const int cn = (lane & 7) * 16;
    f32x4 nw[4];
#pragma unroll
    for (int j = 0; j < 4; ++j) nw[j] = *(const f32x4*)(a.in[7] + cn + 4 * j);
    for (int m = gw; m < MTOK; m += NGW) {
        const GAS f32x4* op = (const GAS f32x4*)(oraw + (size_t)m * 1024 + lane * 16);
        f32x4 v[4]; float s = 0.f;
#pragma unroll
        for (int j = 0; j < 4; ++j) { v[j] = op[j]; s += (v[j].x * v[j].x + v[j].y * v[j].y) + (v[j].z * v[j].z + v[j].w * v[j].w); }
        s = red8(s);
        const float rstd = __builtin_amdgcn_rsqf(s * (1.0f / 128.0f) + RMS_EPS);
        const GAS v4u* zp = (const GAS v4u*)(P + (size_t)m * PW + 3072 + lane * 16);
        const v4u z0 = zp[0], z1 = zp[1]; const unsigned zz[8] = {z0.x, z0.y, z0.z, z0.w, z1.x, z1.y, z1.z, z1.w};
        unsigned ow[8];
#pragma unroll
        for (int j = 0; j < 4; ++j) {
            const float za = h2f((h16)(zz[2 * j] & 0xffff)), zb = h2f((h16)(zz[2 * j] >> 16)), zc = h2f((h16)(zz[2 * j + 1] & 0xffff)), zd = h2f((h16)(zz[2 * j + 1] >> 16));
            const f32x4 o = v[j] * rstd * nw[j];
            ow[2 * j] = pkh(o.x * za * sigmoidf_(za), o.y * zb * sigmoidf_(zb)); ow[2 * j + 1] = pkh(o.z * zc * sigmoidf_(zc), o.w * zd * sigmoidf_(zd)); }
        GAS v4u* dst = (GAS v4u*)(omix + (size_t)m * DM + lane * 16);
        dst[0] = (v4u){ow[0], ow[1], ow[2], ow[3]}; dst[1] = (v4u){ow[4], ow[5], ow[6], ow[7]};
    }
}

constexpr int XA_KP = 136, XA_VP = 264;
constexpr int XAL_K = 0, XAL_V = XAL_K + 256 * XA_KP * 2, XAL_END = XAL_V + 128 * XA_VP * 2;
__device__ __forceinline__ void xattn_phase(const Frame& F, const Args& a) {
    const int tid = F.tid, lane = F.lane, w = F.wave, l15 = lane & 15, lg = lane >> 4;
    LAS h16* KL = (LAS h16*)(F.lds + XAL_K); LAS h16* VT = (LAS h16*)(F.lds + XAL_V);
    const h16* KV = (const h16*)(a.ws + WS_KV); const h16* Q = (const h16*)a.out; h16* AO = (h16*)(a.ws + WS_AO);
    for (int pair = F.bid; pair < 256; pair += F.G) {
        const int bhd = pair >> 3, b = bhd >> 2, hd = bhd & 3;
        __syncthreads();
#pragma unroll
        for (int i = 0; i < 8; ++i) { const int id = tid + 512 * i, mem = id & 255, dc = id >> 8;
            const v4u kv = *(const GAS v4u*)(KV + (size_t)(b * 256 + mem) * 1024 + hd * 128 + dc * 8);
            *(LAS v4u*)(KL + mem * XA_KP + dc * 8) = kv;
            const v4u vv = *(const GAS v4u*)(KV + (size_t)(b * 256 + mem) * 1024 + 512 + hd * 128 + dc * 8);
            const unsigned vw[4] = {vv.x, vv.y, vv.z, vv.w};
#pragma unroll
            for (int e = 0; e < 4; ++e) { VT[(dc * 8 + 2 * e) * XA_VP + mem] = (h16)(vw[e] & 0xffff); VT[(dc * 8 + 2 * e + 1) * XA_VP + mem] = (h16)(vw[e] >> 16); } }
        __syncthreads();
        for (int qi = 0; qi < 2; ++qi) {
            const int qb = (pair & 7) * 2 + qi; const size_t tok = (size_t)b * SEQ + qb * 128 + 16 * w + l15;
            h16x8 qf[4];
            { const h16* q0 = Q + tok * 512 + hd * 128 + 8 * lg; const h16* q1 = q0 + (size_t)MTOK * 512;
              const float rstd = __builtin_amdgcn_rsqf(((const float*)(a.ws + WS_CTL + CTL_SS1))[tok] * (1.0f / DM) + RMS_EPS);
#pragma unroll
              for (int ks = 0; ks < 4; ++ks) { const h16x8 a0 = *(const GAS h16x8*)(q0 + 32 * ks), b0 = *(const GAS h16x8*)(q1 + 32 * ks); float sv[8];
#pragma unroll
                  for (int e = 0; e < 8; ++e) sv[e] = ((float)a0[e] + (float)b0[e]) * rstd;
                  const v4u t = {pkh(sv[0], sv[1]), pkh(sv[2], sv[3]), pkh(sv[4], sv[5]), pkh(sv[6], sv[7])}; qf[ks] = __builtin_bit_cast(h16x8, t); } }
            pg8::f32x4 s[16];
#pragma unroll
            for (int mt = 0; mt < 16; ++mt) { s[mt] = (pg8::f32x4){0.f, 0.f, 0.f, 0.f};
#pragma unroll
                for (int ks = 0; ks < 4; ++ks) { const h16x8 kf = *(const LAS h16x8*)(KL + (16 * mt + l15) * XA_KP + 32 * ks + 8 * lg); s[mt] = __builtin_amdgcn_mfma_f32_16x16x32_f16(kf, qf[ks], s[mt], 0, 0, 0); }
                if (mt & 1) __builtin_amdgcn_sched_barrier(0); }
            float mx = -3.0e38f;
#pragma unroll
            for (int mt = 0; mt < 16; ++mt) mx = fmaxf(fmaxf(fmaxf(mx, s[mt][0]), fmaxf(s[mt][1], s[mt][2])), s[mt][3]);
            mx = fmaxf(mx, __shfl_xor(mx, 16)); mx = fmaxf(mx, __shfl_xor(mx, 32));
            const float sc = 0.08838834764831845f * 1.4426950408889634f; float sum = 0.f;
#pragma unroll
            for (int mt = 0; mt < 16; ++mt)
#pragma unroll
                for (int r = 0; r < 4; ++r) { const float p = __builtin_amdgcn_exp2f((s[mt][r] - mx) * sc); s[mt][r] = p; sum += p; }
            sum += __shfl_xor(sum, 16); sum += __shfl_xor(sum, 32);
            const float inv = 1.0f / sum;
            h16x8 pf[8];
#pragma unroll
            for (int ss = 0; ss < 8; ++ss) { v4u t; t.x = pkh(s[2 * ss][0] * inv, s[2 * ss][1] * inv); t.y = pkh(s[2 * ss][2] * inv, s[2 * ss][3] * inv); t.z = pkh(s[2 * ss + 1][0] * inv, s[2 * ss + 1][1] * inv); t.w = pkh(s[2 * ss + 1][2] * inv, s[2 * ss + 1][3] * inv);
                pf[ss] = __builtin_bit_cast(h16x8, t); }
#pragma unroll
            for (int dt = 0; dt < 8; ++dt) { pg8::f32x4 o = {0.f, 0.f, 0.f, 0.f};
#pragma unroll
                for (int ss = 0; ss < 8; ++ss) { const LAS h16* vp = VT + (16 * dt + l15) * XA_VP + 32 * ss + 4 * lg;
                    const v2u lo = *(const LAS v2u*)vp, hi = *(const LAS v2u*)(vp + 16); const v4u t = {lo.x, lo.y, hi.x, hi.y};
                    o = __builtin_amdgcn_mfma_f32_16x16x32_f16(__builtin_bit_cast(h16x8, t), pf[ss], o, 0, 0, 0); }
                v2u ow; ow.x = pkh(o[0], o[1]); ow.y = pkh(o[2], o[3]);
                *(GAS v2u*)(AO + tok * 512 + hd * 128 + 16 * dt + 4 * lg) = ow; __builtin_amdgcn_sched_barrier(0); }
        }
    }
}

__device__ __forceinline__ void final_norm(const Frame& F, const Args& a) {
    const int gw = F.bid * NWAVES + F.wave, NGW = F.G * NWAVES, lane = F.lane;
    const float* ss = (const float*)(a.ws + WS_CTL + CTL_SS3); const h16* H3 = (const h16*)(a.ws + WS_H2);
    f32x4 wv[4][2];
#pragma unroll
    for (int j = 0; j < 4; ++j) { wv[j][0] = *(const GAS f32x4*)(a.in[29] + 512 * j + 8 * lane); wv[j][1] = *(const GAS f32x4*)(a.in[29] + 512 * j + 8 * lane + 4); }
    for (int m = gw; m < MTOK; m += NGW) {
        const float rstd = __builtin_amdgcn_rsqf(ss[m] * (1.0f / DM) + RMS_EPS);
        const GAS h16x8* xr = (const GAS h16x8*)(H3 + (size_t)m * DM) + lane; GAS f32x4* orow = (GAS f32x4*)(a.out + (size_t)m * DM) + 2 * lane;
        h16x8 v[4];
#pragma unroll
        for (int j = 0; j < 4; ++j) v[j] = xr[64 * j];
#pragma unroll
        for (int j = 0; j < 4; ++j) { const f32x4 lo = {(float)v[j][0], (float)v[j][1], (float)v[j][2], (float)v[j][3]}, hi = {(float)v[j][4], (float)v[j][5], (float)v[j][6], (float)v[j][7]};
            orow[128 * j] = lo * rstd * wv[j][0]; orow[128 * j + 1] = hi * rstd * wv[j][1]; }
    }
}
constexpr int N_PHASES = 11;
#ifndef MK_ONE_LAUNCH
#define MK_ONE_LAUNCH 1
#endif
__global__ void __launch_bounds__(NTHREADS, 2) fwd_kernel(Args args) {
    extern __shared__ __attribute__((aligned(16))) unsigned char lds[];
    Frame F; F.lds = (LAS unsigned char*)lds; F.tid = threadIdx.x; F.lane = F.tid & 63; F.wave = __builtin_amdgcn_readfirstlane(F.tid >> 6); F.G = gridDim.x; F.bid = blockIdx.x;
    unsigned char* ws = args.ws;
    const int lo = args.ph_lo, hi = args.ph_hi;
    volatile LAS unsigned* misc = (volatile LAS unsigned*)(F.lds + LDS_MISC);
    if (F.tid < 16) misc[F.tid] = 0u;
    __syncthreads();
    XcdBarrier xbar = xcd_barrier_post((unsigned*)(ws + WS_CTL + CTL_BAR), misc);
#define IN(k) (lo <= (k) && (k) < hi)
#ifndef REPEAT_PH
#define REPEAT_PH -1
#endif
#ifndef REPEAT_N
#define REPEAT_N 1
#endif
#define REP(k) for (int rep_ = 0; rep_ < ((k) == REPEAT_PH ? 1 + REPEAT_N : 1); ++rep_, ((k) == REPEAT_PH && rep_ <= REPEAT_N ? (cg::this_grid().sync(), 0) : 0))
#ifndef CG_SEAM
#define CG_SEAM 2
#endif
#if MK_ONE_LAUNCH
#define SEAM(k) do { if (IN(k) && IN((k) + 1)) { if ((k) == CG_SEAM) cg::this_grid().sync(); else xcd_barrier(xbar); } } while (0)
#else
#define SEAM(k) do { } while (0)
#endif
#ifdef DIAG_A
    unsigned long long* ts = (unsigned long long*)(ws + WS_CTL + 4096);
#define STAMP(i) do { if (F.bid == 0 && F.tid == 0) { ts[i] = __builtin_amdgcn_s_memrealtime(); ts[64 + (i)] = __builtin_amdgcn_s_memtime(); } } while (0)
#else
#define STAMP(i) do { } while (0)
#endif
    STAMP(0);
    float* ss1 = (float*)(ws + WS_CTL + CTL_SS1); float* ss2 = (float*)(ws + WS_CTL + CTL_SS2); float* ss3 = (float*)(ws + WS_CTL + CTL_SS3);
    if (IN(0)) REP(0) { p0_prologue(F, args); } SEAM(0); STAMP(1);
    if (IN(1)) REP(1) { pg8::Gemm g{(const pg8::h16_t*)args.out, (const pg8::h16_t*)(ws + WS_WALL), DM, DM}; pg8::StaticOrder S; S.init(64, 30, F.G, F.bid, 8, 4);
        pg8::EpiF16<0> E{(pg8::h16_t*)(ws + WS_P), PW, nullptr, 0.f, (pg8::h16_t*)(ws + WS_KV), 1024, 64, 30, 0};
        pg8::gemm_phase(F.lds, g, S, E); } SEAM(1); STAMP(2);
    if (IN(2)) REP(2) {
#ifdef DIAG_A
        const unsigned long long tq0 = __builtin_amdgcn_s_memrealtime();
#endif
        if (F.bid < 64) dn_chunked(F, args, F.bid); else if (F.bid < 192) rw_chunked(F, args, F.bid - 64); else if (LATE_W) p0_weights(F, args, 1, (F.bid - 192) * NWAVES + F.wave, 64 * NWAVES);
#ifdef DIAG_A
        if (F.tid == 0 && F.bid == 0) { ts[16] = tq0; ts[17] = __builtin_amdgcn_s_memrealtime(); }
        if (F.tid == 0 && F.bid == 64) { ts[18] = tq0; ts[19] = __builtin_amdgcn_s_memrealtime(); }
        if (F.tid == 0 && F.bid == 192) { ts[20] = tq0; ts[21] = __builtin_amdgcn_s_memrealtime(); }
#endif
        } SEAM(2); STAMP(3); STAMP(4);
    if (IN(4)) REP(4) { pg8::Gemm g{(const pg8::h16_t*)(ws + WS_OMIX), (const pg8::h16_t*)(ws + WS_WOUT), DM, DM}; pg8::StaticOrder S; S.init(64, 8, F.G, F.bid);
        pg8::EpiRes E{args.in[0], nullptr, nullptr, (pg8::h16_t*)(ws + WS_H1), ss1, DM};
        pg8::gemm_phase(F.lds, g, S, E); } SEAM(4); STAMP(5);
    if (IN(5)) REP(5) { pg8::Gemm g{(const pg8::h16_t*)(ws + WS_H1), (const pg8::h16_t*)(ws + WS_WQ), DM / 2, DM}; pg8::StaticOrder S; S.init(64, 2, F.G, F.bid, 0, 0, 2);
        pg8::EpiF16<0> E{(pg8::h16_t*)args.out, 512, nullptr, 0.f, nullptr, 0, 0, 0, (size_t)MTOK * 512};
        pg8::gemm_phase(F.lds, g, S, E); } SEAM(5); STAMP(6);
    if (IN(6)) REP(6) { xattn_phase(F, args); } SEAM(6); STAMP(7);
    if (IN(7)) REP(7) { pg8::Gemm g{(const pg8::h16_t*)(ws + WS_AO), (const pg8::h16_t*)(ws + WS_WO), 512, 512}; pg8::StaticOrder S; S.init(64, 8, F.G, F.bid);
        pg8::EpiRes E{nullptr, (const pg8::h16_t*)(ws + WS_H1), nullptr, (pg8::h16_t*)(ws + WS_H2), ss2, DM};
        pg8::gemm_phase(F.lds, g, S, E); } SEAM(7); STAMP(8);
    if (IN(8)) REP(8) { pg8::Gemm g{(const pg8::h16_t*)(ws + WS_H2), (const pg8::h16_t*)(ws + WS_W1), DM, DM}; pg8::StaticOrder S; S.init(64, 32, F.G, F.bid);
        pg8::EpiF16<1> E{(pg8::h16_t*)(ws + WS_HID), FF, ss2, RMS_EPS, nullptr, 0, 0, 0, 0};
        pg8::gemm_phase(F.lds, g, S, E); } SEAM(8); STAMP(9);
    if (IN(9)) REP(9) { pg8::Gemm g{(const pg8::h16_t*)(ws + WS_HID), (const pg8::h16_t*)(ws + WS_W2), FF, FF}; pg8::StaticOrder S; S.init(64, 8, F.G, F.bid);
        pg8::EpiRes E{nullptr, (const pg8::h16_t*)(ws + WS_H2), nullptr, (pg8::h16_t*)(ws + WS_H2), ss3, DM};
        pg8::gemm_phase(F.lds, g, S, E); } SEAM(9); STAMP(10);
    if (IN(10)) REP(10) { final_norm(F, args); }
#ifdef DIAG_A
    STAMP(11);
    if (F.bid == 0 && F.tid == 0) {
#ifdef DIAG_CLK
        const unsigned long long d = (ts[64 + DIAG_A + 1] - ts[64 + DIAG_A]) / 100ull, t1 = __builtin_amdgcn_s_memrealtime() + d;
#else
        const unsigned long long d = 4ull * (ts[DIAG_A + 1] - ts[DIAG_A]), t1 = __builtin_amdgcn_s_memrealtime() + d;
#endif
        while (__builtin_amdgcn_s_memrealtime() < t1) __builtin_amdgcn_s_sleep(32); }
#endif
#undef IN
#undef SEAM
}

extern "C" void kernel_launch(void* const* d_in, const int* in_sizes, int n_in, void* d_out, int out_size, void* d_ws, size_t ws_size, hipStream_t stream) {
    static int grid = 0;
    if (grid == 0) {
        if (n_in != 30 || out_size != MTOK * DM || ws_size < WS_END) { fprintf(stderr, "kernel_launch: unexpected problem (n_in %d, out %d, ws %zu < %zu)\n", n_in, out_size, ws_size, (size_t)WS_END); grid = -1; return; }
        int dev = 0, cus = 0, per_cu = 0;
        hipGetDevice(&dev); hipDeviceGetAttribute(&cus, hipDeviceAttributeMultiprocessorCount, dev);
        if (hipFuncSetAttribute((const void*)fwd_kernel, hipFuncAttributeMaxDynamicSharedMemorySize, LDS_BYTES) != hipSuccess) { fprintf(stderr, "kernel_launch: hipFuncSetAttribute failed\n"); grid = -1; return; }
        if (hipOccupancyMaxActiveBlocksPerMultiprocessor(&per_cu, (const void*)fwd_kernel, NTHREADS, LDS_BYTES) != hipSuccess || per_cu < 1) { fprintf(stderr, "kernel_launch: occupancy query says %d\n", per_cu); per_cu = 1; }
        (void)hipGetLastError();
        if (cus < 256 || per_cu < 1) { fprintf(stderr, "kernel_launch: needs 256 CUs with one resident workgroup each (cus %d, per_cu %d); nothing launched\n", cus, per_cu); grid = -1; return; }
        grid = 256;
    }
    if (grid < 0) return;
    hipMemsetAsync((char*)d_ws + WS_CTL, 0, CTL_ZERO_BYTES, stream);
    Args a{};
    for (int i = 0; i < 30; ++i) a.in[i] = (const float*)d_in[i];
    a.out = (float*)d_out; a.ws = (unsigned char*)d_ws;
#if MK_ONE_LAUNCH
    a.ph_lo = 0; a.ph_hi = N_PHASES;
    void* kargs[] = {&a};
    hipError_t e = hipLaunchCooperativeKernel((const void*)fwd_kernel, dim3(grid), dim3(NTHREADS), kargs, LDS_BYTES, stream);
    if (e != hipSuccess) fprintf(stderr, "cooperative launch failed: %s (grid %d)\n", hipGetErrorString(e), grid);
#else
    for (int ph = 0; ph < N_PHASES; ++ph) { a.ph_lo = ph; a.ph_hi = ph + 1; hipLaunchKernelGGL(fwd_kernel, dim3(grid), dim3(NTHREADS), LDS_BYTES, stream, a); }
#endif
}
```

```cpp
#include <hip/hip_runtime.h>
#include <hip/hip_cooperative_groups.h>
#include <cstdio>
#include <cstdint>
namespace cg = cooperative_groups;
#define CG_SEAM 1
namespace pg8 {
#define PG8_LAS __attribute__((address_space(3)))
typedef unsigned short h16_t;
typedef _Float16 h16x8 __attribute__((ext_vector_type(8)));
typedef _Float16 h16x2 __attribute__((ext_vector_type(2)));
typedef _Float16 h16x4 __attribute__((ext_vector_type(4)));
typedef float f32x4 __attribute__((ext_vector_type(4)));
typedef float f32x2 __attribute__((ext_vector_type(2)));
typedef unsigned u32x4 __attribute__((ext_vector_type(4)));
typedef unsigned u32x2 __attribute__((ext_vector_type(2)));
constexpr int BM = 256, BK = 64, HALF = 128, HTB = HALF * BK * 2  , STAGE_BYTES = 8 * HTB, NXCD = 8;

__host__ __device__ __forceinline__ int lds_byte(int r, int c) { const int st = (r >> 4) * 2 + (c >> 5), rr = r & 15, cc = c & 31, ob = rr * 64 + cc * 2; return st * 1024 + (ob ^ (((ob >> 9) & 1) << 5)); }
__host__ __device__ __forceinline__ void stage_rc(int b, int& R, int& C) { const int st = b / 1024, sb = b % 1024, swz = sb ^ (((sb >> 9) & 1) << 5); R = (st >> 1) * 16 + swz / 64; C = (st & 1) * 32 + (swz % 64) / 2; }
__host__ __device__ __forceinline__ int perm32(int rho) { const int n = rho >> 4, i = rho & 15; return 8 * (i >> 2) + 4 * n + (i & 3); }

struct Unit { int pm, pn, ks; };
struct Gemm { const h16_t* A; const h16_t* Bt; int K, ld; };

struct StaticOrder {
    static constexpr int SLEEP = 0;
    int nM, nN, nwg, G, c, eM, eN, nK, rev, WGM;
    __device__ void init(int nM_, int nN_, int G_, int c_, int eM_ = 0, int eN_ = 0, int nK_ = 1, int wgm_ = 4, int rev_ = 0) { nM = nM_; nN = nN_; nwg = nM * nN; G = G_; c = c_; eM = eM_; eN = eN_; nK = nK_; WGM = wgm_; rev = rev_; }
    __device__ bool next(int i, Unit& u) const {
        long L = (long)i * G + c; u.ks = 0;
        if (nK > 1) { if (L >= (long)nwg * nK) return false; u.ks = (int)(L / nwg); L -= (long)u.ks * nwg; }
        else if (L >= nwg) { const int e = (int)(L - nwg); if (e >= eM * eN) return false; u.pm = nM + e / eN; u.pn = nN + e % eN; return true; }
        int wgid = (int)L; { const int q = nwg / NXCD, r = nwg % NXCD, xcd = wgid % NXCD, off = wgid / NXCD; wgid = (xcd < r ? xcd * (q + 1) : r * (q + 1) + (xcd - r) * q) + off; }
        const int nig = WGM * nN, gid = wgid / nig, fm = gid * WGM, gsz = (nM - fm) < WGM ? (nM - fm) : WGM;
        u.pm = fm + ((wgid % nig) % gsz); u.pn = (wgid % nig) / gsz; if (rev) u.pm = nM - 1 - u.pm;
        return true;
    }
};

__device__ __forceinline__ unsigned pkh(float lo, float hi) { f32x2 v = {lo, hi}; h16x2 h = __builtin_convertvector(v, h16x2); return __builtin_bit_cast(unsigned, h); }


#ifndef ST_WT
#define ST_WT 0
#endif
template <int ACT> struct EpiF16 {
    static constexpr bool PERM = true;
    h16_t* O; int ldc; const float* rs; float eps; h16_t* O2; int ldc2; int splitM, splitN; size_t part_stride;
    __device__ __forceinline__ void prefetch(const Unit& u, int wr, int fr, float (&pf)[8]) const {
        if (rs) {
#pragma unroll
            for (int g_ = 0; g_ < 8; ++g_) pf[g_] = rs[u.pm * BM + (g_ >> 2) * HALF + wr * 64 + (g_ & 3) * 16 + fr]; }
    }
    __device__ __forceinline__ void operator()(const f32x4 (&acc)[2][2][4][2], const Unit& u, int wr, int wc, int fr, int fq, const float (&pf)[8]) const {
        int pm = u.pm, pn = u.pn; h16_t* base = O + (size_t)u.ks * part_stride; int ld = ldc;
        if (O2 && pm >= splitM) { pm -= splitM; pn -= splitN; base = O2; ld = ldc2; }
        const int row0 = pm * BM + wr * 64 + fr; const int col0 = pn * BM + wc * 32 + 8 * fq;
#if ST_WT
        const __amdgpu_buffer_rsrc_t wrs = __builtin_amdgcn_make_buffer_rsrc((void*)base, (short)0, (int)0x7FFFF000, 0x00020000);
#endif
#pragma unroll
        for (int ai = 0; ai < 2; ++ai)
#pragma unroll
            for (int m = 0; m < 4; ++m) { const int row = row0 + ai * HALF + m * 16; h16_t* rowp = base + (size_t)row * ld + col0;
                float sc = 1.f; if (rs) sc = __builtin_amdgcn_rsqf(pf[ai * 4 + m] * (1.0f / 2048.0f) + eps);
#pragma unroll
                for (int bj = 0; bj < 2; ++bj) { f32x4 v0 = acc[ai][bj][m][0] * sc, v1 = acc[ai][bj][m][1] * sc;
                    if (ACT == 1) { v0 = __builtin_elementwise_max(v0, (f32x4){0.f, 0.f, 0.f, 0.f}); v1 = __builtin_elementwise_max(v1, (f32x4){0.f, 0.f, 0.f, 0.f}); v0 = v0 * v0; v1 = v1 * v1; }
                    u32x4 w; w.x = pkh(v0[0], v0[1]); w.y = pkh(v0[2], v0[3]); w.z = pkh(v1[0], v1[1]); w.w = pkh(v1[2], v1[3]);
#if ST_WT
                    __builtin_amdgcn_raw_buffer_store_b128(w, wrs, (unsigned)(((size_t)row * ld + col0 + bj * HALF) * 2), 0, 17);
#else
                    *(u32x4*)(rowp + bj * HALF) = w;
#endif
                } }
    }
};
struct EpiF32Part {
    static constexpr bool PERM = false;
    float* O; int ldc; size_t part_stride;
    __device__ __forceinline__ void prefetch(const Unit&, int, int, float (&)[8]) const {}
    __device__ __forceinline__ void operator()(const f32x4 (&acc)[2][2][4][2], const Unit& u, int wr, int wc, int fr, int fq, const float (&)[8]) const {
        const int col0 = u.pn * BM + wc * 32 + 4 * fq; float* base = O + (size_t)u.ks * part_stride;
#pragma unroll
        for (int ai = 0; ai < 2; ++ai)
#pragma unroll
            for (int m = 0; m < 4; ++m) { float* rowp = base + (size_t)(u.pm * BM + ai * HALF + wr * 64 + m * 16 + fr) * ldc + col0;
#pragma unroll
                for (int bj = 0; bj < 2; ++bj)
#pragma unroll
                    for (int n = 0; n < 2; ++n) *(f32x4*)(rowp + bj * HALF + n * 16) = acc[ai][bj][m][n]; }
    }
};
struct EpiRes {
    static constexpr bool PERM = true;
    const float* base32; const h16_t* base16; float* out32; h16_t* o16; float* ss; int ldc;
    __device__ __forceinline__ void prefetch(const Unit&, int, int, float (&)[8]) const {}
    __device__ __forceinline__ void operator()(const f32x4 (&acc)[2][2][4][2], const Unit& u, int wr, int wc, int fr, int fq, const float (&)[8]) const {
        const int col0 = u.pn * BM + wc * 32 + 8 * fq;
        const size_t off0 = (size_t)(u.pm * BM + wr * 64 + fr) * ldc + col0;
        f32x4 pre[3][4];
#define ER_LOAD(slot, g_) do { const size_t o_ = off0 + (size_t)(((g_) >> 2) * HALF + ((g_) & 3) * 16) * ldc; _Pragma("unroll") for (int bj_ = 0; bj_ < 2; ++bj_) { const size_t e_ = o_ + bj_ * HALF; \
            if (base16) { const h16x8 h_ = *(const h16x8*)(base16 + e_); pre[slot][2 * bj_] = (f32x4){(float)h_[0], (float)h_[1], (float)h_[2], (float)h_[3]}; pre[slot][2 * bj_ + 1] = (f32x4){(float)h_[4], (float)h_[5], (float)h_[6], (float)h_[7]}; } \
            else { pre[slot][2 * bj_] = *(const f32x4*)(base32 + e_); pre[slot][2 * bj_ + 1] = *(const f32x4*)(base32 + e_ + 4); } } } while (0)
        ER_LOAD(0, 0); ER_LOAD(1, 1);
#pragma unroll
        for (int g_ = 0; g_ < 8; ++g_) { const int ai = g_ >> 2, m = g_ & 3; const int row = u.pm * BM + ai * HALF + wr * 64 + m * 16 + fr; const size_t off = (size_t)row * ldc + col0; float q = 0.f;
            if (g_ + 2 < 8) ER_LOAD((g_ + 2) % 3, g_ + 2);
#pragma unroll
            for (int bj = 0; bj < 2; ++bj) { const f32x4 o0 = pre[g_ % 3][2 * bj] + acc[ai][bj][m][0], o1 = pre[g_ % 3][2 * bj + 1] + acc[ai][bj][m][1];
                if (out32) { *(f32x4*)(out32 + off + bj * HALF) = o0; *(f32x4*)(out32 + off + bj * HALF + 4) = o1; }
                q += (o0[0] * o0[0] + o0[1] * o0[1]) + (o0[2] * o0[2] + o0[3] * o0[3]) + (o1[0] * o1[0] + o1[1] * o1[1]) + (o1[2] * o1[2] + o1[3] * o1[3]);
                if (o16) { u32x4 w; w.x = pkh(o0[0], o0[1]); w.y = pkh(o0[2], o0[3]); w.z = pkh(o1[0], o1[1]); w.w = pkh(o1[2], o1[3]); *(u32x4*)(o16 + off + bj * HALF) = w; } }
            q += __shfl_xor(q, 16); q += __shfl_xor(q, 32);
            if (fq == 0) atomicAdd(ss + row, q); }
#undef ER_LOAD
    }
};

template <class Epi, class Sched>
__device__ __forceinline__ void gemm_phase(PG8_LAS unsigned char* lds, const Gemm g, const Sched& S, const Epi& E) {
    const int tid = threadIdx.x, wid = __builtin_amdgcn_readfirstlane(tid >> 6), lane = tid & 63, wr = wid >> 2, wc = wid & 3, fr = lane & 15, fq = lane >> 4;
    const int K = g.K, nt = K / BK, ld = g.ld;
    unsigned voffA[2], voffB[2];
#pragma unroll
    for (int i = 0; i < 2; ++i) { int R, C; stage_rc(tid * 16 + i * 8192, R, C); const int Rb = Epi::PERM ? ((R & ~31) + perm32(R & 31)) : R;
        voffA[i] = (unsigned)(R * ld + C) * 2u; voffB[i] = (unsigned)(Rb * ld + C) * 2u; }
    const size_t kstep = (size_t)(BK * 2);
    const size_t hstep = (size_t)HALF * ld * 2;
    const size_t tstep = 2 * hstep;
    const unsigned ldsw = (unsigned)wid * 1024u;
    const int aoff = lds_byte(wr * 64 + fr, fq * 8), boff = lds_byte(wc * 32 + fr, fq * 8);
#define PG8_SA(b, h) (((b) * 2 + (h)) * HTB)
#define PG8_SB(b, h) ((4 + (b) * 2 + (h)) * HTB)
#define PG8_STAGE(bufoff, gbase, voff) do { _Pragma("unroll") for (int _i = 0; _i < 2; ++_i) \
        __builtin_amdgcn_global_load_lds((const unsigned*)((const char*)(gbase) + (voff)[_i]), (PG8_LAS unsigned*)(lds + (bufoff) + ldsw + _i * 8192), 16, 0, 0); } while (0)
#define PG8_LDA(dst, b, h) do { _Pragma("unroll") for (int m = 0; m < 4; ++m) _Pragma("unroll") for (int k = 0; k < 2; ++k) dst[m][k] = *(const PG8_LAS h16x8*)(lds + PG8_SA(b, h) + aoff + m * 2048 + k * 1024); } while (0)
#define PG8_LDB(dst, b, h) do { _Pragma("unroll") for (int n = 0; n < 2; ++n) _Pragma("unroll") for (int k = 0; k < 2; ++k) dst[n][k] = *(const PG8_LAS h16x8*)(lds + PG8_SB(b, h) + boff + n * 2048 + k * 1024); } while (0)
#define PG8_MMA(ai, bj, At, Bt) do { __builtin_amdgcn_s_setprio(1); _Pragma("unroll") for (int m = 0; m < 4; ++m) _Pragma("unroll") for (int n = 0; n < 2; ++n) _Pragma("unroll") for (int k = 0; k < 2; ++k) \
        acc[ai][bj][m][n] = __builtin_amdgcn_mfma_f32_16x16x32_f16(Bt[n][k], At[m][k], acc[ai][bj][m][n], 0, 0, 0); __builtin_amdgcn_s_setprio(0); } while (0)
#define PG8_WAIT_V(n) asm volatile("s_waitcnt vmcnt(" #n ")" ::: "memory")
#define PG8_WAIT_L(n) asm volatile("s_waitcnt lgkmcnt(" #n ")" ::: "memory")
#define PG8_BAR __builtin_amdgcn_s_barrier()
#define PG8_SCHED __builtin_amdgcn_sched_barrier(0)
    Unit cur, nxt; int ui = 0;
    if (!S.next(0, cur)) return;
    f32x4 acc[2][2][4][2];
#pragma unroll
    for (int a = 0; a < 2; ++a)
#pragma unroll
        for (int b = 0; b < 2; ++b)
#pragma unroll
            for (int m = 0; m < 4; ++m)
#pragma unroll
                for (int n = 0; n < 2; ++n) acc[a][b][m][n] = (f32x4){0.f, 0.f, 0.f, 0.f};
    h16x8 At[4][2], B0[2][2], B1[2][2];
    float pf[8] = {0.f, 0.f, 0.f, 0.f, 0.f, 0.f, 0.f, 0.f};
    E.prefetch(cur, wr, fr, pf);
    const size_t kslice = (size_t)K * 2;
    const char* cA = (const char*)g.A + (size_t)cur.pm * tstep + cur.ks * kslice; const char* cB = (const char*)g.Bt + (size_t)cur.pn * tstep + cur.ks * kslice;
    PG8_STAGE(PG8_SB(0, 0), cB, voffB); PG8_STAGE(PG8_SB(0, 1), cB + hstep, voffB); PG8_STAGE(PG8_SA(0, 0), cA, voffA); PG8_STAGE(PG8_SA(0, 1), cA + hstep, voffA);
    if (wr == 1) PG8_BAR;
    PG8_WAIT_V(2); PG8_BAR;
    PG8_STAGE(PG8_SB(1, 0), cB + kstep, voffB); PG8_STAGE(PG8_SA(1, 0), cA + kstep, voffA); PG8_STAGE(PG8_SB(1, 1), cB + hstep + kstep, voffB);
    PG8_WAIT_V(6); PG8_BAR;
    for (;;) {
        const bool has_next = S.next(ui + 1, nxt);
        const char* nA = has_next ? (const char*)g.A + (size_t)nxt.pm * tstep + nxt.ks * kslice : cA; const char* nB = has_next ? (const char*)g.Bt + (size_t)nxt.pn * tstep + nxt.ks * kslice : cB;
        for (int t = 0; t < nt; t += 2) {
            if constexpr (Sched::SLEEP > 0) __builtin_amdgcn_s_sleep(Sched::SLEEP);
            const bool last = (t == nt - 2);
            const char* a1 = cA + (size_t)(t + 1) * kstep;
            const char* a2 = last ? nA : cA + (size_t)(t + 2) * kstep; const char* b2 = last ? nB : cB + (size_t)(t + 2) * kstep;
            const char* a3 = a2 + kstep; const char* b3 = b2 + kstep;
            PG8_LDB(B0, 0, 0); PG8_LDB(B1, 0, 1); PG8_SCHED; PG8_LDA(At, 0, 0); PG8_STAGE(PG8_SA(1, 1), a1 + hstep, voffA);
            PG8_WAIT_V(8); PG8_WAIT_L(0); PG8_BAR; PG8_MMA(0, 0, At, B0); PG8_MMA(0, 1, At, B1); PG8_BAR; PG8_SCHED;
            PG8_LDA(At, 0, 1); PG8_STAGE(PG8_SB(0, 0), b2, voffB); PG8_STAGE(PG8_SB(0, 1), b2 + hstep, voffB); PG8_STAGE(PG8_SA(0, 0), a2, voffA);
            PG8_WAIT_V(8); PG8_WAIT_L(0); PG8_BAR; PG8_MMA(1, 0, At, B0); PG8_MMA(1, 1, At, B1); PG8_BAR; PG8_SCHED;
            PG8_LDB(B0, 1, 0); PG8_LDB(B1, 1, 1); PG8_SCHED; PG8_LDA(At, 1, 0); PG8_STAGE(PG8_SA(0, 1), a2 + hstep, voffA);
            PG8_WAIT_V(8); PG8_WAIT_L(0); PG8_BAR; PG8_MMA(0, 0, At, B0); PG8_MMA(0, 1, At, B1); PG8_BAR; PG8_SCHED;
            PG8_LDA(At, 1, 1); PG8_STAGE(PG8_SB(1, 0), b3, voffB); PG8_STAGE(PG8_SB(1, 1), b3 + hstep, voffB); PG8_STAGE(PG8_SA(1, 0), a3, voffA);
            PG8_WAIT_V(8); PG8_WAIT_L(0); PG8_BAR; PG8_MMA(1, 0, At, B0); PG8_MMA(1, 1, At, B1); PG8_BAR; PG8_SCHED;
        }
        if (wr == 0) PG8_BAR;
        E(acc, cur, wr, wc, fr, fq, pf);
        if (!has_next) break;
#pragma unroll
        for (int a = 0; a < 2; ++a)
#pragma unroll
            for (int b = 0; b < 2; ++b)
#pragma unroll
                for (int m = 0; m < 4; ++m)
#pragma unroll
                    for (int n = 0; n < 2; ++n) acc[a][b][m][n] = (f32x4){0.f, 0.f, 0.f, 0.f};
        cur = nxt; cA = nA; cB = nB; ++ui; E.prefetch(cur, wr, fr, pf);
        if (wr == 1) PG8_BAR;
    }
    PG8_WAIT_V(0);
    PG8_BAR;
#undef PG8_SA
#undef PG8_SB
#undef PG8_STAGE
#undef PG8_LDA
#undef PG8_LDB
#undef PG8_MMA
#undef PG8_WAIT_V
#undef PG8_WAIT_L
#undef PG8_BAR
#undef PG8_SCHED
}
}
constexpr int NWAVES = 8, NTHREADS = 512;
constexpr int DM = 2048, BATCH = 8, SEQ = 2048, MTOK = BATCH * SEQ, MEMLEN = 256, MMEM = BATCH * MEMLEN;
constexpr int INC = 7440, PW = 7680;
constexpr int RW0 = 4128;
constexpr int FF = 8192;
constexpr float RMS_EPS = 1e-6f;
constexpr size_t MiB = 1u << 20;
constexpr size_t WS_CTL = 0, CTL_ZERO_BYTES = 1 * MiB;
constexpr size_t CTL_SS1 = 65536, CTL_SS2 = 131072, CTL_SS3 = 196608, CTL_BAR = 262144;
constexpr size_t WS_WALL = 2 * MiB;
constexpr size_t WS_WOUT = 36 * MiB, WS_WQ = 44 * MiB, WS_WO = 46 * MiB, WS_W1 = 48 * MiB, WS_W2 = 80 * MiB;
constexpr size_t WS_LORA = 112 * MiB;
constexpr size_t WS_KV = 113 * MiB;
constexpr size_t WS_Q = 117 * MiB, WS_AO = 133 * MiB;
constexpr size_t WS_C = 150 * MiB;
constexpr size_t WS_P = WS_C;
constexpr size_t WS_OMIX = WS_C + 240 * MiB;
constexpr size_t WS_HID = WS_C;
constexpr size_t WS_H1 = WS_C;
constexpr size_t WS_H2 = WS_C + 256 * MiB;
constexpr size_t WS_END = WS_C + 320 * MiB;

constexpr int LDS_BYTES = 163840, LDS_MISC = LDS_BYTES - 64;

#define GAS __attribute__((address_space(1)))
#define LAS __attribute__((address_space(3)))
typedef unsigned short h16;
typedef float f32x4 __attribute__((ext_vector_type(4)));
typedef float f32x2 __attribute__((ext_vector_type(2)));
typedef unsigned v4u __attribute__((ext_vector_type(4)));
typedef unsigned v2u __attribute__((ext_vector_type(2)));
typedef _Float16 h16x8 __attribute__((ext_vector_type(8)));
typedef _Float16 h16x4 __attribute__((ext_vector_type(4)));
using pg8::pkh;
__device__ __forceinline__ float h2f(h16 v) { return (float)__builtin_bit_cast(_Float16, v); }
__device__ __forceinline__ h16 f2h(float v) { return __builtin_bit_cast(h16, (_Float16)v); }
__device__ __forceinline__ float fexp(float x) { return __builtin_amdgcn_exp2f(x * 1.4426950408889634f); }
__device__ __forceinline__ float sigmoidf_(float x) { return __builtin_amdgcn_rcpf(1.0f + fexp(-x)); }
__device__ __forceinline__ float ftanh(float x) { return 2.0f * sigmoidf_(2.0f * x) - 1.0f; }
__device__ __forceinline__ float softplusf_(float x) { return fmaxf(x, 0.f) + __builtin_amdgcn_logf(1.0f + fexp(-fabsf(x))) * 0.6931471805599453f; }
template <int CTRL> __device__ __forceinline__ float dpp_(float v) { return __builtin_bit_cast(float, __builtin_amdgcn_update_dpp(0, __builtin_bit_cast(int, v), CTRL, 0xf, 0xf, true)); }
__device__ __forceinline__ float red8(float x) { x += dpp_<0xB1>(x); x += dpp_<0x4E>(x); x += dpp_<0x141>(x); return x; }
__device__ __forceinline__ float red16(float x) { x += __shfl_xor(x, 1); x += __shfl_xor(x, 2); x += __shfl_xor(x, 4); x += __shfl_xor(x, 8); return x; }
__device__ __forceinline__ float wave_sum(float v) {
#pragma unroll
    for (int o = 1; o < 64; o <<= 1) v += __shfl_xor(v, o);
    return v;
}

#define XB_TMO      128
#define XB_XCNT(j)  (256  + 64 * (j))
#define XB_XSUB(j)  (1280 + 64 * (j))
#define XB_XGEN(j)  (2304 + 64 * (j))
#define XB_TOP      3328
#define XB_TOPGEN   3392
#define XCD_BAR_WORDS 3456
#define XB_SPIN_CAP (1u << 18)

__device__ __forceinline__ unsigned xb_ld(unsigned* p)              { return __hip_atomic_load(p, __ATOMIC_RELAXED, __HIP_MEMORY_SCOPE_AGENT); }
__device__ __forceinline__ unsigned xb_add(unsigned* p, unsigned v) { return __hip_atomic_fetch_add(p, v, __ATOMIC_RELAXED, __HIP_MEMORY_SCOPE_AGENT); }
__device__ __forceinline__ unsigned xb_xcc_id() { return (unsigned)__builtin_amdgcn_s_getreg((3 << 11) | 20) & 0xFu; }
#define XB_SPIN(cond, bar) do { unsigned _sp = 0; while (cond) { __builtin_amdgcn_s_sleep(1); \
    if ((++_sp & 255u) == 0u) { if (xb_ld(&(bar)[XB_TMO])) break; if (_sp > XB_SPIN_CAP) { atomicAdd(&(bar)[XB_TMO], 1u); break; } } } } while (0)

struct XcdBarrier {
    unsigned* bar; unsigned x;
    volatile LAS unsigned* st;
};

#ifndef DEFER
#define DEFER 2
#endif
#ifndef ROLE_XCD
#define ROLE_XCD 1
#endif
#ifndef FLOW
#define FLOW 0
#endif
constexpr size_t CTL_DEF = CTL_BAR + 16384;
constexpr unsigned DEF_TILES = 30;
__device__ __forceinline__ void defer_wait(unsigned char* ws, int b) {
    if (threadIdx.x == 0) { unsigned* bar = (unsigned*)(ws + WS_CTL + CTL_BAR); unsigned* cnt = (unsigned*)(ws + WS_CTL + CTL_DEF) + 64 * b;
        XB_SPIN(xb_ld(cnt) < DEF_TILES, bar);
        __builtin_amdgcn_fence(__ATOMIC_ACQUIRE, "agent"); asm volatile("s_waitcnt vmcnt(0)" ::: "memory"); }
    __syncthreads();
}
constexpr size_t CTL_FLOW = CTL_DEF + 8 * 256;
__device__ __forceinline__ void flow_signal(unsigned char* ws, int which) {
    asm volatile("s_waitcnt vmcnt(0)" ::: "memory");
    __syncthreads();
    if (threadIdx.x == 0) { __builtin_amdgcn_fence(__ATOMIC_RELEASE, "agent"); asm volatile("s_waitcnt vmcnt(0)" ::: "memory"); (void)xb_add((unsigned*)(ws + WS_CTL + CTL_FLOW) + 64 * which, 1u); }
}
__device__ __forceinline__ void flow_wait(unsigned char* ws, int which) {
    if (threadIdx.x == 0) { unsigned* bar = (unsigned*)(ws + WS_CTL + CTL_BAR); unsigned* cnt = (unsigned*)(ws + WS_CTL + CTL_FLOW) + 64 * which;
        XB_SPIN(xb_ld(cnt) < 256u, bar);
        __builtin_amdgcn_fence(__ATOMIC_ACQUIRE, "agent"); asm volatile("s_waitcnt vmcnt(0)" ::: "memory"); }
    __syncthreads();
}
__device__ __forceinline__ XcdBarrier xcd_barrier_post(unsigned* bar, volatile LAS unsigned* st) {
    XcdBarrier b; b.bar = bar; b.x = xb_xcc_id(); b.st = st;
    if (threadIdx.x == 0) (void)xb_add(&bar[XB_XCNT(b.x)], 1u);
    return b;
}
__device__ __forceinline__ void xcd_barrier_complete(unsigned* bar, unsigned x, unsigned& nloc, unsigned& nx) {
    const unsigned G = gridDim.x * gridDim.y * gridDim.z;
    unsigned sum, cnt, mine, sp = 0u;
    for (;;) {
        sum = 0u; cnt = 0u; mine = 0u;
#pragma unroll
        for (unsigned j = 0; j < 16; ++j) { const unsigned c = xb_ld(&bar[XB_XCNT(j)]); sum += c; cnt += (c > 0u) ? 1u : 0u; mine = (j == x) ? c : mine; }
        if (sum == G) break;
        __builtin_amdgcn_s_sleep(1);
        if ((++sp & 255u) == 0u) { if (xb_ld(&bar[XB_TMO])) break; if (sp > XB_SPIN_CAP) { atomicAdd(&bar[XB_TMO], 1u); break; } }
    }
    nloc = mine > 0u ? mine : 1u; nx = cnt > 0u ? cnt : 1u;
}

__device__ __forceinline__ void xcd_barrier(const XcdBarrier& b) {
    asm volatile("s_waitcnt vmcnt(0)" ::: "memory");
    __syncthreads();
    if (threadIdx.x == 0) {
        unsigned* bar = b.bar;
        __builtin_amdgcn_s_waitcnt(0);
        unsigned nloc = b.st[0], nx = b.st[1];
        if (nloc == 0u) { xcd_barrier_complete(bar, b.x, nloc, nx); b.st[0] = nloc; b.st[1] = nx; }
        const unsigned old = xb_add(&bar[XB_XSUB(b.x)], 1u);
        const unsigned gen = old / nloc;
        if (old + 1u == (gen + 1u) * nloc) {
            __builtin_amdgcn_fence(__ATOMIC_RELEASE, "agent");
            asm volatile("s_waitcnt vmcnt(0)" ::: "memory");
            const unsigned og = xb_add(&bar[XB_TOP], 1u);
            const unsigned tg = og / nx;
            if (og + 1u == (tg + 1u) * nx) xb_add(&bar[XB_TOPGEN], 1u);
            else XB_SPIN(xb_ld(&bar[XB_TOPGEN]) == tg, bar);
            __builtin_amdgcn_fence(__ATOMIC_ACQUIRE, "agent");
            xb_add(&bar[XB_XGEN(b.x)], 1u);
            asm volatile("s_waitcnt vmcnt(0)" ::: "memory");
        } else {
            XB_SPIN(xb_ld(&bar[XB_XGEN(b.x)]) == gen, bar);
            __builtin_amdgcn_fence(__ATOMIC_ACQUIRE, "agent");
            asm volatile("s_waitcnt vmcnt(0)" ::: "memory");
        }
    }
    __syncthreads();
}

#ifndef LATE_W
#define LATE_W 1
#endif
#define LBAR() do { asm volatile("s_waitcnt lgkmcnt(0)" ::: "memory"); __builtin_amdgcn_s_barrier(); asm volatile("" ::: "memory"); } while (0)
struct Args {
    const float* in[30]; float* out; unsigned char* ws; int ph_lo, ph_hi;
};
struct Frame {
    LAS unsigned char* lds; int tid, lane, wave, G, bid;
};

struct TrItem { const float* W; const float* ksc; h16* WT; int N, K, k0, ns, nv, nd; };
__device__ __forceinline__ void tr_load(const TrItem& P, f32x4 (&v)[8], int lane) {
    const int j4 = lane & 7, kq = lane >> 3;
#pragma unroll
    for (int i = 0; i < 8; ++i) { v[i] = (f32x4){0.f, 0.f, 0.f, 0.f}; if (4 * j4 < P.nv) v[i] = __builtin_nontemporal_load((const GAS f32x4*)(P.W + (size_t)(P.k0 + kq + 8 * i) * P.N + P.ns + 4 * j4)); }
}
__device__ __forceinline__ void tr_finish(const TrItem& P, f32x4 (&v)[8], LAS float* scr, int lane) {
    const int j4 = lane & 7, kq = lane >> 3;
    if (P.ksc) {
#pragma unroll
        for (int i = 0; i < 8; ++i) v[i] = v[i] * P.ksc[P.k0 + kq + 8 * i]; }
#pragma unroll
    for (int i = 0; i < 8; ++i) { LAS float* d = scr + (kq + 8 * i) * 33 + 4 * j4; d[0] = v[i].x; d[1] = v[i].y; d[2] = v[i].z; d[3] = v[i].w; }
    asm volatile("s_waitcnt lgkmcnt(0)" ::: "memory");
    const int c = lane & 7;
#pragma unroll
    for (int jj = 0; jj < 4; ++jj) { const int n = (lane >> 3) + 8 * jj; const LAS float* s = scr + (8 * c) * 33 + n;
        v4u o; o.x = pkh(s[0 * 33], s[1 * 33]); o.y = pkh(s[2 * 33], s[3 * 33]); o.z = pkh(s[4 * 33], s[5 * 33]); o.w = pkh(s[6 * 33], s[7 * 33]);
        *(GAS v4u*)(P.WT + (size_t)(P.nd + n) * P.K + P.k0 + 8 * c) = o; }
    asm volatile("s_waitcnt lgkmcnt(0)" ::: "memory");
}
__device__ __forceinline__ void rms_row_to_f16(const float* xrow, const float* w, h16* orow, int lane) {
    const GAS f32x4* xr = (const GAS f32x4*)xrow + lane; const GAS f32x4* wr = (const GAS f32x4*)w + lane;
    f32x4 v[8]; float s = 0.f;
#pragma unroll
    for (int j = 0; j < 8; ++j) { v[j] = xr[64 * j]; s += (v[j].x * v[j].x + v[j].y * v[j].y) + (v[j].z * v[j].z + v[j].w * v[j].w); }
    const float rstd = __builtin_amdgcn_rsqf(wave_sum(s) * (1.f / DM) + RMS_EPS);
    GAS v2u* o8 = (GAS v2u*)orow + lane;
#pragma unroll
    for (int j = 0; j < 8; ++j) { const f32x4 ww = wr[64 * j]; v2u o; o.x = pkh(v[j].x * rstd * ww.x, v[j].y * rstd * ww.y); o.y = pkh(v[j].z * rstd * ww.z, v[j].w * rstd * ww.w);
#if P0_NTST
                __builtin_nontemporal_store(o, o8 + 64 * j);
#else
                o8[64 * j] = o;
#endif
            }
}
__device__ __forceinline__ void p0_weights(const Frame& F, const Args& a, int part, int gw, int NGW) {
    LAS float* scr = (LAS float*)(F.lds + F.wave * 16384);
    unsigned char* ws = a.ws; const int lane = F.lane;
    constexpr int I_IN = 240 * 32, I_K = 16 * 32, I_V = 16 * 32, I_LW = 32, I_LA = 32, I_LG = 64, I_OUT = 64 * 32, I_Q = 16 * 32, I_O = 64 * 8, I_1 = 256 * 32, I_2 = 64 * 128;
    constexpr int N_EARLY = I_IN + I_K + I_V + I_LW + I_LA + I_LG, N_LATE = I_OUT + I_Q + I_O + I_1 + I_2;
    h16* wall = (h16*)(ws + WS_WALL);
    const int nitems = part ? N_LATE : N_EARLY;
    auto decode = [&](int it, TrItem& P) {
        int r = it; P.ksc = nullptr; P.nv = 32;
        if (part == 0) {
            if (r < I_IN) { const int nb = r % 240, kb = r / 240;
                if (nb < 128) { P.ns = 32 * nb; } else if (nb == 128) { P.ns = 4096; P.nv = 16; } else if (nb < 233) { P.ns = 4112 + 32 * (nb - 129); } else { P.ns = 0; P.nv = 0; }
                P.W = a.in[3]; P.N = INC; P.K = DM; P.WT = wall; P.k0 = 64 * kb; P.nd = 32 * nb; }
            else if ((r -= I_IN) < I_K) { P.W = a.in[23]; P.N = 512; P.K = DM; P.WT = wall; P.k0 = 64 * (r / 16); P.ns = 32 * (r % 16); P.nd = 7680 + P.ns; }
            else if ((r -= I_K) < I_V) { P.W = a.in[24]; P.N = 512; P.K = DM; P.WT = wall; P.k0 = 64 * (r / 16); P.ns = 32 * (r % 16); P.nd = 8192 + P.ns; }
            else if ((r -= I_V) < I_LW) { P.W = a.in[10]; P.N = 1024; P.K = 64; P.WT = (h16*)(ws + WS_LORA); P.k0 = 0; P.ns = 32 * r; P.nd = P.ns; }
            else if ((r -= I_LW) < I_LA) { P.W = a.in[12]; P.N = 1024; P.K = 64; P.WT = (h16*)(ws + WS_LORA + 131072); P.k0 = 0; P.ns = 32 * r; P.nd = P.ns; }
            else { r -= I_LA; P.W = a.in[13]; P.N = 1024; P.K = 128; P.WT = (h16*)(ws + WS_LORA + 262144); P.k0 = 64 * (r / 32); P.ns = 32 * (r % 32); P.nd = P.ns; }
        } else {
            if (r < I_OUT) { P.W = a.in[19]; P.N = DM; P.K = DM; P.WT = (h16*)(ws + WS_WOUT); P.k0 = 64 * (r / 64); P.ns = 32 * (r % 64); P.nd = P.ns; }
            else if ((r -= I_OUT) < I_Q) { P.W = a.in[22]; P.N = 512; P.K = DM; P.WT = (h16*)(ws + WS_WQ); P.ksc = a.in[20]; P.k0 = 64 * (r / 16); P.ns = 32 * (r % 16); P.nd = P.ns; }
            else if ((r -= I_Q) < I_O) { P.W = a.in[25]; P.N = DM; P.K = 512; P.WT = (h16*)(ws + WS_WO); P.k0 = 64 * (r / 64); P.ns = 32 * (r % 64); P.nd = P.ns; }
            else if ((r -= I_O) < I_1) { P.W = a.in[27]; P.N = FF; P.K = DM; P.WT = (h16*)(ws + WS_W1); P.ksc = a.in[26]; P.k0 = 64 * (r / 256); P.ns = 32 * (r % 256); P.nd = P.ns; }
            else { r -= I_1; P.W = a.in[28]; P.N = DM; P.K = FF; P.WT = (h16*)(ws + WS_W2); P.k0 = 64 * (r / 64); P.ns = 32 * (r % 64); P.nd = P.ns; }
        } };
    if (gw < nitems) {
        TrItem Pc, Pn; f32x4 vc[8], vn[8]; decode(gw, Pc); tr_load(Pc, vc, lane);
        for (int it = gw; it < nitems; it += NGW) { const bool more = it + NGW < nitems;
            if (more) { decode(it + NGW, Pn); tr_load(Pn, vn, lane); }
            tr_finish(Pc, vc, scr, lane);
            if (more) { Pc = Pn;
#pragma unroll
                for (int i = 0; i < 8; ++i) vc[i] = vn[i]; } } }
}
__device__ __forceinline__ void p0_rows(const Frame& F, const Args& a, int gw, int NGW) {
    const int lane = F.lane;
    h16* aall = (h16*)a.out;
#ifndef ROWREP
#define ROWREP 1
#endif
#pragma unroll 1
    for (int rr_ = 0; rr_ < ROWREP; ++rr_)
    {
#if FLOW
        auto phys = [&](int q) -> int { return q < MMEM ? MTOK + q : ((q - MMEM) & 7) * SEQ + (SEQ - 1 - ((q - MMEM) >> 3)); };
#else
        auto phys = [&](int q) -> int { return q; };
#endif
        auto rowp = [&](int q) -> const float* { const int m = phys(q); return m < MTOK ? a.in[0] + (size_t)m * DM : a.in[1] + (size_t)(m - MTOK) * DM; };
        int m = gw; f32x4 v[8], nv[8];
        if (m < MTOK + MMEM) { const GAS f32x4* xr = (const GAS f32x4*)rowp(m) + lane;
#pragma unroll
            for (int j = 0; j < 8; ++j) v[j] = __builtin_nontemporal_load(xr + 64 * j); }
        for (; m < MTOK + MMEM; m += NGW) { const int mn = m + NGW;
            if (mn < MTOK + MMEM) { const GAS f32x4* xr = (const GAS f32x4*)rowp(mn) + lane;
#pragma unroll
                for (int j = 0; j < 8; ++j) nv[j] = __builtin_nontemporal_load(xr + 64 * j); }
            float s = 0.f;
#pragma unroll
            for (int j = 0; j < 8; ++j) s += (v[j].x * v[j].x + v[j].y * v[j].y) + (v[j].z * v[j].z + v[j].w * v[j].w);
            const float rstd = __builtin_amdgcn_rsqf(wave_sum(s) * (1.f / DM) + RMS_EPS);
            const int pm_ = phys(m);
            const GAS f32x4* wr = (const GAS f32x4*)(pm_ < MTOK ? a.in[2] : a.in[21]) + lane; GAS v2u* o8 = (GAS v2u*)(aall + (size_t)pm_ * DM) + lane;
#pragma unroll
            for (int j = 0; j < 8; ++j) { const f32x4 ww = wr[64 * j]; v2u o; o.x = pkh(v[j].x * rstd * ww.x, v[j].y * rstd * ww.y); o.y = pkh(v[j].z * rstd * ww.z, v[j].w * rstd * ww.w); o8[64 * j] = o; }
#pragma unroll
            for (int j = 0; j < 8; ++j) v[j] = nv[j]; } }
}
__device__ __forceinline__ void p0_prologue(const Frame& F, const Args& a) {
    const int gw = F.bid * NWAVES + F.wave, NGW = F.G * NWAVES;
    if (F.wave & 1) { p0_weights(F, a, 0, gw, NGW); if (!LATE_W) p0_weights(F, a, 1, gw, NGW); p0_rows(F, a, gw, NGW); }
    else { p0_rows(F, a, gw, NGW); p0_weights(F, a, 0, gw, NGW); if (!LATE_W) p0_weights(F, a, 1, gw, NGW); }
}
constexpr int DC_P = 136;
constexpr int DCL_RAWQ = 0, DCL_RAWK = DCL_RAWQ + 64 * DC_P * 2, DCL_VV = DCL_RAWK + 64 * DC_P * 2, DCL_QH = DCL_VV + 64 * DC_P * 2, DCL_KH = DCL_QH + 64 * DC_P * 2, DCL_KBH = DCL_KH + 64 * DC_P * 2,
              DCL_KDT = DCL_KBH + 64 * DC_P * 2, DCL_ATT = DCL_KDT + 4 * 128 * 16 * 2 + 1024, DCL_AMT = DCL_ATT + 64 * 24 * 2, DCL_SM = DCL_AMT + 4 * 16 * 20 * 4, DCL_END = DCL_SM + 2048;
constexpr int DCL_QG = DCL_RAWQ, DCL_XW = DCL_QH  , DCL_OS = DCL_VV;
static_assert(64 * 264 * 2 <= 2 * 64 * DC_P * 2 && DCL_END <= LDS_BYTES, "DN LDS map");
#define TIDX(row, tok) ((row) * 16 + ((row) >> 3) * 8 + (tok))
#ifndef DN_PF_EARLY
#define DN_PF_EARLY 0
#endif
__device__ __forceinline__ void dn_chunked(const Frame& F, const Args& a, int unit) {
    const int b = unit >> 3, h = unit & 7;
    const int tid = F.tid, lane = F.lane, w = F.wave, l15 = lane & 15, lg = lane >> 4;
    LAS h16* RAWQ = (LAS h16*)(F.lds + DCL_RAWQ); LAS h16* RAWK = (LAS h16*)(F.lds + DCL_RAWK); LAS h16* VV = (LAS h16*)(F.lds + DCL_VV);
    LAS h16* QH = (LAS h16*)(F.lds + DCL_QH); LAS h16* KH = (LAS h16*)(F.lds + DCL_KH); LAS h16* KBH = (LAS h16*)(F.lds + DCL_KBH);
    LAS h16* KDT = (LAS h16*)(F.lds + DCL_KDT); LAS h16* ATT = (LAS h16*)(F.lds + DCL_ATT); LAS float* AMT = (LAS float*)(F.lds + DCL_AMT);
    LAS float* gS = (LAS float*)(F.lds + DCL_SM); LAS float* betaS = gS + 64; LAS float* egcS = gS + 128; LAS float* eclS = gS + 192; LAS float* gcS = gS + 256; LAS float* nwS = gS + 320;
    LAS h16* QG = (LAS h16*)(F.lds + DCL_QG); LAS h16* XW = (LAS h16*)(F.lds + DCL_XW); LAS h16* OS = (LAS h16*)(F.lds + DCL_OS);
    const h16* P = (const h16*)(a.ws + WS_P); h16* omix = (h16*)(a.ws + WS_OMIX);
    const size_t row0 = (size_t)b * SEQ;
    const bool roleA = tid < 384, is_g = (tid >= 384 && tid < 448);
    const int jB = tid - 384, cp = roleA ? tid % 192 : jB, rg = tid / 192, cp2 = 128 + (jB >> 1);
    const int pcol = (cp >> 6) * 1024 + h * 128 + 2 * (cp & 63), pcol2 = (cp2 >> 6) * 1024 + h * 128 + 2 * (cp2 & 63);
    f32x2 cw0, cw1, cw2, cw3; { const float* cw = a.in[4]; cw0 = *(const f32x2*)(cw + pcol); cw1 = *(const f32x2*)(cw + 3072 + pcol); cw2 = *(const f32x2*)(cw + 6144 + pcol); cw3 = *(const f32x2*)(cw + 9216 + pcol); }
    const float neg_ea = -fexp(a.in[5][h]), dtb = a.in[6][h];
    const int pt = tid >> 3, pp = tid & 7;
    unsigned raw[30]; h16 rg0 = 0, rg1 = 0;
    pg8::f32x4 S[8];
#pragma unroll
    for (int i = 0; i < 8; ++i) S[i] = (pg8::f32x4){0.f, 0.f, 0.f, 0.f};
    const __amdgpu_buffer_rsrc_t prs = __builtin_amdgcn_make_buffer_rsrc((void*)(P - 3 * PW), (short)0, (MTOK + 3) * PW * 2, 0x00020000);
#define DC_LOAD_RAW(t0_) do { if (roleA) { const int tb = (t0_) + 24 * rg; const unsigned vo = (unsigned)((row0 + tb) * PW + pcol) * 2u; \
            _Pragma("unroll") for (int i = 0; i < 27; ++i) { const unsigned v = __builtin_amdgcn_raw_buffer_load_b32(prs, vo, i * PW * 2, 0); raw[i] = (tb + i >= 3) ? v : 0u; } } \
        else { const unsigned vo = (unsigned)((row0 + (t0_) + 48) * PW + pcol) * 2u, vo2 = (unsigned)((row0 + (t0_) + 48 + 8 * (jB & 1)) * PW + pcol2) * 2u; \
            _Pragma("unroll") for (int i = 0; i < 19; ++i) raw[i] = __builtin_amdgcn_raw_buffer_load_b32(prs, vo, i * PW * 2, 0); \
            _Pragma("unroll") for (int i = 0; i < 11; ++i) raw[19 + i] = __builtin_amdgcn_raw_buffer_load_b32(prs, vo2, i * PW * 2, 0); \
            if (is_g) { const int t = (t0_) + (tid - 384); rg0 = P[(row0 + t) * PW + 4096 + h]; rg1 = P[(row0 + t) * PW + 4104 + h]; } } } while (0)
#define DC_S1_ROWS(NT, RB, DST, W0, W1, W2, W3) do { _Pragma("unroll") for (int t = 0; t < (NT); ++t) { f32x2 y = {0.f, 0.f}; \
            _Pragma("unroll") for (int j = 0; j < 4; ++j) { const unsigned rw = raw[(RB) + t + j]; const f32x2 x = {h2f((h16)(rw & 0xffff)), h2f((h16)(rw >> 16))}; y += (j == 0 ? (W0) : j == 1 ? (W1) : j == 2 ? (W2) : (W3)) * x; } \
            { f32x2 e = y * (-1.4426950408889634f); e.x = __builtin_amdgcn_exp2f(e.x); e.y = __builtin_amdgcn_exp2f(e.y); e = e + 1.0f; e.x = __builtin_amdgcn_rcpf(e.x); e.y = __builtin_amdgcn_rcpf(e.y); y = y * e; } \
            *(LAS unsigned*)((DST) + t * DC_P) = pkh(y.x, y.y); if ((t & 7) == 7) __builtin_amdgcn_sched_barrier(0); } } while (0)
    if (tid < 128) nwS[tid] = a.in[7][tid];
    v4u zpre0 = {0u, 0u, 0u, 0u}, zpre1 = zpre0;
#define DC_LOAD_Z(t0_) do { const GAS v4u* zp = (const GAS v4u*)(P + (row0 + (t0_) + pt) * PW + 3072 + h * 128 + 16 * pp); zpre0 = zp[0]; zpre1 = zp[1]; } while (0)
#ifdef DIAG_STG
    unsigned long long stg_t[8] = {0, 0, 0, 0, 0, 0, 0, 0}, stg_last = __builtin_amdgcn_s_memrealtime();
#define STG(i) do { const unsigned long long n_ = __builtin_amdgcn_s_memrealtime(); stg_t[i] += n_ - stg_last; stg_last = n_; } while (0)
#else
#define STG(i) do { } while (0)
#endif
    DC_LOAD_RAW(0); DC_LOAD_Z(0);
    for (int bt = 0; bt < SEQ / 64; ++bt) {
        const int t0 = bt * 64;
        if (roleA) { LAS h16* dst = (cp < 64 ? RAWQ : (cp < 128 ? RAWK : VV)) + 2 * (cp & 63) + 24 * rg * DC_P;
            DC_S1_ROWS(24, 0, dst, cw0, cw1, cw2, cw3);
        } else { LAS h16* dst = (cp < 64 ? RAWQ : RAWK) + 2 * (cp & 63) + 48 * DC_P;
            DC_S1_ROWS(16, 0, dst, cw0, cw1, cw2, cw3);
            const float* cw = a.in[4]; const f32x2 v0 = *(const f32x2*)(cw + pcol2), v1 = *(const f32x2*)(cw + 3072 + pcol2), v2 = *(const f32x2*)(cw + 6144 + pcol2), v3 = *(const f32x2*)(cw + 9216 + pcol2);
            LAS h16* dst2 = VV + 2 * (cp2 & 63) + (48 + 8 * (jB & 1)) * DC_P;
            DC_S1_ROWS(8, 19, dst2, v0, v1, v2, v3);
            if (is_g) { const int t = tid - 384; gS[t] = neg_ea * softplusf_(h2f(rg0) + dtb); betaS[t] = sigmoidf_(h2f(rg1)); } }
        LBAR(); STG(0);
        { const int t = pt, c16 = t & ~15; float gc = 0.f, gl = 0.f;
            for (int i = 0; i < 16; ++i) { const float gv = gS[c16 + i]; gl += gv; if (c16 + i <= t) gc += gv; }
            const float egc = fexp(gc), ekd = fexp(gl - gc), beta = betaS[t];
            if (pp == 0) { egcS[t] = egc; gcS[t] = gc; if ((t & 15) == 15) eclS[t >> 4] = fexp(gl); }
            const LAS h16* qp = RAWQ + t * DC_P + 16 * pp; const LAS h16* kp = RAWK + t * DC_P + 16 * pp;
            const h16x8 q0 = *(const LAS h16x8*)qp, q1 = *(const LAS h16x8*)(qp + 8), k0 = *(const LAS h16x8*)kp, k1 = *(const LAS h16x8*)(kp + 8);
            float qf[16], kf[16]; float sq = 0.f, sk = 0.f;
#pragma unroll
            for (int i = 0; i < 8; ++i) { qf[i] = (float)q0[i]; qf[8 + i] = (float)q1[i]; kf[i] = (float)k0[i]; kf[8 + i] = (float)k1[i]; }
#pragma unroll
            for (int i = 0; i < 16; ++i) { sq += qf[i] * qf[i]; sk += kf[i] * kf[i]; }
            sq = red8(sq); sk = red8(sk);
            const float rq = __builtin_amdgcn_rsqf(sq + 1e-6f) * 0.08838834764831845f, rk = __builtin_amdgcn_rsqf(sk + 1e-6f);
            unsigned oq[8], og[8], ok[8], ob[8];
#pragma unroll
            for (int i = 0; i < 8; ++i) { const float qa = qf[2 * i] * rq, qb = qf[2 * i + 1] * rq, ka = kf[2 * i] * rk, kb = kf[2 * i + 1] * rk;
                oq[i] = pkh(qa, qb); og[i] = pkh(qa * egc, qb * egc); ok[i] = pkh(ka, kb); ob[i] = pkh(ka * beta, kb * beta);
                KDT[TIDX((t >> 4) * 128 + 16 * pp + 2 * i, t & 15)] = f2h(ka * ekd); KDT[TIDX((t >> 4) * 128 + 16 * pp + 2 * i + 1, t & 15)] = f2h(kb * ekd); }
            *(LAS v4u*)(QH + t * DC_P + 16 * pp) = (v4u){oq[0], oq[1], oq[2], oq[3]}; *(LAS v4u*)(QH + t * DC_P + 16 * pp + 8) = (v4u){oq[4], oq[5], oq[6], oq[7]};
            *(LAS v4u*)(QG + t * DC_P + 16 * pp) = (v4u){og[0], og[1], og[2], og[3]}; *(LAS v4u*)(QG + t * DC_P + 16 * pp + 8) = (v4u){og[4], og[5], og[6], og[7]};
            *(LAS v4u*)(KH + t * DC_P + 16 * pp) = (v4u){ok[0], ok[1], ok[2], ok[3]}; *(LAS v4u*)(KH + t * DC_P + 16 * pp + 8) = (v4u){ok[4], ok[5], ok[6], ok[7]};
            *(LAS v4u*)(KBH + t * DC_P + 16 * pp) = (v4u){ob[0], ob[1], ob[2], ob[3]}; *(LAS v4u*)(KBH + t * DC_P + 16 * pp + 8) = (v4u){ob[4], ob[5], ob[6], ob[7]}; }
        LBAR(); STG(1);
        { const int c = w & 3, which = w >> 2; const LAS h16* Am = (which ? QH : KBH) + (16 * c + l15) * DC_P + 8 * lg; const LAS h16* Bm = KH + (16 * c + l15) * DC_P + 8 * lg;
            pg8::f32x4 acc = {0.f, 0.f, 0.f, 0.f};
#pragma unroll
            for (int ks = 0; ks < 4; ++ks) acc = __builtin_amdgcn_mfma_f32_16x16x32_f16(*(const LAS h16x8*)(Am + 32 * ks), *(const LAS h16x8*)(Bm + 32 * ks), acc, 0, 0, 0);
            const float gj = gcS[16 * c + l15];
#pragma unroll
            for (int r = 0; r < 4; ++r) { const int i = 4 * lg + r, j = l15; const float dec = fexp(gcS[16 * c + i] - gj);
                if (which) ATT[(16 * c + i) * 24 + j] = f2h(i >= j ? acc[r] * dec : 0.f); else AMT[(c * 16 + j) * 20 + i] = (i > j ? acc[r] * dec : 0.f); } }
        LBAR(); STG(2);
#if DN_PF_EARLY
#if FLOW
        if (bt == 15) flow_wait(a.ws, 1);
#endif
#if DEFER && DEFER != 3
        if (bt == 27) defer_wait(a.ws, (int)(row0 / SEQ));
#endif
        if (bt + 1 < SEQ / 64) DC_LOAD_RAW(t0 + 64);
#endif
        { const int c = tid >> 7, cp = tid & 127, col = 2 * cp; f32x2 x[16];
            { const LAS h16* src = col < 128 ? VV + 16 * c * DC_P + col : KBH + 16 * c * DC_P + col - 128; const LAS float* scs = (col < 128 ? betaS : egcS) + 16 * c;
#pragma unroll
              for (int i = 0; i < 16; ++i) { const unsigned rv = *(const LAS unsigned*)(src + i * DC_P); x[i] = (f32x2){h2f((h16)(rv & 0xffff)), h2f((h16)(rv >> 16))} * scs[i]; } }
#pragma unroll
            for (int j = 0; j < 15; ++j) { const LAS f32x4* ap4 = (const LAS f32x4*)(AMT + (c * 16 + j) * 20); float ap[16];
#pragma unroll
                for (int q = (j + 1) / 4; q < 4; ++q) { const f32x4 v = ap4[q]; ap[4 * q] = v.x; ap[4 * q + 1] = v.y; ap[4 * q + 2] = v.z; ap[4 * q + 3] = v.w; }
#pragma unroll
                for (int i = j + 1; i < 16; ++i) x[i] -= x[j] * ap[i]; }
#pragma unroll
            for (int i = 0; i < 16; ++i) *(LAS unsigned*)(XW + (16 * c + i) * 264 + col) = pkh(x[i].x, x[i].y); }
        LBAR(); STG(3);
#if !DN_PF_EARLY
#if FLOW
        if (bt == 15) flow_wait(a.ws, 1);
#endif
#if DEFER && DEFER != 3
        if (bt == 27) defer_wait(a.ws, (int)(row0 / SEQ));
#endif
        if (bt + 1 < SEQ / 64) DC_LOAD_RAW(t0 + 64);
#endif
#pragma unroll 1
        for (int c = 0; c < 4; ++c) { const int T0 = 16 * c;
            h16x8 sf[4];
#pragma unroll
            for (int s = 0; s < 4; ++s) { const v4u t = {pkh(S[2 * s][0], S[2 * s][1]), pkh(S[2 * s][2], S[2 * s][3]), pkh(S[2 * s + 1][0], S[2 * s + 1][1]), pkh(S[2 * s + 1][2], S[2 * s + 1][3])}; sf[s] = __builtin_bit_cast(h16x8, t); }
            pg8::f32x4 av = {0.f, 0.f, 0.f, 0.f}, ao = av;
#pragma unroll
            for (int s = 0; s < 4; ++s) { const LAS h16* wp = XW + (T0 + l15) * 264 + 128 + 32 * s + 4 * lg; const v2u lo = *(const LAS v2u*)wp, hi = *(const LAS v2u*)(wp + 16);
                av = __builtin_amdgcn_mfma_f32_16x16x32_f16(__builtin_bit_cast(h16x8, (v4u){lo.x, lo.y, hi.x, hi.y}), sf[s], av, 0, 0, 0);
                const LAS h16* qp = QG + (T0 + l15) * DC_P + 32 * s + 4 * lg; const v2u ql = *(const LAS v2u*)qp, qh = *(const LAS v2u*)(qp + 16);
                ao = __builtin_amdgcn_mfma_f32_16x16x32_f16(__builtin_bit_cast(h16x8, (v4u){ql.x, ql.y, qh.x, qh.y}), sf[s], ao, 0, 0, 0); }
            float vn[4];
#pragma unroll
            for (int r = 0; r < 4; ++r) vn[r] = h2f(XW[(T0 + 4 * lg + r) * 264 + 16 * w + l15]) - av[r];
            const h16x8 vf = __builtin_bit_cast(h16x8, (v4u){pkh(vn[0], vn[1]), pkh(vn[2], vn[3]), 0u, 0u});
            { const v2u al = *(const LAS v2u*)(ATT + (T0 + l15) * 24 + 4 * lg); ao = __builtin_amdgcn_mfma_f32_16x16x32_f16(__builtin_bit_cast(h16x8, (v4u){al.x, al.y, 0u, 0u}), vf, ao, 0, 0, 0); }
            const float ecl = eclS[c];
#pragma unroll
            for (int tau = 0; tau < 8; ++tau) { const v2u kl = *(const LAS v2u*)(KDT + TIDX(c * 128 + 16 * tau + l15, 4 * lg));
                S[tau] = __builtin_amdgcn_mfma_f32_16x16x32_f16(__builtin_bit_cast(h16x8, (v4u){kl.x, kl.y, 0u, 0u}), vf, S[tau] * ecl, 0, 0, 0); }
#pragma unroll
            for (int r = 0; r < 4; ++r) OS[(T0 + 4 * lg + r) * DC_P + 16 * w + l15] = f2h(ao[r]);
        }
        LBAR(); STG(4);
        { const LAS h16* op = OS + pt * DC_P + 16 * pp; const h16x8 o0 = *(const LAS h16x8*)op, o1 = *(const LAS h16x8*)(op + 8);
            const v4u z0 = zpre0, z1 = zpre1;
            f32x4 nw[4];
#pragma unroll
            for (int j = 0; j < 4; ++j) nw[j] = *(const LAS f32x4*)(nwS + 16 * pp + 4 * j);
            float of[16]; float s = 0.f;
#pragma unroll
            for (int i = 0; i < 8; ++i) { of[i] = (float)o0[i]; of[8 + i] = (float)o1[i]; }
#pragma unroll
            for (int i = 0; i < 16; ++i) s += of[i] * of[i];
            s = red8(s); const float rstd = __builtin_amdgcn_rsqf(s * (1.0f / 128.0f) + RMS_EPS);
            const unsigned zz[8] = {z0.x, z0.y, z0.z, z0.w, z1.x, z1.y, z1.z, z1.w}; unsigned ow[8];
#pragma unroll
            for (int i = 0; i < 8; ++i) { const float za = h2f((h16)(zz[i] & 0xffff)), zb = h2f((h16)(zz[i] >> 16)); const float wa = nw[i >> 1][(2 * i) & 3], wb = nw[i >> 1][(2 * i + 1) & 3];
                ow[i] = pkh(of[2 * i] * rstd * wa * za * sigmoidf_(za), of[2 * i + 1] * rstd * wb * zb * sigmoidf_(zb)); }
            GAS v4u* dst = (GAS v4u*)(omix + (row0 + t0 + pt) * DM + h * 128 + 16 * pp);
            dst[0] = (v4u){ow[0], ow[1], ow[2], ow[3]}; dst[1] = (v4u){ow[4], ow[5], ow[6], ow[7]}; }
        if (bt + 1 < SEQ / 64) DC_LOAD_Z(t0 + 64);
        LBAR(); STG(5);
    }
#ifdef DIAG_STG
    if (tid == 0 && unit == 0) { unsigned long long* tsq = (unsigned long long*)(a.ws + WS_CTL + 4096); unsigned long long c_ = 0; tsq[48] = 0;
#pragma unroll
        for (int i = 0; i < 6; ++i) { c_ += stg_t[i]; tsq[49 + i] = c_; } }
#endif
#undef STG
#undef DC_LOAD_Z
#undef DC_LOAD_RAW
#undef DC_S1_ROWS
}
constexpr int RC_FP = 68, RC_F = RC_FP * 64 * 4, RC_H = 72 * 64 * 2;
constexpr int RCL_RL = 0, RCL_PKL = RCL_RL + RC_F, RCL_GL = RCL_PKL + RC_F, RCL_ALR = RCL_GL + RC_F, RCL_GATE = RCL_ALR + RC_F, RCL_VH = RCL_GATE + RC_F, RCL_HW = RCL_VH + RC_H, RCL_HA = RCL_HW + RC_H,
              RCL_HG = RCL_HA + RC_H, RCL_BR = RCL_HG + 64 * 136 * 2 + 256, RCL_KR = RCL_BR + RC_H, RCL_KHT = RCL_KR + RC_H, RCL_WC = RCL_KHT + 8192 + 256, RCL_BON = RCL_WC + 1024, RCL_CST = RCL_BON + 256, RCL_END = RCL_CST + 7 * 256;
constexpr int RCL_LT = RCL_RL, RCL_RHS2 = RCL_LT + 5120, RCL_MRB = RCL_RHS2 + 5120, RCL_MRK = RCL_MRB + 3072;
constexpr int RCL_WP = RCL_PKL, RCL_TL = RCL_WP + RC_H;
constexpr int RCL_YL = RCL_GL, RCL_ATF = RCL_ALR, RCL_AR = RCL_HW, RCL_RT = RCL_HA, RCL_RR = RCL_HG, RCL_BHT = RCL_HG + RC_H;
static_assert(RCL_MRK + 3072 <= RCL_PKL && RCL_TL + 3072 <= RCL_GL && RCL_BHT + 8192 + 256 <= RCL_BR && RCL_END <= LDS_MISC, "RW LDS map");
#define TIDX16(row, tok) ((row) * 16 + ((row) >> 4) * 8 + (tok))
__device__ __forceinline__ void rw_chunked(const Frame& F, const Args& a, int unit) {
    const int b = unit >> 4, h = unit & 15;
    const int tid0 = F.tid, w = F.wave;
    LAS float* RL = (LAS float*)(F.lds + RCL_RL); LAS float* PKL = (LAS float*)(F.lds + RCL_PKL); LAS float* GL = (LAS float*)(F.lds + RCL_GL); LAS float* ALR = (LAS float*)(F.lds + RCL_ALR);
    LAS float* GATE = (LAS float*)(F.lds + RCL_GATE); LAS h16* VH = (LAS h16*)(F.lds + RCL_VH); LAS h16* HW = (LAS h16*)(F.lds + RCL_HW); LAS h16* HA = (LAS h16*)(F.lds + RCL_HA); LAS h16* HG = (LAS h16*)(F.lds + RCL_HG);
    LAS h16* BR = (LAS h16*)(F.lds + RCL_BR); LAS h16* KR = (LAS h16*)(F.lds + RCL_KR); LAS h16* KHT = (LAS h16*)(F.lds + RCL_KHT); LAS float* WC = (LAS float*)(F.lds + RCL_WC); LAS float* BON = (LAS float*)(F.lds + RCL_BON);
    LAS float* LT = (LAS float*)(F.lds + RCL_LT); LAS float* RHS2 = (LAS float*)(F.lds + RCL_RHS2); LAS h16* MRB = (LAS h16*)(F.lds + RCL_MRB); LAS h16* MRK = (LAS h16*)(F.lds + RCL_MRK);
    LAS h16* WP = (LAS h16*)(F.lds + RCL_WP); LAS h16* TL = (LAS h16*)(F.lds + RCL_TL); LAS float* YL = (LAS float*)(F.lds + RCL_YL); LAS float* ATF = (LAS float*)(F.lds + RCL_ATF);
    LAS h16* AR = (LAS h16*)(F.lds + RCL_AR); LAS h16* RT = (LAS h16*)(F.lds + RCL_RT); LAS h16* RR = (LAS h16*)(F.lds + RCL_RR); LAS h16* BHT = (LAS h16*)(F.lds + RCL_BHT);
    const h16* P = (const h16*)(a.ws + WS_P); h16* omix = (h16*)(a.ws + WS_OMIX);
    const size_t row0 = (size_t)b * SEQ;
    const bool is_col = tid0 < 448; const int cp = tid0 % 224, rgp = tid0 / 224;
    int rcol = 0; f32x2 mu = {0.f, 0.f};
    if (is_col) { rcol = cp < 96 ? (cp >> 5) * 1024 + h * 64 + 2 * (cp & 31) : 3072 + 2 * (cp - 96); mu = *(const f32x2*)(a.in[8] + rcol); }
    int kind = 0, dstb = 0, dstride = RC_FP * 4;
    if (cp < 32) { dstb = RCL_RL + 8 * cp; } else if (cp < 64) { dstb = RCL_PKL + 8 * (cp - 32); } else if (cp < 96) { kind = 1; dstb = RCL_VH + 4 * (cp - 64); dstride = 144; }
    else if (cp < 128) { kind = 2; dstb = RCL_HW + 4 * (cp - 96); dstride = 144; } else if (cp < 160) { kind = 1; dstb = RCL_HA + 4 * (cp - 128); dstride = 144; } else { kind = 3; dstb = RCL_HG + 4 * (cp - 160); dstride = 272; }
    const __amdgpu_buffer_rsrc_t prs = __builtin_amdgcn_make_buffer_rsrc((void*)(P - PW), (short)0, (MTOK + 1) * PW * 2, 0x00020000);
    unsigned raw[33];
#define RC_LOAD_RAW(t0_) do { if (is_col) { const int tb = (t0_) + 32 * rgp; const unsigned vo = (unsigned)((row0 + tb) * PW + RW0 + rcol) * 2u; \
            _Pragma("unroll") for (int i = 0; i < 33; ++i) { const unsigned v = __builtin_amdgcn_raw_buffer_load_b32(prs, vo, i * PW * 2, 0); raw[i] = (tb + i >= 1) ? v : 0u; } } } while (0)
    pg8::f32x4 St[4];
#pragma unroll
    for (int i = 0; i < 4; ++i) St[i] = (pg8::f32x4){0.f, 0.f, 0.f, 0.f};
    h16x8 bq[4];
    { const int n = h * 64 + 16 * (w & 3) + (F.lane & 15), lg0 = F.lane >> 4;
        if (w < 4) { const h16* w2T = (const h16*)(a.ws + WS_LORA) + (size_t)n * 64 + 8 * lg0; const h16* a2T = (const h16*)(a.ws + WS_LORA + 131072) + (size_t)n * 64 + 8 * lg0;
            bq[0] = *(const GAS h16x8*)w2T; bq[1] = *(const GAS h16x8*)(w2T + 32); bq[2] = *(const GAS h16x8*)a2T; bq[3] = *(const GAS h16x8*)(a2T + 32); }
        else { const h16* g2T = (const h16*)(a.ws + WS_LORA + 262144) + (size_t)n * 128 + 8 * lg0;
#pragma unroll
            for (int ks = 0; ks < 4; ++ks) bq[ks] = *(const GAS h16x8*)(g2T + 32 * ks); } }
    LAS float* CST = (LAS float*)(F.lds + RCL_CST);
    if (tid0 < 448) { const int q = tid0 >> 6, n = tid0 & 63; const int src[7] = {14, 15, 16, 17, 18, 9, 11}; CST[q * 64 + n] = a.in[src[q]][h * 64 + n]; }
#ifdef DIAG_STG
    unsigned long long stg_t[10] = {0, 0, 0, 0, 0, 0, 0, 0, 0, 0}, stg_last = __builtin_amdgcn_s_memrealtime();
#define STG(i) do { const unsigned long long n_ = __builtin_amdgcn_s_memrealtime(); stg_t[i] += n_ - stg_last; stg_last = n_; } while (0)
#else
#define STG(i) do { } while (0)
#endif
    RC_LOAD_RAW(0);
    for (int bt = 0; bt < SEQ / 64; ++bt) {
        const int t0 = bt * 64;
        int tid = tid0; asm volatile("" : "+v"(tid));
        const int lane = tid & 63, l15 = lane & 15, lg = lane >> 4, ft = tid >> 3, fp = tid & 7, hc0 = h * 64 + 8 * fp;
#ifndef S1REP
#define S1REP 1
#endif
#ifdef S1UNROLL
#pragma unroll
#else
#pragma unroll 1
#endif
        for (int rep_ = 0; rep_ < S1REP; ++rep_)
        if (is_col) { unsigned ad = (unsigned)(dstb + 32 * rgp * dstride); asm volatile("" : "+v"(ad));
            if (kind == 0) {
#pragma unroll
                for (int t = 0; t < 32; ++t) { const unsigned rw = raw[t + 1], rp = raw[t]; const f32x2 x = {h2f((h16)(rw & 0xffff)), h2f((h16)(rw >> 16))}, xp = {h2f((h16)(rp & 0xffff)), h2f((h16)(rp >> 16))};
                    *(LAS f32x2*)(F.lds + ad) = x + (xp - x) * mu; ad += RC_FP * 4; if ((t & 7) == 7) __builtin_amdgcn_sched_barrier(0); }
            } else {
#pragma unroll
                for (int t = 0; t < 32; ++t) { const unsigned rw = raw[t + 1], rp = raw[t]; const f32x2 x = {h2f((h16)(rw & 0xffff)), h2f((h16)(rw >> 16))}, xp = {h2f((h16)(rp & 0xffff)), h2f((h16)(rp >> 16))};
                    const f32x2 y = x + (xp - x) * mu; *(LAS unsigned*)(F.lds + ad) = pkh(y.x, y.y); ad += dstride; if ((t & 7) == 7) __builtin_amdgcn_sched_barrier(0); }
            }
        }
        LBAR(); STG(0);
#pragma unroll 2
        for (int i = tid; i < 64 * 32; i += NTHREADS) { LAS unsigned* p = (LAS unsigned*)(HW + (i >> 5) * 72 + 2 * (i & 31)); const unsigned v = *p; *p = pkh(ftanh(h2f((h16)(v & 0xffff))), ftanh(h2f((h16)(v >> 16)))); }
#pragma unroll 2
        for (int i = tid; i < 64 * 64; i += NTHREADS) { LAS unsigned* p = (LAS unsigned*)(HG + (i >> 6) * 136 + 2 * (i & 63)); const unsigned v = *p; *p = pkh(sigmoidf_(h2f((h16)(v & 0xffff))), sigmoidf_(h2f((h16)(v >> 16)))); }
        LBAR();
        { const int nt = w & 3, n = 16 * nt + l15;
            if (w < 4) { const float c_w0 = CST[320 + n], c_a0 = CST[384 + n];
#pragma unroll
                for (int mt = 0; mt < 4; ++mt) { pg8::f32x4 accw = {0.f, 0.f, 0.f, 0.f}, acca = accw;
#pragma unroll
                    for (int ks = 0; ks < 2; ++ks) { accw = __builtin_amdgcn_mfma_f32_16x16x32_f16(*(const LAS h16x8*)(HW + (16 * mt + l15) * 72 + 32 * ks + 8 * lg), bq[ks], accw, 0, 0, 0);
                        acca = __builtin_amdgcn_mfma_f32_16x16x32_f16(*(const LAS h16x8*)(HA + (16 * mt + l15) * 72 + 32 * ks + 8 * lg), bq[2 + ks], acca, 0, 0, 0); }
                    float ld[4];
#pragma unroll
                    for (int r = 0; r < 4; ++r) ld[r] = -0.6065306597126334f * sigmoidf_(c_w0 + accw[r]);
                    ld[1] += ld[0]; ld[2] += ld[1]; ld[3] += ld[2];
                    { const float tot = ld[3]; const float t1 = __shfl_up(tot, 16), t2 = __shfl_up(tot, 32), t3 = __shfl_up(tot, 48);
                      const float off = (lg >= 1 ? t1 : 0.f) + (lg >= 2 ? t2 : 0.f) + (lg >= 3 ? t3 : 0.f);
#pragma unroll
                      for (int r = 0; r < 4; ++r) { const int tok = 16 * mt + 4 * lg + r; GL[tok * RC_FP + n] = ld[r] + off; ALR[tok * RC_FP + n] = sigmoidf_(c_a0 + acca[r]); } } }
            } else {
#pragma unroll
                for (int mt = 0; mt < 4; ++mt) { pg8::f32x4 accg = {0.f, 0.f, 0.f, 0.f};
#pragma unroll
                    for (int ks = 0; ks < 4; ++ks) accg = __builtin_amdgcn_mfma_f32_16x16x32_f16(*(const LAS h16x8*)(HG + (16 * mt + l15) * 136 + 32 * ks + 8 * lg), bq[ks], accg, 0, 0, 0);
#pragma unroll
                    for (int r = 0; r < 4; ++r) GATE[(16 * mt + 4 * lg + r) * RC_FP + n] = accg[r]; } } }
        LBAR(); STG(1);
        { const int t = ft, c16 = t & ~15, tl = t & 15, c = t >> 4;
            const f32x4 ckk0 = *(const LAS f32x4*)(CST + 8 * fp), ckk1 = *(const LAS f32x4*)(CST + 8 * fp + 4), cka0 = *(const LAS f32x4*)(CST + 64 + 8 * fp), cka1 = *(const LAS f32x4*)(CST + 64 + 8 * fp + 4),
                        crk0 = *(const LAS f32x4*)(CST + 128 + 8 * fp), crk1 = *(const LAS f32x4*)(CST + 128 + 8 * fp + 4);
            const float ckk[8] = {ckk0.x, ckk0.y, ckk0.z, ckk0.w, ckk1.x, ckk1.y, ckk1.z, ckk1.w}, cka[8] = {cka0.x, cka0.y, cka0.z, cka0.w, cka1.x, cka1.y, cka1.z, cka1.w}, crk[8] = {crk0.x, crk0.y, crk0.z, crk0.w, crk1.x, crk1.y, crk1.z, crk1.w};
            float pk[8], rr[8], al[8], kk[8], kf[8], bb[8], gt[8], gp[8], gl[8], gr[8]; float ss = 0.f, bon = 0.f;
#pragma unroll
            for (int q = 0; q < 2; ++q) { const int o = t * RC_FP + 8 * fp + 4 * q;
                const f32x4 a_ = *(const LAS f32x4*)(PKL + o), b_ = *(const LAS f32x4*)(RL + o), c_ = *(const LAS f32x4*)(ALR + o), g0 = *(const LAS f32x4*)(GL + o),
                            g2 = *(const LAS f32x4*)(GL + (c16 + 15) * RC_FP + 8 * fp + 4 * q), g3 = *(const LAS f32x4*)(GL + (c16 + 7) * RC_FP + 8 * fp + 4 * q);
                f32x4 g1 = {0.f, 0.f, 0.f, 0.f}; if (tl) g1 = *(const LAS f32x4*)(GL + o - RC_FP);
#pragma unroll
                for (int e = 0; e < 4; ++e) { pk[4 * q + e] = a_[e]; rr[4 * q + e] = b_[e]; al[4 * q + e] = c_[e]; gt[4 * q + e] = g0[e]; gp[4 * q + e] = g1[e]; gl[4 * q + e] = g2[e]; gr[4 * q + e] = g3[e]; } }
#pragma unroll
            for (int i = 0; i < 8; ++i) { kk[i] = pk[i] * ckk[i]; ss += kk[i] * kk[i]; }
            ss = red8(ss); const float inv = 1.0f / fmaxf(__builtin_amdgcn_sqrtf(ss), 1e-12f);
#pragma unroll
            for (int i = 0; i < 8; ++i) { kk[i] *= inv; kf[i] = pk[i] * (1.0f + (al[i] - 1.0f) * cka[i]); bb[i] = kk[i] * al[i]; bon += rr[i] * kf[i] * crk[i]; }
            bon = red8(bon); if (fp == 0) BON[t] = bon;
            unsigned oar[4], ort[4], orr[4], obr[4], okr[4]; float atf[8];
            LAS h16* bhw = BHT + TIDX16(c * 64 + 8 * fp, tl); LAS h16* khw = KHT + TIDX16(c * 64 + 8 * fp, tl);
#pragma unroll
            for (int i = 0; i < 8; i += 2) { float va[2], vr[2], vrr[2], vb[2], vk[2];
#pragma unroll
                for (int e = 0; e < 2; ++e) { const float Gt = gt[i + e], Gp = gp[i + e], Gl = gl[i + e], Gr = gr[i + e];
                    const float ap = -kk[i + e];
                    atf[i + e] = ap * fexp(Gp); va[e] = ap * fexp(Gp - Gr); vr[e] = rr[i + e] * fexp(Gt); vrr[e] = rr[i + e] * fexp(Gt - Gr);
                    const float er = fexp(Gr - Gt), el = fexp(Gl - Gt); vb[e] = bb[i + e] * er; vk[e] = kf[i + e] * er;
                    bhw[(i + e) * 16] = f2h(bb[i + e] * el); khw[(i + e) * 16] = f2h(kf[i + e] * el); }
                oar[i >> 1] = pkh(va[0], va[1]); ort[i >> 1] = pkh(vr[0], vr[1]); orr[i >> 1] = pkh(vrr[0], vrr[1]); obr[i >> 1] = pkh(vb[0], vb[1]); okr[i >> 1] = pkh(vk[0], vk[1]); }
            *(LAS f32x4*)(ATF + t * RC_FP + 8 * fp) = (f32x4){atf[0], atf[1], atf[2], atf[3]}; *(LAS f32x4*)(ATF + t * RC_FP + 8 * fp + 4) = (f32x4){atf[4], atf[5], atf[6], atf[7]};
            if (tl == 15) { *(LAS f32x4*)(WC + c * 64 + 8 * fp) = (f32x4){fexp(gl[0]), fexp(gl[1]), fexp(gl[2]), fexp(gl[3])}; *(LAS f32x4*)(WC + c * 64 + 8 * fp + 4) = (f32x4){fexp(gl[4]), fexp(gl[5]), fexp(gl[6]), fexp(gl[7])}; }
            *(LAS v4u*)(AR + t * 72 + 8 * fp) = (v4u){oar[0], oar[1], oar[2], oar[3]}; *(LAS v4u*)(RT + t * 72 + 8 * fp) = (v4u){ort[0], ort[1], ort[2], ort[3]};
            *(LAS v4u*)(RR + t * 72 + 8 * fp) = (v4u){orr[0], orr[1], orr[2], orr[3]}; *(LAS v4u*)(BR + t * 72 + 8 * fp) = (v4u){obr[0], obr[1], obr[2], obr[3]};
            *(LAS v4u*)(KR + t * 72 + 8 * fp) = (v4u){okr[0], okr[1], okr[2], okr[3]}; }
        LBAR(); STG(3);
        { const int c = w & 3, rt = w >> 2; const LAS h16* Am = (rt ? RR : AR) + (16 * c + l15) * 72 + 8 * lg;
#pragma unroll
            for (int ct = 0; ct < 2; ++ct) { const LAS h16* Bm = (ct ? KR : BR) + (16 * c + l15) * 72 + 8 * lg; pg8::f32x4 acc = {0.f, 0.f, 0.f, 0.f};
#pragma unroll
                for (int ks = 0; ks < 2; ++ks) acc = __builtin_amdgcn_mfma_f32_16x16x32_f16(*(const LAS h16x8*)(Am + 32 * ks), *(const LAS h16x8*)(Bm + 32 * ks), acc, 0, 0, 0);
#pragma unroll
                for (int r = 0; r < 4; ++r) { const int t = 4 * lg + r, i = l15;
                    if (rt == 0) { const float v = t > i ? acc[r] : 0.f; if (ct == 0) LT[(c * 16 + i) * 20 + t] = v; else RHS2[(c * 16 + t) * 20 + i] = v; }
                    else { const h16 v = f2h(t >= i ? acc[r] : 0.f); if (ct == 0) MRB[(16 * c + t) * 24 + i] = v; else MRK[(16 * c + t) * 24 + i] = v; } } } }
        LBAR(); STG(4);
        if (tid < 320) { const int c = tid / 80, col = tid % 80; float x[16];
            const LAS float* src = col < 64 ? ATF + 16 * c * RC_FP + col : RHS2 + c * 16 * 20 + col - 64; const int sstr = col < 64 ? RC_FP : 20;
#pragma unroll
            for (int i = 0; i < 16; ++i) x[i] = src[i * sstr];
#pragma unroll
            for (int j = 0; j < 15; ++j) { const LAS f32x4* lp4 = (const LAS f32x4*)(LT + (c * 16 + j) * 20); float lp[16];
#pragma unroll
                for (int q = (j + 1) / 4; q < 4; ++q) { const f32x4 v = lp4[q]; lp[4 * q] = v.x; lp[4 * q + 1] = v.y; lp[4 * q + 2] = v.z; lp[4 * q + 3] = v.w; }
#pragma unroll
                for (int i = j + 1; i < 16; ++i) x[i] += lp[i] * x[j]; }
            LAS h16* dst = col < 64 ? WP + 16 * c * 72 + col : TL + 16 * c * 24 + col - 64; const int dstr = col < 64 ? 72 : 24;
#pragma unroll
            for (int i = 0; i < 16; ++i) dst[i * dstr] = f2h(x[i]); }
        LBAR(); STG(5);
#if DEFER && DEFER != 3
        if (bt == 27) defer_wait(a.ws, b);
#endif
        if (bt + 1 < SEQ / 64) RC_LOAD_RAW(t0 + 64);
        if (w < 4) {
#pragma unroll 1
            for (int c = 0; c < 4; ++c) { const int T0 = 16 * c;
                h16x8 sf[2];
#pragma unroll
                for (int s = 0; s < 2; ++s) { const v4u t = {pkh(St[2 * s][0], St[2 * s][1]), pkh(St[2 * s][2], St[2 * s][3]), pkh(St[2 * s + 1][0], St[2 * s + 1][1]), pkh(St[2 * s + 1][2], St[2 * s + 1][3])}; sf[s] = __builtin_bit_cast(h16x8, t); }
                float vv[4];
#pragma unroll
                for (int r = 0; r < 4; ++r) vv[r] = h2f(VH[(T0 + 4 * lg + r) * 72 + 16 * w + l15]);
                const h16x8 vf = __builtin_bit_cast(h16x8, (v4u){pkh(vv[0], vv[1]), pkh(vv[2], vv[3]), 0u, 0u});
                pg8::f32x4 U = {0.f, 0.f, 0.f, 0.f}, Y = U;
#pragma unroll
                for (int s = 0; s < 2; ++s) { const LAS h16* wp = WP + (T0 + l15) * 72 + 32 * s + 4 * lg; const v2u lo = *(const LAS v2u*)wp, hi = *(const LAS v2u*)(wp + 16);
                    U = __builtin_amdgcn_mfma_f32_16x16x32_f16(__builtin_bit_cast(h16x8, (v4u){lo.x, lo.y, hi.x, hi.y}), sf[s], U, 0, 0, 0);
                    const LAS h16* rp = RT + (T0 + l15) * 72 + 32 * s + 4 * lg; const v2u rl = *(const LAS v2u*)rp, rh = *(const LAS v2u*)(rp + 16);
                    Y = __builtin_amdgcn_mfma_f32_16x16x32_f16(__builtin_bit_cast(h16x8, (v4u){rl.x, rl.y, rh.x, rh.y}), sf[s], Y, 0, 0, 0); }
                { const v2u tl = *(const LAS v2u*)(TL + (T0 + l15) * 24 + 4 * lg); U = __builtin_amdgcn_mfma_f32_16x16x32_f16(__builtin_bit_cast(h16x8, (v4u){tl.x, tl.y, 0u, 0u}), vf, U, 0, 0, 0); }
                const h16x8 uf = __builtin_bit_cast(h16x8, (v4u){pkh(U[0], U[1]), pkh(U[2], U[3]), 0u, 0u});
                { const v2u mb = *(const LAS v2u*)(MRB + (T0 + l15) * 24 + 4 * lg), mk = *(const LAS v2u*)(MRK + (T0 + l15) * 24 + 4 * lg);
                    Y = __builtin_amdgcn_mfma_f32_16x16x32_f16(__builtin_bit_cast(h16x8, (v4u){mb.x, mb.y, 0u, 0u}), uf, Y, 0, 0, 0);
                    Y = __builtin_amdgcn_mfma_f32_16x16x32_f16(__builtin_bit_cast(h16x8, (v4u){mk.x, mk.y, 0u, 0u}), vf, Y, 0, 0, 0); }
#pragma unroll
                for (int r = 0; r < 4; ++r) YL[(T0 + 4 * lg + r) * RC_FP + 16 * w + l15] = Y[r];
#pragma unroll
                for (int tau = 0; tau < 4; ++tau) { const f32x4 wc = *(const LAS f32x4*)(WC + c * 64 + 16 * tau + 4 * lg);
                    const v2u bl = *(const LAS v2u*)(BHT + (c * 4 + tau) * 264 + l15 * 16 + 4 * lg), kl = *(const LAS v2u*)(KHT + (c * 4 + tau) * 264 + l15 * 16 + 4 * lg);
                    pg8::f32x4 sacc = {St[tau][0] * wc.x, St[tau][1] * wc.y, St[tau][2] * wc.z, St[tau][3] * wc.w};
                    sacc = __builtin_amdgcn_mfma_f32_16x16x32_f16(__builtin_bit_cast(h16x8, (v4u){bl.x, bl.y, 0u, 0u}), uf, sacc, 0, 0, 0);
                    St[tau] = __builtin_amdgcn_mfma_f32_16x16x32_f16(__builtin_bit_cast(h16x8, (v4u){kl.x, kl.y, 0u, 0u}), vf, sacc, 0, 0, 0); }
            }
        }
        LBAR(); STG(6);
        { const int t = ft; float y[8]; float s = 0.f;
#pragma unroll
            for (int q = 0; q < 2; ++q) { const f32x4 yv = *(const LAS f32x4*)(YL + t * RC_FP + 8 * fp + 4 * q);
#pragma unroll
                for (int e = 0; e < 4; ++e) { y[4 * q + e] = yv[e]; s += yv[e]; } }
            const float mean = red8(s) * (1.0f / 64.0f); float q = 0.f;
#pragma unroll
            for (int i = 0; i < 8; ++i) { y[i] -= mean; q += y[i] * y[i]; }
            const float rstd = __builtin_amdgcn_rsqf(red8(q) * (1.0f / 64.0f) + 64e-5f), bon = BON[t];
            const f32x4 lw0 = *(const LAS f32x4*)(CST + 192 + 8 * fp), lw1 = *(const LAS f32x4*)(CST + 192 + 8 * fp + 4), lb0 = *(const LAS f32x4*)(CST + 256 + 8 * fp), lb1 = *(const LAS f32x4*)(CST + 256 + 8 * fp + 4);
            const float lw[8] = {lw0.x, lw0.y, lw0.z, lw0.w, lw1.x, lw1.y, lw1.z, lw1.w}, lb[8] = {lb0.x, lb0.y, lb0.z, lb0.w, lb1.x, lb1.y, lb1.z, lb1.w};
            const h16x8 v8 = *(const LAS h16x8*)(VH + t * 72 + 8 * fp); float res[8];
            const f32x4 gq0 = *(const LAS f32x4*)(GATE + t * RC_FP + 8 * fp), gq1 = *(const LAS f32x4*)(GATE + t * RC_FP + 8 * fp + 4); const float gq[8] = {gq0.x, gq0.y, gq0.z, gq0.w, gq1.x, gq1.y, gq1.z, gq1.w};
#pragma unroll
            for (int i = 0; i < 8; ++i) res[i] = (y[i] * rstd * lw[i] + lb[i] + bon * (float)v8[i]) * gq[i];
            *(GAS v4u*)(omix + (row0 + t0 + t) * DM + 1024 + hc0) = (v4u){pkh(res[0], res[1]), pkh(res[2], res[3]), pkh(res[4], res[5]), pkh(res[6], res[7])}; }
        LBAR(); STG(7);
    }
#ifdef DIAG_STG
    if (tid0 == 0 && unit == 0) { unsigned long long* tsq = (unsigned long long*)(a.ws + WS_CTL + 4096); unsigned long long c_ = 0; tsq[32] = 0;
#pragma unroll
        for (int i = 0; i < 10; ++i) { c_ += stg_t[i]; tsq[33 + i] = c_; } }
#endif
#undef STG
#undef RC_LOAD_RAW
}
__device__ __forceinline__ void dn_norm_gate(const Frame& F, const Args& a) {
    const int gw = F.bid * NWAVES + F.wave, NGW = F.G * NWAVES, lane = F.lane;
    const float* oraw = a.out; const h16* P = (const h16*)(a.ws + WS_P); h16* omix = (h16*)(a.ws + WS_OMIX);
    const int cn = (lane & 7) * 16;
    f32x4 nw[4];
#pragma unroll
    for (int j = 0; j < 4; ++j) nw[j] = *(const f32x4*)(a.in[7] + cn + 4 * j);
    for (int m = gw; m < MTOK; m += NGW) {
        const GAS f32x4* op = (const GAS f32x4*)(oraw + (size_t)m * 1024 + lane * 16);
        f32x4 v[4]; float s = 0.f;
#pragma unroll
        for (int j = 0; j < 4; ++j) { v[j] = op[j]; s += (v[j].x * v[j].x + v[j].y * v[j].y) + (v[j].z * v[j].z + v[j].w * v[j].w); }
        s = red8(s);
        const float rstd = __builtin_amdgcn_rsqf(s * (1.0f / 128.0f) + RMS_EPS);
        const GAS v4u* zp = (const GAS v4u*)(P + (size_t)m * PW + 3072 + lane * 16);
        const v4u z0 = zp[0], z1 = zp[1]; const unsigned zz[8] = {z0.x, z0.y, z0.z, z0.w, z1.x, z1.y, z1.z, z1.w};
        unsigned ow[8];
#pragma unroll
        for (int j = 0; j < 4; ++j) {
            const float za = h2f((h16)(zz[2 * j] & 0xffff)), zb = h2f((h16)(zz[2 * j] >> 16)), zc = h2f((h16)(zz[2 * j + 1] & 0xffff)), zd = h2f((h16)(zz[2 * j + 1] >> 16));
            const f32x4 o = v[j] * rstd * nw[j];
            ow[2 * j] = pkh(o.x * za * sigmoidf_(za), o.y * zb * sigmoidf_(zb)); ow[2 * j + 1] = pkh(o.z * zc * sigmoidf_(zc), o.w * zd * sigmoidf_(zd)); }
        GAS v4u* dst = (GAS v4u*)(omix + (size_t)m * DM + lane * 16);
        dst[0] = (v4u){ow[0], ow[1], ow[2], ow[3]}; dst[1] = (v4u){ow[4], ow[5], ow[6], ow[7]};
    }
}

constexpr int XA_KP = 136, XA_VP = 264;
constexpr int XAL_K = 0, XAL_V = XAL_K + 256 * XA_KP * 2, XAL_END = XAL_V + 128 * XA_VP * 2;
__device__ __forceinline__ void xattn_phase(const Frame& F, const Args& a) {
    const int tid = F.tid, lane = F.lane, w = F.wave, l15 = lane & 15, lg = lane >> 4;
    LAS h16* KL = (LAS h16*)(F.lds + XAL_K); LAS h16* VT = (LAS h16*)(F.lds + XAL_V);
    const h16* KV = (const h16*)(a.ws + WS_KV); const h16* Q = (const h16*)a.out; h16* AO = (h16*)(a.ws + WS_AO);
    for (int pair = F.bid; pair < 256; pair += F.G) {
        const int bhd = pair >> 3, b = bhd >> 2, hd = bhd & 3;
        __syncthreads();
#pragma unroll
        for (int i = 0; i < 8; ++i) { const int id = tid + 512 * i;
            { const int mem = id >> 4, dc = id & 15; *(LAS v4u*)(KL + mem * XA_KP + dc * 8) = *(const GAS v4u*)(KV + (size_t)(b * 256 + mem) * 512 + hd * 128 + dc * 8); }
            { const int d = id >> 5, ch = id & 31; *(LAS v4u*)(VT + d * XA_VP + ch * 8) = *(const GAS v4u*)(KV + (size_t)MMEM * 512 + (size_t)(hd * 128 + d) * MMEM + b * 256 + ch * 8); } }
        __syncthreads();
        for (int qi = 0; qi < 2; ++qi) {
            const int qb = (pair & 7) * 2 + qi; const size_t tok = (size_t)b * SEQ + qb * 128 + 16 * w + l15;
            h16x8 qf[4];
            { const h16* q0 = Q + tok * 512 + hd * 128 + 8 * lg; const h16* q1 = q0 + (size_t)MTOK * 512;
              const float rstd = __builtin_amdgcn_rsqf(((const float*)(a.ws + WS_CTL + CTL_SS1))[tok] * (1.0f / DM) + RMS_EPS);
#pragma unroll
              for (int ks = 0; ks < 4; ++ks) { const h16x8 a0 = *(const GAS h16x8*)(q0 + 32 * ks), b0 = *(const GAS h16x8*)(q1 + 32 * ks); float sv[8];
#pragma unroll
                  for (int e = 0; e < 8; ++e) sv[e] = ((float)a0[e] + (float)b0[e]) * rstd;
                  const v4u t = {pkh(sv[0], sv[1]), pkh(sv[2], sv[3]), pkh(sv[4], sv[5]), pkh(sv[6], sv[7])}; qf[ks] = __builtin_bit_cast(h16x8, t); } }
            pg8::f32x4 s[16];
#pragma unroll
            for (int mt = 0; mt < 16; ++mt) { s[mt] = (pg8::f32x4){0.f, 0.f, 0.f, 0.f};
#pragma unroll
                for (int ks = 0; ks < 4; ++ks) { const h16x8 kf = *(const LAS h16x8*)(KL + (16 * mt + l15) * XA_KP + 32 * ks + 8 * lg); s[mt] = __builtin_amdgcn_mfma_f32_16x16x32_f16(kf, qf[ks], s[mt], 0, 0, 0); }
                if (mt & 1) __builtin_amdgcn_sched_barrier(0); }
            float mx = -3.0e38f;
#pragma unroll
            for (int mt = 0; mt < 16; ++mt) mx = fmaxf(fmaxf(fmaxf(mx, s[mt][0]), fmaxf(s[mt][1], s[mt][2])), s[mt][3]);
            mx = fmaxf(mx, __shfl_xor(mx, 16)); mx = fmaxf(mx, __shfl_xor(mx, 32));
            const float sc = 0.08838834764831845f * 1.4426950408889634f; float sum = 0.f;
#pragma unroll
            for (int mt = 0; mt < 16; ++mt)
#pragma unroll
                for (int r = 0; r < 4; ++r) { const float p = __builtin_amdgcn_exp2f((s[mt][r] - mx) * sc); s[mt][r] = p; sum += p; }
            sum += __shfl_xor(sum, 16); sum += __shfl_xor(sum, 32);
            const float inv = 1.0f / sum;
            h16x8 pf[8];
#pragma unroll
            for (int ss = 0; ss < 8; ++ss) { v4u t; t.x = pkh(s[2 * ss][0] * inv, s[2 * ss][1] * inv); t.y = pkh(s[2 * ss][2] * inv, s[2 * ss][3] * inv); t.z = pkh(s[2 * ss + 1][0] * inv, s[2 * ss + 1][1] * inv); t.w = pkh(s[2 * ss + 1][2] * inv, s[2 * ss + 1][3] * inv);
                pf[ss] = __builtin_bit_cast(h16x8, t); }
#pragma unroll
            for (int dt = 0; dt < 8; ++dt) { pg8::f32x4 o = {0.f, 0.f, 0.f, 0.f};
#pragma unroll
                for (int ss = 0; ss < 8; ++ss) { const LAS h16* vp = VT + (16 * dt + l15) * XA_VP + 32 * ss + 4 * lg;
                    const v2u lo = *(const LAS v2u*)vp, hi = *(const LAS v2u*)(vp + 16); const v4u t = {lo.x, lo.y, hi.x, hi.y};
                    o = __builtin_amdgcn_mfma_f32_16x16x32_f16(__builtin_bit_cast(h16x8, t), pf[ss], o, 0, 0, 0); }
                v2u ow; ow.x = pkh(o[0], o[1]); ow.y = pkh(o[2], o[3]);
                *(GAS v2u*)(AO + tok * 512 + hd * 128 + 16 * dt + 4 * lg) = ow; __builtin_amdgcn_sched_barrier(0); }
        }
    }
}

__device__ __forceinline__ void final_norm(const Frame& F, const Args& a) {
    const int gw = F.bid * NWAVES + F.wave, NGW = F.G * NWAVES, lane = F.lane;
    const float* ss = (const float*)(a.ws + WS_CTL + CTL_SS3); const h16* H3 = (const h16*)(a.ws + WS_H2);
    f32x4 wv[4][2];
#pragma unroll
    for (int j = 0; j < 4; ++j) { wv[j][0] = *(const GAS f32x4*)(a.in[29] + 512 * j + 8 * lane); wv[j][1] = *(const GAS f32x4*)(a.in[29] + 512 * j + 8 * lane + 4); }
    for (int m = gw; m < MTOK; m += NGW) {
        const float rstd = __builtin_amdgcn_rsqf(ss[m] * (1.0f / DM) + RMS_EPS);
        const GAS h16x8* xr = (const GAS h16x8*)(H3 + (size_t)m * DM) + lane; GAS f32x4* orow = (GAS f32x4*)(a.out + (size_t)m * DM) + 2 * lane;
        h16x8 v[4];
#pragma unroll
        for (int j = 0; j < 4; ++j) v[j] = xr[64 * j];
#pragma unroll
        for (int j = 0; j < 4; ++j) { const f32x4 lo = {(float)v[j][0], (float)v[j][1], (float)v[j][2], (float)v[j][3]}, hi = {(float)v[j][4], (float)v[j][5], (float)v[j][6], (float)v[j][7]};
            orow[128 * j] = lo * rstd * wv[j][0]; orow[128 * j + 1] = hi * rstd * wv[j][1]; }
    }
}
constexpr int N_PHASES = 11;
#ifndef MK_ONE_LAUNCH
#define MK_ONE_LAUNCH 1
#endif
struct P1Order {
    static constexpr int SLEEP = 0;
    pg8::StaticOrder s;
    __device__ bool next(int i, pg8::Unit& u) const { if (!s.next(i, u)) return false; u.pm = u.pm < 56 ? (u.pm / 7) * 8 + u.pm % 7 : u.pm + 8; return true; }
};
struct FlowOrder {
    static constexpr int SLEEP = 0;
    int c, rank;
    __device__ bool next(int i, pg8::Unit& u) const {
        if (i > 6 || (i == 6 && rank < 0)) return false;
        const int L = i * 256 + (i == 6 ? rank : c); u.ks = 0;
        if (L >= 1680) { const int e = L - 1680; if (e >= 16) return false; u.pm = 64 + (e >> 1); u.pn = 30 + (e & 1); return true; }
        const int x = L & 7, off = L >> 3;
        if (off < 120) { u.pm = x * 8 + (off & 3); u.pn = off >> 2; } else { const int w = off - 120; u.pm = x * 8 + 4 + w % 3; u.pn = w / 3; }
        return true; }
};
struct EpiFlow {
    static constexpr bool PERM = true;
    pg8::EpiF16<0> e; unsigned char* ws; mutable int n;
    __device__ __forceinline__ void prefetch(const pg8::Unit&, int, int, float (&)[8]) const { }
    __device__ __forceinline__ void operator()(const pg8::f32x4 (&acc)[2][2][4][2], const pg8::Unit& u, int wr, int wc, int fr, int fq, const float (&pf)[8]) const {
        e(acc, u, wr, wc, fr, fq, pf);
        if (++n == 4) flow_signal(ws, 0);
    }
};
struct DefOrder {
    static constexpr int SLEEP = 0;
    pg8::StaticOrder s;
    __device__ bool next(int i, pg8::Unit& u) const { if (!s.next(i, u)) return false; u.pm = u.pm * 8 + 7; return true; }
};
struct DefOrder2 {
#ifndef DEF_SLEEP
#define DEF_SLEEP 0
#endif
    static constexpr int SLEEP = DEF_SLEEP;
    int half, j;
    __device__ bool next(int i, pg8::Unit& u) const { const int L = 32 * i + j; if (L >= 120) return false; u.ks = 0; u.pm = (half * 4 + (L & 3)) * 8 + 7; u.pn = L >> 2; return true; }
};
struct EpiSig {
    static constexpr bool PERM = true;
    pg8::EpiF16<0> e; unsigned* cnt;
    __device__ __forceinline__ void prefetch(const pg8::Unit&, int, int, float (&)[8]) const { }
    __device__ __forceinline__ void operator()(const pg8::f32x4 (&acc)[2][2][4][2], const pg8::Unit& u, int wr, int wc, int fr, int fq, const float (&pf)[8]) const {
        e(acc, u, wr, wc, fr, fq, pf);
        asm volatile("s_waitcnt vmcnt(0)" ::: "memory");
        __syncthreads();
        if (threadIdx.x == 0) { __builtin_amdgcn_fence(__ATOMIC_RELEASE, "agent"); asm volatile("s_waitcnt vmcnt(0)" ::: "memory"); (void)xb_add(cnt + 64 * (u.pm >> 3), 1u); }
    }
};
__global__ void __launch_bounds__(NTHREADS, 2) fwd_kernel(Args args) {
    extern __shared__ __attribute__((aligned(16))) unsigned char lds[];
    Frame F; F.lds = (LAS unsigned char*)lds; F.tid = threadIdx.x; F.lane = F.tid & 63; F.wave = __builtin_amdgcn_readfirstlane(F.tid >> 6); F.G = gridDim.x; F.bid = blockIdx.x;
    unsigned char* ws = args.ws;
    const int lo = args.ph_lo, hi = args.ph_hi;
    volatile LAS unsigned* misc = (volatile LAS unsigned*)(F.lds + LDS_MISC);
    if (F.tid < 16) misc[F.tid] = 0u;
    __syncthreads();
    XcdBarrier xbar = xcd_barrier_post((unsigned*)(ws + WS_CTL + CTL_BAR), misc);
#define IN(k) (lo <= (k) && (k) < hi)
#ifndef REPEAT_PH
#define REPEAT_PH -1
#endif
#ifndef REPEAT_N
#define REPEAT_N 1
#endif
#define REP(k) for (int rep_ = 0; rep_ < ((k) == REPEAT_PH ? 1 + REPEAT_N : 1); ++rep_, ((k) == REPEAT_PH && rep_ <= REPEAT_N ? (cg::this_grid().sync(), 0) : 0))
#ifndef WGM_P1
#define WGM_P1 4
#endif
#ifndef WGM_P4
#define WGM_P4 4
#endif
#ifndef WGM_P8
#define WGM_P8 4
#endif
#ifndef WGM_P9
#define WGM_P9 4
#endif
#ifndef REV_P1
#define REV_P1 1
#endif
#ifndef REV_P9
#define REV_P9 1
#endif
#ifndef CG_SEAM
#define CG_SEAM 2
#endif
#if MK_ONE_LAUNCH
#define SEAM(k) do { if (IN(k) && IN((k) + 1)) { if ((k) == CG_SEAM) cg::this_grid().sync(); else xcd_barrier(xbar); } } while (0)
#else
#define SEAM(k) do { } while (0)
#endif
#ifdef DIAG_A
    unsigned long long* ts = (unsigned long long*)(ws + WS_CTL + 4096);
#define STAMP(i) do { if (F.bid == 0 && F.tid == 0) { ts[i] = __builtin_amdgcn_s_memrealtime(); ts[64 + (i)] = __builtin_amdgcn_s_memtime(); } } while (0)
#else
#define STAMP(i) do { } while (0)
#endif
    STAMP(0);
    float* ss1 = (float*)(ws + WS_CTL + CTL_SS1); float* ss2 = (float*)(ws + WS_CTL + CTL_SS2); float* ss3 = (float*)(ws + WS_CTL + CTL_SS3);
    if (IN(0)) REP(0) { p0_prologue(F, args); } SEAM(0); STAMP(1);
    if (IN(1)) REP(1) { pg8::Gemm g{(const pg8::h16_t*)args.out, (const pg8::h16_t*)(ws + WS_WALL), DM, DM};
#if FLOW
        const int role1 = (F.bid & 7) * 32 + (F.bid >> 3);
        FlowOrder S{F.bid, role1 - 64};
        EpiFlow E{{(pg8::h16_t*)(ws + WS_P), PW, nullptr, 0.f, (pg8::h16_t*)(ws + WS_KV), 512, 64, 30, 0}, ws, 0};
        pg8::gemm_phase(F.lds, g, S, E);
        flow_signal(ws, 1); }
#else
#if DEFER && DEFER != 3
        P1Order S; S.s.init(56, 30, F.G, F.bid, 8, 2, 1, WGM_P1, REV_P1);
#else
        pg8::StaticOrder S; S.init(64, 30, F.G, F.bid, 8, 2, 1, WGM_P1, REV_P1);
#endif

        pg8::EpiF16<0> E{(pg8::h16_t*)(ws + WS_P), PW, nullptr, 0.f, (pg8::h16_t*)(ws + WS_KV), 512, 64, 30, 0};
        pg8::gemm_phase(F.lds, g, S, E); }
    SEAM(1);
#endif
    STAMP(2);
    if (IN(2)) REP(2) {
#ifdef DIAG_A
        const unsigned long long tq0 = __builtin_amdgcn_s_memrealtime();
#endif
#if ROLE_XCD
#if ROLE_XCD == 2
        const int rx_ = F.bid & 7, rj_ = F.bid >> 3;
        const int role = rx_ < 4 ? (rj_ < 16 ? rx_ * 16 + rj_ : 64 + rx_ * 16 + (rj_ - 16)) : rx_ < 6 ? 128 + (rx_ - 4) * 32 + rj_ : 192 + (rx_ - 6) * 32 + rj_;
#else
        const int role = (F.bid & 7) * 32 + (F.bid >> 3);
#endif
#else
        const int role = F.bid;
#endif
#if FLOW
        if (IN(1)) { if (role < 64) flow_wait(ws, 0); else if (role < 192) flow_wait(ws, 1); }
#endif
        if (role < 64) dn_chunked(F, args, role); else if (role < 192) rw_chunked(F, args, role - 64); else {
#if DEFER
            { pg8::Gemm g{(const pg8::h16_t*)args.out, (const pg8::h16_t*)(ws + WS_WALL), DM, DM};
#if ROLE_XCD
              DefOrder2 S{(role - 192) >> 5, (role - 192) & 31};
#else
              DefOrder S; S.s.init(8, 30, 64, F.bid - 192, 0, 0, 1, 1);
#endif

#if DEFER >= 2
              pg8::EpiF16<0> E{(pg8::h16_t*)(ws + WS_P), PW, nullptr, 0.f, nullptr, 0, 0, 0, 0};
              pg8::gemm_phase(F.lds, g, S, E);
              asm volatile("s_waitcnt vmcnt(0)" ::: "memory");
              __syncthreads();
              if (F.tid == 0) { __builtin_amdgcn_fence(__ATOMIC_RELEASE, "agent"); asm volatile("s_waitcnt vmcnt(0)" ::: "memory");
#if ROLE_XCD
                  (void)xb_add((unsigned*)(ws + WS_CTL + CTL_DEF) + 64 * (S.half * 4 + (S.j & 3)), S.j < 24 ? 4u : 3u); }
#else
                  const int c = F.bid - 192;
                  (void)xb_add((unsigned*)(ws + WS_CTL + CTL_DEF) + 64 * (c & 7), (c >> 3) < 6 ? 4u : 3u); }
#endif
#else
              EpiSig E{{(pg8::h16_t*)(ws + WS_P), PW, nullptr, 0.f, nullptr, 0, 0, 0, 0}, (unsigned*)(ws + WS_CTL + CTL_DEF)};
              pg8::gemm_phase(F.lds, g, S, E);
#endif
            }
            __syncthreads();
#endif
#ifdef DIAG_A
            if (F.tid == 0 && role == 192) { ts[22] = tq0; ts[23] = __builtin_amdgcn_s_memrealtime(); }
#endif
            if (LATE_W) p0_weights(F, args, 1, (role - 192) * NWAVES + F.wave, 64 * NWAVES);
            __syncthreads();
            pg8::Gemm g{(const pg8::h16_t*)(ws + WS_WALL) + (size_t)8192 * DM, (const pg8::h16_t*)args.out + (size_t)MTOK * DM, DM, DM}; pg8::StaticOrder S; S.init(2, 8, 64, role - 192, 0, 0, 1, 2);
            pg8::EpiF16<0> E{(pg8::h16_t*)(ws + WS_KV) + (size_t)MMEM * 512, MMEM, nullptr, 0.f, nullptr, 0, 0, 0, 0};
            pg8::gemm_phase(F.lds, g, S, E); }
#ifdef DIAG_A
#ifndef DIAG_R0
#define DIAG_R0 0
#endif
#ifndef DIAG_R1
#define DIAG_R1 64
#endif
#ifndef DIAG_R2
#define DIAG_R2 192
#endif
        if (F.tid == 0) { const unsigned long long now_ = __builtin_amdgcn_s_memrealtime(); if (F.bid == 0) { ts[28] = tq0; ts[30] = tq0; ts[34] = tq0; }
            if (role < 64) atomicMax(&ts[31], now_); else if (role < 192) atomicMax(&ts[29], now_); else atomicMax(&ts[35], now_); }
        if (F.tid == 0) { if (F.bid == 0) ts[24] = tq0; atomicMax(&ts[25], (unsigned long long)__builtin_amdgcn_s_memrealtime()); atomicMax(&ts[27], (((unsigned long long)__builtin_amdgcn_s_memrealtime()) << 8) | (unsigned long long)role); }
        if (F.tid == 0 && role == DIAG_R0) { ts[16] = tq0; ts[17] = __builtin_amdgcn_s_memrealtime(); }
        if (F.tid == 0 && role == DIAG_R1) { ts[18] = tq0; ts[19] = __builtin_amdgcn_s_memrealtime(); }
        if (F.tid == 0 && role == DIAG_R2) { ts[20] = tq0; ts[21] = __builtin_amdgcn_s_memrealtime(); }
#endif
        } SEAM(2); STAMP(3); STAMP(4);
#ifdef DIAG_A
    if (F.bid == 0 && F.tid == 0) { ts[38] = ts[0]; ts[39] = ts[3]; ts[36] = ts[1]; ts[37] = ts[3]; }
#endif
    if (IN(4)) REP(4) { pg8::Gemm g{(const pg8::h16_t*)(ws + WS_OMIX), (const pg8::h16_t*)(ws + WS_WOUT), DM, DM}; pg8::StaticOrder S; S.init(64, 8, F.G, F.bid, 0, 0, 1, WGM_P4);
        pg8::EpiRes E{args.in[0], nullptr, nullptr, (pg8::h16_t*)(ws + WS_H1), ss1, DM};
        pg8::gemm_phase(F.lds, g, S, E); } SEAM(4); STAMP(5);
    if (IN(5)) REP(5) { pg8::Gemm g{(const pg8::h16_t*)(ws + WS_H1), (const pg8::h16_t*)(ws + WS_WQ), DM / 2, DM}; pg8::StaticOrder S; S.init(64, 2, F.G, F.bid, 0, 0, 2);
        pg8::EpiF16<0> E{(pg8::h16_t*)args.out, 512, nullptr, 0.f, nullptr, 0, 0, 0, (size_t)MTOK * 512};
        pg8::gemm_phase(F.lds, g, S, E); } SEAM(5); STAMP(6);
    if (IN(6)) REP(6) { xattn_phase(F, args); } SEAM(6); STAMP(7);
    if (IN(7)) REP(7) { pg8::Gemm g{(const pg8::h16_t*)(ws + WS_AO), (const pg8::h16_t*)(ws + WS_WO), 512, 512}; pg8::StaticOrder S; S.init(64, 8, F.G, F.bid);
        pg8::EpiRes E{nullptr, (const pg8::h16_t*)(ws + WS_H1), nullptr, (pg8::h16_t*)(ws + WS_H2), ss2, DM};
        pg8::gemm_phase(F.lds, g, S, E); } SEAM(7); STAMP(8);
    if (IN(8)) REP(8) { pg8::Gemm g{(const pg8::h16_t*)(ws + WS_H2), (const pg8::h16_t*)(ws + WS_W1), DM, DM}; pg8::StaticOrder S; S.init(64, 32, F.G, F.bid, 0, 0, 1, WGM_P8);
        pg8::EpiF16<1> E{(pg8::h16_t*)(ws + WS_HID), FF, ss2, RMS_EPS, nullptr, 0, 0, 0, 0};
        pg8::gemm_phase(F.lds, g, S, E); } SEAM(8); STAMP(9);
    if (IN(9)) REP(9) { pg8::Gemm g{(const pg8::h16_t*)(ws + WS_HID), (const pg8::h16_t*)(ws + WS_W2), FF, FF}; pg8::StaticOrder S; S.init(64, 8, F.G, F.bid, 0, 0, 1, WGM_P9, REV_P9);
        pg8::EpiRes E{nullptr, (const pg8::h16_t*)(ws + WS_H2), nullptr, (pg8::h16_t*)(ws + WS_H2), ss3, DM};
        pg8::gemm_phase(F.lds, g, S, E); } SEAM(9); STAMP(10);
    if (IN(10)) REP(10) { final_norm(F, args); }
#ifdef DIAG_A
    STAMP(11);
    if (F.bid == 0 && F.tid == 0) { ts[60] = ts[0]; ts[61] = ts[11]; }
    if (F.bid == 0 && F.tid == 0) {
#ifdef DIAG_CLK
        const unsigned long long d = (ts[64 + DIAG_A + 1] - ts[64 + DIAG_A]) / 100ull, t1 = __builtin_amdgcn_s_memrealtime() + d;
#else
#ifndef DIAG_MUL
#define DIAG_MUL 4
#endif
#ifdef DIAG_WHO
        const unsigned long long d = (ts[27] & 255ull) * 1000ull, t1 = __builtin_amdgcn_s_memrealtime() + d;
#else
        const unsigned long long d = (unsigned long long)DIAG_MUL * (ts[DIAG_A + 1] - ts[DIAG_A]), t1 = __builtin_amdgcn_s_memrealtime() + d;
#endif
#endif
        while (__builtin_amdgcn_s_memrealtime() < t1) __builtin_amdgcn_s_sleep(32); }
#endif
#undef IN
#undef SEAM
}

extern "C" void kernel_launch(void* const* d_in, const int* in_sizes, int n_in, void* d_out, int out_size, void* d_ws, size_t ws_size, hipStream_t stream) {
    static int grid = 0;
    if (grid == 0) {
        if (n_in != 30 || out_size != MTOK * DM || ws_size < WS_END) { fprintf(stderr, "kernel_launch: unexpected problem (n_in %d, out %d, ws %zu < %zu)\n", n_in, out_size, ws_size, (size_t)WS_END); grid = -1; return; }
        int dev = 0, cus = 0, per_cu = 0;
        hipGetDevice(&dev); hipDeviceGetAttribute(&cus, hipDeviceAttributeMultiprocessorCount, dev);
        if (hipFuncSetAttribute((const void*)fwd_kernel, hipFuncAttributeMaxDynamicSharedMemorySize, LDS_BYTES) != hipSuccess) { fprintf(stderr, "kernel_launch: hipFuncSetAttribute failed\n"); grid = -1; return; }
        if (hipOccupancyMaxActiveBlocksPerMultiprocessor(&per_cu, (const void*)fwd_kernel, NTHREADS, LDS_BYTES) != hipSuccess || per_cu < 1) { fprintf(stderr, "kernel_launch: occupancy query says %d\n", per_cu); per_cu = 1; }
        (void)hipGetLastError();
        if (cus < 256 || per_cu < 1) { fprintf(stderr, "kernel_launch: needs 256 CUs with one resident workgroup each (cus %d, per_cu %d); nothing launched\n", cus, per_cu); grid = -1; return; }
        grid = 256;
    }
    if (grid < 0) return;
    hipMemsetAsync((char*)d_ws + WS_CTL, 0, CTL_ZERO_BYTES, stream);
    Args a{};
    for (int i = 0; i < 30; ++i) a.in[i] = (const float*)d_in[i];
    a.out = (float*)d_out; a.ws = (unsigned char*)d_ws;
#if MK_ONE_LAUNCH
    a.ph_lo = 0; a.ph_hi = N_PHASES;
    void* kargs[] = {&a};
    hipError_t e = hipLaunchCooperativeKernel((const void*)fwd_kernel, dim3(grid), dim3(NTHREADS), kargs, LDS_BYTES, stream);
    if (e != hipSuccess) fprintf(stderr, "cooperative launch failed: %s (grid %d)\n", hipGetErrorString(e), grid);
#else
    for (int ph = 0; ph < N_PHASES; ++ph) { a.ph_lo = ph; a.ph_hi = ph + 1; hipLaunchKernelGGL(fwd_kernel, dim3(grid), dim3(NTHREADS), LDS_BYTES, stream, a); }
#endif
}
```
